# Optimizing an MI355X kernel written in HIP

```python
import jax, jax.numpy as jnp
from jax import lax
import numpy as np

D_MODEL = 1024
BATCH = 4
SEQ = 4096
DEPTH = 4

N_META = 16
N_A_LAYERS = DEPTH // 2
N_B_LAYERS = DEPTH - N_A_LAYERS
N_HEADS = 8
HEAD_DIM = D_MODEL // N_HEADS
N_KV_HEADS = 2
GROUP = N_HEADS // N_KV_HEADS
ROPE_THETA = 500000.0
IDX_HEADS = 4
IDX_DIM = 64
INDEX_TOPK = 256
Q_BLOCK = 128
PEER_HEADS = 8
PEER_QUERY_DIM = 256
PEER_HALF = PEER_QUERY_DIM // 2
N_KEYS = 128
N_EXPERTS = N_KEYS * N_KEYS
PEER_TOPK = 16
PEER_CHUNK = 128
RMS_EPS = 1e-6

A_Q = N_HEADS * HEAD_DIM
A_K = N_KV_HEADS * HEAD_DIM
A_V = N_KV_HEADS * HEAD_DIM
A_QI = IDX_HEADS * IDX_DIM
A_KI = IDX_DIM
A_WI = IDX_HEADS
A_COLS = A_Q + A_K + A_V + A_QI + A_KI + A_WI
A_SPLITS = [A_Q, A_Q + A_K, A_Q + A_K + A_V, A_Q + A_K + A_V + A_QI, A_Q + A_K + A_V + A_QI + A_KI]

kernel_name = "yoco_dsa_stickbreak_peer_meta"


def rms_norm(x, gain):
    xf = x.astype(jnp.float32)
    y = xf * lax.rsqrt(jnp.mean(xf * xf, axis=-1, keepdims=True) + RMS_EPS)
    return (y * gain.astype(jnp.float32)).astype(x.dtype)


def partial_rope(x, pos):
    d = x.shape[-1]
    r = d // 4
    half = r // 2
    inv = ROPE_THETA ** (-jnp.arange(half, dtype=jnp.float32) * 2.0 / r)
    ang = pos[:, None] * inv[None, :]
    cos = jnp.cos(ang)[None, :, None, :]
    sin = jnp.sin(ang)[None, :, None, :]
    xf = x.astype(jnp.float32)
    x1 = xf[..., :half]
    x2 = xf[..., half:r]
    out = jnp.concatenate([x1 * cos - x2 * sin, x2 * cos + x1 * sin, xf[..., r:]], axis=-1)
    return out.astype(x.dtype)


def to_blocks(a):
    b, t = a.shape[:2]
    a = a.reshape((b, t // Q_BLOCK, Q_BLOCK) + a.shape[2:])
    return jnp.moveaxis(a, 1, 0)


def from_blocks(a):
    a = jnp.moveaxis(a, 0, 1)
    return a.reshape((a.shape[0], a.shape[1] * a.shape[2]) + a.shape[3:])


def dsa_attention(hn, w_in, q_gain, k_gain, w_o, pos, topk):
    b, t, _ = hn.shape
    proj = hn @ w_in
    q, k, v, qi, ki, wi = jnp.split(proj, A_SPLITS, axis=-1)
    q = partial_rope(rms_norm(q.reshape(b, t, N_HEADS, HEAD_DIM), q_gain), pos)
    k = partial_rope(rms_norm(k.reshape(b, t, N_KV_HEADS, HEAD_DIM), k_gain), pos)
    v = v.reshape(b, t, N_KV_HEADS, HEAD_DIM)
    qi = partial_rope(qi.reshape(b, t, IDX_HEADS, IDX_DIM), pos) * (IDX_DIM ** -0.5)
    ki = partial_rope(ki.reshape(b, t, 1, IDX_DIM), pos)[:, :, 0]
    wi = wi * (IDX_HEADS ** -0.5)
    key_pos = jnp.arange(t)
    gather = jax.vmap(lambda a, i: a[i])

    def block(args):
        qb, qib, wib, t0 = args
        qpos = t0 + jnp.arange(Q_BLOCK)
        causal = key_pos[None, :] <= qpos[:, None]
        score = jnp.einsum('bqhd,bsd->bqhs', qib.astype(jnp.float32), ki.astype(jnp.float32))
        score = jnp.einsum('bqhs,bqh->bqs', jax.nn.relu(score), wib.astype(jnp.float32))
        score = jnp.where(causal[None], score, -jnp.inf)
        _, sel = lax.top_k(score, topk)
        valid = sel <= qpos[None, :, None]
        k_sel = gather(k, sel)
        v_sel = gather(v, sel)
        qg = qb.reshape(b, Q_BLOCK, N_KV_HEADS, GROUP, HEAD_DIM)
        logits = jnp.einsum('bqhgd,bqnhd->bqhgn', qg, k_sel).astype(jnp.float32) * (HEAD_DIM ** -0.5)
        logits = jnp.where(valid[:, :, None, None, :], logits, -jnp.inf)
        p = jax.nn.softmax(logits, axis=-1).astype(v.dtype)
        o = jnp.einsum('bqhgn,bqnhd->bqhgd', p, v_sel)
        return o.reshape(b, Q_BLOCK, N_HEADS * HEAD_DIM)

    starts = jnp.arange(t // Q_BLOCK) * Q_BLOCK
    o = lax.map(block, (to_blocks(q), to_blocks(qi), to_blocks(wi), starts))
    return from_blocks(o) @ w_o


def stick_breaking_attention(hn, w_q, w_o, k, v):
    b, t, _ = hn.shape
    q = (hn @ w_q).reshape(b, t, N_KV_HEADS, GROUP, HEAD_DIM)
    key_pos = jnp.arange(t)

    def block(args):
        qb, t0 = args
        qpos = t0 + jnp.arange(Q_BLOCK)
        causal = key_pos[None, :] < qpos[:, None]
        z = jnp.einsum('bqhgd,bshd->bhgqs', qb, k).astype(jnp.float32) * (HEAD_DIM ** -0.5)
        log_keep = jnp.where(causal, jax.nn.log_sigmoid(-z), 0.0)
        between = lax.cumsum(log_keep, axis=4, reverse=True) - log_keep
        a = jnp.where(causal, jnp.exp(jax.nn.log_sigmoid(z) + between), 0.0).astype(v.dtype)
        o = jnp.einsum('bhgqs,bshd->bqhgd', a, v)
        return o.reshape(b, Q_BLOCK, N_HEADS * HEAD_DIM)

    starts = jnp.arange(t // Q_BLOCK) * Q_BLOCK
    o = lax.map(block, (to_blocks(q), starts))
    return from_blocks(o) @ w_o


def peer_ffn(hn, w_q, subkeys, u, v):
    b, t, d = hn.shape
    n = b * t
    xt = hn.reshape(n, d)
    q = (xt @ w_q).reshape(n, PEER_HEADS, 2, PEER_HALF)
    s = jnp.einsum('nhcd,ckd->nhck', q, subkeys).astype(jnp.float32)
    s_top, i_top = lax.top_k(s, PEER_TOPK)
    cand = s_top[:, :, 0, :, None] + s_top[:, :, 1, None, :]
    cand_id = i_top[:, :, 0, :, None] * N_KEYS + i_top[:, :, 1, None, :]
    best, pick = lax.top_k(cand.reshape(n, PEER_HEADS, PEER_TOPK * PEER_TOPK), PEER_TOPK)
    ids = jnp.take_along_axis(cand_id.reshape(n, PEER_HEADS, PEER_TOPK * PEER_TOPK), pick, axis=-1)
    g = jax.nn.softmax(best, axis=-1).astype(hn.dtype)
    n_chunks = n // PEER_CHUNK

    def chunk(args):
        xc, ic, gc = args
        u_sel = u[ic]
        v_sel = v[ic]
        act = jax.nn.gelu(jnp.einsum('cd,ced->ce', xc, u_sel), approximate=False) * gc
        return jnp.einsum('ce,ced->cd', act, v_sel)

    out = lax.map(chunk, (xt.reshape(n_chunks, PEER_CHUNK, d),
                          ids.reshape(n_chunks, PEER_CHUNK, PEER_HEADS * PEER_TOPK),
                          g.reshape(n_chunks, PEER_CHUNK, PEER_HEADS * PEER_TOPK)))
    return out.reshape(b, t, d)


def setup_inputs(seed: int = 0) -> dict:
    key = jax.random.key(seed)
    ks = jax.random.split(key, 20)
    f32 = jnp.float32
    hd = N_HEADS * HEAD_DIM

    def nrm(k, shape, scale):
        return jax.random.normal(k, shape, f32) * scale

    def gain(k, shape):
        return 1.0 + 0.02 * jax.random.normal(k, shape, f32)

    return {
        "x": nrm(ks[0], (BATCH, SEQ, D_MODEL), 1.0),
        "meta_tokens": nrm(ks[1], (N_META, D_MODEL), 1.0),
        "a_norm": gain(ks[2], (N_A_LAYERS, D_MODEL)),
        "a_w_in": nrm(ks[3], (N_A_LAYERS, D_MODEL, A_COLS), D_MODEL ** -0.5),
        "a_q_norm": gain(ks[4], (N_A_LAYERS, HEAD_DIM)),
        "a_k_norm": gain(ks[5], (N_A_LAYERS, HEAD_DIM)),
        "a_w_o": nrm(ks[6], (N_A_LAYERS, hd, D_MODEL), hd ** -0.5),
        "kv_norm": gain(ks[7], (D_MODEL,)),
        "kv_w": nrm(ks[8], (D_MODEL, 2 * N_KV_HEADS * HEAD_DIM), D_MODEL ** -0.5),
        "b_norm": gain(ks[9], (N_B_LAYERS, D_MODEL)),
        "b_w_q": nrm(ks[10], (N_B_LAYERS, D_MODEL, hd), D_MODEL ** -0.5),
        "b_w_o": nrm(ks[11], (N_B_LAYERS, hd, D_MODEL), hd ** -0.5),
        "ffn_norm": gain(ks[12], (DEPTH, D_MODEL)),
        "peer_w_q": nrm(ks[13], (DEPTH, D_MODEL, PEER_HEADS * PEER_QUERY_DIM), D_MODEL ** -0.5),
        "peer_subkeys": nrm(ks[14], (DEPTH, 2, N_KEYS, PEER_HALF), PEER_HALF ** -0.5),
        "peer_u": nrm(ks[15], (DEPTH, N_EXPERTS, D_MODEL), D_MODEL ** -0.5),
        "peer_v": nrm(ks[16], (DEPTH, N_EXPERTS, D_MODEL), 0.1),
    }


def reference(x, meta_tokens, a_norm, a_w_in, a_q_norm, a_k_norm, a_w_o, kv_norm, kv_w,
              b_norm, b_w_q, b_w_o, ffn_norm, peer_w_q, peer_subkeys, peer_u, peer_v):
    b, s, d = x.shape
    t = s + N_META
    t_pad = -(-t // Q_BLOCK) * Q_BLOCK
    h = jnp.concatenate([jnp.broadcast_to(meta_tokens[None].astype(x.dtype), (b, N_META, d)), x], axis=1)
    h = jnp.pad(h, ((0, 0), (0, t_pad - t), (0, 0)))
    pos = jnp.arange(t_pad, dtype=jnp.float32)
    topk = min(INDEX_TOPK, s // 4)
    shared_k = None
    shared_v = None
    for layer in range(DEPTH):
        if layer < N_A_LAYERS:
            h = h + dsa_attention(rms_norm(h, a_norm[layer]), a_w_in[layer], a_q_norm[layer],
                                  a_k_norm[layer], a_w_o[layer], pos, topk)
        else:
            j = layer - N_A_LAYERS
            h = h + stick_breaking_attention(rms_norm(h, b_norm[j]), b_w_q[j], b_w_o[j], shared_k, shared_v)
        h = h + peer_ffn(rms_norm(h, ffn_norm[layer]), peer_w_q[layer], peer_subkeys[layer],
                         peer_u[layer], peer_v[layer])
        if layer == N_A_LAYERS - 1:
            kv = (rms_norm(h, kv_norm) @ kv_w).reshape(b, t_pad, 2 * N_KV_HEADS, HEAD_DIM)
            shared_k, shared_v = jnp.split(kv, 2, axis=2)
    return h[:, N_META:N_META + s]
```

```cpp
#include <hip/hip_runtime.h>
#include <cstdio>
#include <cmath>
#define LAS __attribute__((address_space(3)))
#define GAS __attribute__((address_space(1)))
typedef unsigned short bf16_t;
typedef short bf16x8 __attribute__((ext_vector_type(8)));
typedef float f32x4 __attribute__((ext_vector_type(4)));
typedef float f32x2 __attribute__((ext_vector_type(2)));
typedef unsigned u32x4 __attribute__((ext_vector_type(4)));
typedef unsigned u32x2 __attribute__((ext_vector_type(2)));
typedef __bf16 bf16x2_t __attribute__((ext_vector_type(2)));

constexpr int BATCH = 4, SEQ = 4096, DM = 1024, NMETA = 16, TT = SEQ + NMETA  , TP = 4224, NR = BATCH * TP  ;
constexpr int HD = 128, TOPK = 256;
constexpr int ACOLS = 1860, ACOLS_P = 2048;
constexpr int NEXP = 16384;
constexpr float RMS_EPS = 1e-6f;
constexpr int NT = 512, NWAVES = 8;
constexpr int LDS_BYTES = 160 * 1024;
constexpr int MISC_OFF = LDS_BYTES - 64;

constexpr size_t al256(size_t x) { return (x + 255) & ~(size_t)255; }
constexpr size_t WS_CTL   = 0;
constexpr size_t WS_WIN   = 65536;
constexpr size_t WS_WOA   = WS_WIN  + (size_t)2 * 2048 * 1024 * 2;
constexpr size_t WS_WKVQ  = WS_WOA  + (size_t)2 * 1024 * 1024 * 2;
constexpr size_t WS_WBQ1  = WS_WKVQ + (size_t)1536 * 1024 * 2;
constexpr size_t WS_WOB   = WS_WBQ1 + (size_t)1024 * 1024 * 2;
constexpr size_t WS_WPQ   = WS_WOB  + (size_t)2 * 1024 * 1024 * 2;
constexpr size_t WS_SK    = WS_WPQ  + (size_t)4 * 2048 * 1024 * 2;
constexpr size_t WS_ROPE32= WS_SK   + (size_t)4 * 2 * 128 * 128 * 2;
constexpr size_t WS_ROPE16= WS_ROPE32 + (size_t)TP * 16 * 8;
constexpr size_t WS_U     = al256(WS_ROPE16 + (size_t)TP * 8 * 8);
constexpr size_t WS_V     = WS_U    + (size_t)4 * NEXP * 1024 * 2;
constexpr size_t WS_H     = WS_V    + (size_t)4 * NEXP * 1024 * 2;
constexpr size_t WS_HB    = WS_H    + (size_t)NR * 1024 * 4;
constexpr size_t WS_SS    = WS_HB   + (size_t)NR * 1024 * 2;
constexpr size_t WS_PROJ  = WS_SS   + (size_t)NR * 16 * 4;
constexpr size_t WS_Q     = WS_PROJ + (size_t)NR * 2048 * 2;
constexpr size_t WS_KVA   = WS_Q    + (size_t)NR * 1024 * 2;
constexpr size_t WS_QI    = WS_KVA  + (size_t)NR * 512 * 2;
constexpr size_t WS_KI    = WS_QI   + (size_t)NR * 256 * 2;
constexpr size_t WS_WI    = WS_KI   + (size_t)NR * 64 * 2;
constexpr size_t WS_O     = WS_WI   + (size_t)NR * 4 * 4;
constexpr size_t WS_SKV   = WS_O    + (size_t)NR * 1024 * 2;
constexpr size_t WS_VT    = WS_SKV  + (size_t)NR * 512 * 2;
constexpr size_t WS_END   = WS_VT   + (size_t)BATCH * 2 * 128 * TP * 2;

__device__ __forceinline__ float bf2f(unsigned b) { return __uint_as_float(b << 16); }
__device__ __forceinline__ float bflo(unsigned w) { return __uint_as_float(w << 16); }
__device__ __forceinline__ float bfhi(unsigned w) { return __uint_as_float(w & 0xffff0000u); }
__device__ __forceinline__ unsigned f2bf(float f) { unsigned u = __float_as_uint(f); return (u + 0x7fffu + ((u >> 16) & 1u)) >> 16; }
__device__ __forceinline__ unsigned pk2(float lo, float hi) { return f2bf(lo) | (f2bf(hi) << 16); }
__device__ __forceinline__ float wave_sum(float v) {
#pragma unroll
    for (int o = 1; o < 64; o <<= 1) v += __shfl_xor(v, o);
    return v;
}
__device__ __forceinline__ unsigned mono_key(float s) { const unsigned u = __float_as_uint(s); return u ^ ((u >> 31) ? 0xFFFFFFFFu : 0x80000000u); }
__device__ __forceinline__ float unmono_key(unsigned k) { const unsigned u = (k >> 31) ? (k ^ 0x80000000u) : ~k; return __uint_as_float(u); }
__device__ __forceinline__ unsigned med3u(unsigned a, unsigned b, unsigned c) { unsigned r; asm("v_med3_u32 %0, %1, %2, %3" : "=v"(r) : "v"(a), "v"(b), "v"(c)); return r; }
__device__ __forceinline__ float dot2bf(unsigned a, unsigned b, float c) { return __builtin_amdgcn_fdot2_f32_bf16(__builtin_bit_cast(bf16x2_t, a), __builtin_bit_cast(bf16x2_t, b), c, false); }
#define MFMA16(a, b, c) __builtin_amdgcn_mfma_f32_16x16x32_bf16((a), (b), (c), 0, 0, 0)

#define XB_TMO      128
#define XB_XCNT(j)  (256  + 64 * (j))
#define XB_XSUB(j)  (1280 + 64 * (j))
#define XB_XGEN(j)  (2304 + 64 * (j))
#define XB_TOP      3328
#define XB_TOPGEN   3392
#define XCD_BAR_WORDS 3456
#define XB_SPIN_CAP (1u << 22)
__device__ __forceinline__ unsigned xb_ld(unsigned* p)              { return __hip_atomic_load(p, __ATOMIC_RELAXED, __HIP_MEMORY_SCOPE_AGENT); }
__device__ __forceinline__ unsigned xb_add(unsigned* p, unsigned v) { return __hip_atomic_fetch_add(p, v, __ATOMIC_RELAXED, __HIP_MEMORY_SCOPE_AGENT); }
__device__ __forceinline__ unsigned xb_xcc_id() { return (unsigned)__builtin_amdgcn_s_getreg((3 << 11) | 20) & 0xFu; }
#define XB_SPIN(cond, bar) do { unsigned _sp = 0; while (cond) { __builtin_amdgcn_s_sleep(1); \
    if ((++_sp & 255u) == 0u) { if (xb_ld(&(bar)[XB_TMO])) break; if (_sp > XB_SPIN_CAP) { atomicAdd(&(bar)[XB_TMO], 1u); break; } } } } while (0)
struct XcdBarrier { unsigned* bar; unsigned x; volatile LAS unsigned* st; };
__device__ __forceinline__ XcdBarrier xcd_barrier_post(unsigned* bar, volatile LAS unsigned* st) {
    XcdBarrier b; b.bar = bar; b.x = xb_xcc_id(); b.st = st;
    if (threadIdx.x == 0) (void)xb_add(&bar[XB_XCNT(b.x)], 1u);
    return b;
}
__device__ __forceinline__ void xcd_barrier_complete(unsigned* bar, unsigned x, unsigned& nloc, unsigned& nx) {
    const unsigned G = gridDim.x * gridDim.y * gridDim.z;
    unsigned sum, cnt, mine, sp = 0u;
    for (;;) {
        sum = 0u; cnt = 0u; mine = 0u;
#pragma unroll
        for (unsigned j = 0; j < 16; ++j) { const unsigned c = xb_ld(&bar[XB_XCNT(j)]); sum += c; cnt += (c > 0u) ? 1u : 0u; mine = (j == x) ? c : mine; }
        if (sum == G) break;
        __builtin_amdgcn_s_sleep(1);
        if ((++sp & 255u) == 0u) { if (xb_ld(&bar[XB_TMO])) break; if (sp > XB_SPIN_CAP) { atomicAdd(&bar[XB_TMO], 1u); break; } }
    }
    nloc = mine > 0u ? mine : 1u; nx = cnt > 0u ? cnt : 1u;
}
__device__ __forceinline__ void xcd_barrier(const XcdBarrier& b) {
    asm volatile("s_waitcnt vmcnt(0)" ::: "memory");
    __syncthreads();
    if (threadIdx.x == 0) {
        unsigned* bar = b.bar;
        __builtin_amdgcn_s_waitcnt(0);
        unsigned nloc = b.st[0], nx = b.st[1];
        if (nloc == 0u) { xcd_barrier_complete(bar, b.x, nloc, nx); b.st[0] = nloc; b.st[1] = nx; }
        const unsigned old = xb_add(&bar[XB_XSUB(b.x)], 1u);
        const unsigned gen = old / nloc;
        if (old + 1u == (gen + 1u) * nloc) {
            __builtin_amdgcn_fence(__ATOMIC_RELEASE, "agent");
            asm volatile("s_waitcnt vmcnt(0)" ::: "memory");
            const unsigned og = xb_add(&bar[XB_TOP], 1u);
            const unsigned tg = og / nx;
            if (og + 1u == (tg + 1u) * nx) xb_add(&bar[XB_TOPGEN], 1u);
            else XB_SPIN(xb_ld(&bar[XB_TOPGEN]) == tg, bar);
            __builtin_amdgcn_fence(__ATOMIC_ACQUIRE, "agent");
            xb_add(&bar[XB_XGEN(b.x)], 1u);
            asm volatile("s_waitcnt vmcnt(0)" ::: "memory");
        } else {
            XB_SPIN(xb_ld(&bar[XB_XGEN(b.x)]) == gen, bar);
            __builtin_amdgcn_fence(__ATOMIC_ACQUIRE, "agent");
            asm volatile("s_waitcnt vmcnt(0)" ::: "memory");
        }
    }
    __syncthreads();
}
namespace pg8 {
#define PG8_LAS __attribute__((address_space(3)))
typedef unsigned short bf16_t;
typedef short bf16x8 __attribute__((ext_vector_type(8)));
typedef float f32x4 __attribute__((ext_vector_type(4)));
typedef unsigned u32x4 __attribute__((ext_vector_type(4)));
constexpr int BM = 256, BK = 64, HALF = 128, HTB = HALF * BK * 2  , STAGE_BYTES = 8 * HTB, NXCD = 8, WGM = 8;

__host__ __device__ __forceinline__ int lds_byte(int r, int c) { const int st = (r >> 4) * 2 + (c >> 5), rr = r & 15, cc = c & 31, ob = rr * 64 + cc * 2; return st * 1024 + (ob ^ (((ob >> 9) & 1) << 5)); }
__host__ __device__ __forceinline__ void stage_rc(int b, int& R, int& C) { const int st = b / 1024, sb = b % 1024, swz = sb ^ (((sb >> 9) & 1) << 5); R = (st >> 1) * 16 + swz / 64; C = (st & 1) * 32 + (swz % 64) / 2; }
__host__ __device__ __forceinline__ int perm32(int rho) { const int n = rho >> 4, i = rho & 15; return 8 * (i >> 2) + 4 * n + (i & 3); }

struct Unit { int pm, pn; };
struct Gemm { const bf16_t* A; const bf16_t* Bt; int M, N, K; };

struct StaticOrder {
    int nM, nN, nwg, G, c;
    __host__ __device__ void init(int M, int N, int G_, int c_) { nM = M / BM; nN = N / BM; nwg = nM * nN; G = G_; c = c_; }
    __host__ __device__ bool next(int i, Unit& u) const {
        const long L = (long)i * G + c; if (L >= nwg) return false;
        int wgid = (int)L; { const int q = nwg / NXCD, r = nwg % NXCD, xcd = wgid % NXCD, off = wgid / NXCD; wgid = (xcd < r ? xcd * (q + 1) : r * (q + 1) + (xcd - r) * q) + off; }
        const int nig = WGM * nN, gid = wgid / nig, fm = gid * WGM, gsz = (nM - fm) < WGM ? (nM - fm) : WGM;
        u.pm = fm + ((wgid % nig) % gsz); u.pn = (wgid % nig) / gsz; return true;
    }
    __device__ __forceinline__ void a_ready(const Unit&) const {}
    __device__ __forceinline__ void done(const Unit&) const {}
};
__device__ __forceinline__ unsigned cvt_pk_bf16(float lo, float hi) { unsigned r; asm volatile("v_cvt_pk_bf16_f32 %0, %1, %2" : "=v"(r) : "v"(lo), "v"(hi)); return r; }
template <class Epi, class Sched>
__device__ __forceinline__ void gemm_phase(PG8_LAS unsigned char* lds, const Gemm g, const Sched& S, const Epi& E) {
    const int tid = threadIdx.x, wid = __builtin_amdgcn_readfirstlane(tid >> 6), lane = tid & 63, wr = wid >> 2, wc = wid & 3, fr = lane & 15, fq = lane >> 4;
    const int K = g.K, nt = K / BK;
    unsigned voffA[2], voffB[2];
#pragma unroll
    for (int i = 0; i < 2; ++i) { int R, C; stage_rc(tid * 16 + i * 8192, R, C); const int Rb = Epi::PERM ? ((R & ~31) + perm32(R & 31)) : R;
        voffA[i] = (unsigned)(R * K + C) * 2u; voffB[i] = (unsigned)(Rb * K + C) * 2u; }
    const size_t kstep = (size_t)(BK * 2);
    const size_t hstep = (size_t)HALF * K * 2;
    const size_t tstep = 2 * hstep;
    const unsigned ldsw = (unsigned)wid * 1024u;
    const int aoff = lds_byte(wr * 64 + fr, fq * 8), boff = lds_byte(wc * 32 + fr, fq * 8);
#define PG8_SA(b, h) (((b) * 2 + (h)) * HTB)
#define PG8_SB(b, h) ((4 + (b) * 2 + (h)) * HTB)
#define PG8_STAGE(bufoff, gbase, voff) do { _Pragma("unroll") for (int _i = 0; _i < 2; ++_i) \
        __builtin_amdgcn_global_load_lds((const unsigned*)((const char*)(gbase) + (voff)[_i]), (PG8_LAS unsigned*)(lds + (bufoff) + ldsw + _i * 8192), 16, 0, 0); } while (0)
#define PG8_LDA(dst, b, h) do { _Pragma("unroll") for (int m = 0; m < 4; ++m) _Pragma("unroll") for (int k = 0; k < 2; ++k) dst[m][k] = *(const PG8_LAS bf16x8*)(lds + PG8_SA(b, h) + aoff + m * 2048 + k * 1024); } while (0)
#define PG8_LDB(dst, b, h) do { _Pragma("unroll") for (int n = 0; n < 2; ++n) _Pragma("unroll") for (int k = 0; k < 2; ++k) dst[n][k] = *(const PG8_LAS bf16x8*)(lds + PG8_SB(b, h) + boff + n * 2048 + k * 1024); } while (0)
#define PG8_MMA(ai, bj, At, Bt) do { __builtin_amdgcn_s_setprio(1); _Pragma("unroll") for (int m = 0; m < 4; ++m) _Pragma("unroll") for (int n = 0; n < 2; ++n) _Pragma("unroll") for (int k = 0; k < 2; ++k) \
        acc[ai][bj][m][n] = __builtin_amdgcn_mfma_f32_16x16x32_bf16(Bt[n][k], At[m][k], acc[ai][bj][m][n], 0, 0, 0); __builtin_amdgcn_s_setprio(0); } while (0)
#define PG8_WAIT_V(n) asm volatile("s_waitcnt vmcnt(" #n ")" ::: "memory")
#define PG8_WAIT_L(n) asm volatile("s_waitcnt lgkmcnt(" #n ")" ::: "memory")
#define PG8_BAR __builtin_amdgcn_s_barrier()
#define PG8_SCHED __builtin_amdgcn_sched_barrier(0)
    Unit cur, nxt; int ui = 0;
    if (!S.next(0, cur)) return;
    f32x4 acc[2][2][4][2];
#pragma unroll
    for (int a = 0; a < 2; ++a)
#pragma unroll
        for (int b = 0; b < 2; ++b)
#pragma unroll
            for (int m = 0; m < 4; ++m)
#pragma unroll
                for (int n = 0; n < 2; ++n) acc[a][b][m][n] = (f32x4){0.f, 0.f, 0.f, 0.f};
    bf16x8 At[4][2], B0[2][2], B1[2][2];
    const char* cA = (const char*)g.A + (size_t)cur.pm * tstep; const char* cB = (const char*)g.Bt + (size_t)cur.pn * tstep;
    S.a_ready(cur);
    PG8_STAGE(PG8_SB(0, 0), cB, voffB); PG8_STAGE(PG8_SA(0, 0), cA, voffA); PG8_STAGE(PG8_SB(0, 1), cB + hstep, voffB); PG8_STAGE(PG8_SA(0, 1), cA + hstep, voffA);
    if (wr == 1) PG8_BAR;
    PG8_WAIT_V(4); PG8_BAR;
    PG8_STAGE(PG8_SB(1, 0), cB + kstep, voffB); PG8_STAGE(PG8_SA(1, 0), cA + kstep, voffA); PG8_STAGE(PG8_SB(1, 1), cB + hstep + kstep, voffB);
    PG8_WAIT_V(6); PG8_BAR;
    for (;;) {
        const bool has_next = S.next(ui + 1, nxt);
        const char* nA = has_next ? (const char*)g.A + (size_t)nxt.pm * tstep : cA; const char* nB = has_next ? (const char*)g.Bt + (size_t)nxt.pn * tstep : cB;
        for (int t = 0; t < nt; t += 2) {
            const bool last = (t == nt - 2);
            const char* a1 = cA + (size_t)(t + 1) * kstep;
            const char* a2 = last ? nA : cA + (size_t)(t + 2) * kstep; const char* b2 = last ? nB : cB + (size_t)(t + 2) * kstep;
            const char* a3 = a2 + kstep; const char* b3 = b2 + kstep;
            if (last && has_next) S.a_ready(nxt);
            PG8_LDB(B0, 0, 0); PG8_SCHED; PG8_LDA(At, 0, 0); PG8_STAGE(PG8_SA(1, 1), a1 + hstep, voffA);
            PG8_WAIT_L(8); PG8_BAR; PG8_WAIT_L(0); PG8_MMA(0, 0, At, B0); PG8_BAR; PG8_SCHED;
            PG8_LDB(B1, 0, 1); PG8_STAGE(PG8_SB(0, 0), b2, voffB);
            PG8_BAR; PG8_WAIT_L(0); PG8_MMA(0, 1, At, B1); PG8_BAR;
            PG8_LDA(At, 0, 1); PG8_STAGE(PG8_SA(0, 0), a2, voffA);
            PG8_BAR; PG8_WAIT_L(0); PG8_MMA(1, 0, At, B0); PG8_BAR; PG8_SCHED;
            PG8_STAGE(PG8_SB(0, 1), b2 + hstep, voffB);
            PG8_WAIT_V(6); PG8_BAR; PG8_MMA(1, 1, At, B1); PG8_BAR;
            PG8_LDB(B0, 1, 0); PG8_SCHED; PG8_LDA(At, 1, 0); PG8_STAGE(PG8_SA(0, 1), a2 + hstep, voffA);
            PG8_WAIT_L(8); PG8_BAR; PG8_WAIT_L(0); PG8_MMA(0, 0, At, B0); PG8_BAR; PG8_SCHED;
            PG8_LDB(B1, 1, 1); PG8_STAGE(PG8_SB(1, 0), b3, voffB);
            PG8_BAR; PG8_WAIT_L(0); PG8_MMA(0, 1, At, B1); PG8_BAR;
            PG8_LDA(At, 1, 1); PG8_STAGE(PG8_SA(1, 0), a3, voffA);
            PG8_BAR; PG8_WAIT_L(0); PG8_MMA(1, 0, At, B0); PG8_BAR; PG8_SCHED;
            PG8_STAGE(PG8_SB(1, 1), b3 + hstep, voffB);
            PG8_WAIT_V(6); PG8_BAR; PG8_MMA(1, 1, At, B1); PG8_BAR;
        }
        if constexpr (!Epi::AFTER_DRAIN) { E(acc, cur, wr, wc, fr, fq); S.done(cur); }
        if (!has_next) break;
#pragma unroll
        for (int a = 0; a < 2; ++a)
#pragma unroll
            for (int b = 0; b < 2; ++b)
#pragma unroll
                for (int m = 0; m < 4; ++m)
#pragma unroll
                    for (int n = 0; n < 2; ++n) acc[a][b][m][n] = (f32x4){0.f, 0.f, 0.f, 0.f};
        cur = nxt; cA = nA; cB = nB; ++ui;
    }
    PG8_WAIT_V(0);
    if (wr == 0) PG8_BAR;
    PG8_BAR;
    if constexpr (Epi::AFTER_DRAIN) { E.fused(acc, cur, wr, wc, fr, fq, lds, wid, lane); S.done(cur); }
#undef PG8_SA
#undef PG8_SB
#undef PG8_STAGE
#undef PG8_LDA
#undef PG8_LDB
#undef PG8_MMA
#undef PG8_WAIT_V
#undef PG8_WAIT_L
#undef PG8_BAR
#undef PG8_SCHED
}
}
__device__ __forceinline__ float row_rinv(const GAS float* ss, int row) {
    const GAS f32x4* p = (const GAS f32x4*)(ss + (size_t)row * 16);
    const f32x4 a = p[0], b = p[1], c = p[2], d = p[3];
    const float s = ((a[0] + a[1]) + (a[2] + a[3])) + ((b[0] + b[1]) + (b[2] + b[3])) + ((c[0] + c[1]) + (c[2] + c[3])) + ((d[0] + d[1]) + (d[2] + d[3]));
    return 1.0f / sqrtf(s * (1.0f / 1024.0f) + RMS_EPS);
}
struct EpiScale {
    static constexpr bool PERM = true, AFTER_DRAIN = false;
    GAS bf16_t* O0; int ld0; int split; GAS bf16_t* O1; int ld1; const GAS float* ss; GAS bf16_t* vT;
    __device__ __forceinline__ void operator()(const f32x4 (&acc)[2][2][4][2], const pg8::Unit& u, int wr, int wc, int fr, int fq) const {
        const int row0 = u.pm * 256 + wr * 64 + fr; const int colt = u.pn * 256;
        GAS bf16_t* base; int ldc, c0;
        if (colt < split) { base = O0; ldc = ld0; c0 = colt; } else { base = O1; ldc = ld1; c0 = colt - split; }
        const int col0 = c0 + wc * 32 + 8 * fq;
        const bool dovt = (vT != nullptr) && (colt == 256);
#pragma unroll
        for (int ai = 0; ai < 2; ++ai)
#pragma unroll
            for (int m = 0; m < 4; ++m) {
                const int row = row0 + ai * 128 + m * 16;
                const float ri = row_rinv(ss, row);
                GAS bf16_t* rowp = base + (size_t)row * ldc + col0;
#pragma unroll
                for (int bj = 0; bj < 2; ++bj) {
                    const f32x4 v0 = acc[ai][bj][m][0] * ri, v1 = acc[ai][bj][m][1] * ri;
                    u32x4 w; w.x = pk2(v0[0], v0[1]); w.y = pk2(v0[2], v0[3]); w.z = pk2(v1[0], v1[1]); w.w = pk2(v1[2], v1[3]);
                    *(GAS u32x4*)(rowp + bj * 128) = w;
                    if (dovt) {
                        const int b = row / TP, t = row - b * TP;
                        GAS bf16_t* vp = vT + ((size_t)(b * 2 + bj) * 128 + wc * 32 + 8 * fq) * TP + t;
                        vp[0 * TP] = (bf16_t)(w.x & 0xffff); vp[1 * TP] = (bf16_t)(w.x >> 16); vp[2 * TP] = (bf16_t)(w.y & 0xffff); vp[3 * TP] = (bf16_t)(w.y >> 16);
                        vp[4 * TP] = (bf16_t)(w.z & 0xffff); vp[5 * TP] = (bf16_t)(w.z >> 16); vp[6 * TP] = (bf16_t)(w.w & 0xffff); vp[7 * TP] = (bf16_t)(w.w >> 16);
                    }
                }
            }
    }
};
struct EpiResid {
    static constexpr bool PERM = false, AFTER_DRAIN = false;
    GAS float* H; GAS bf16_t* HB; GAS float* ss;
    __device__ __forceinline__ void operator()(const f32x4 (&acc)[2][2][4][2], const pg8::Unit& u, int wr, int wc, int fr, int fq) const {
        const int row0 = u.pm * 256 + wr * 64 + fr, col0 = u.pn * 256 + wc * 32 + 4 * fq;
#pragma unroll
        for (int ai = 0; ai < 2; ++ai)
#pragma unroll
            for (int m = 0; m < 4; ++m) {
                const int row = row0 + ai * 128 + m * 16; float s = 0.f;
                GAS float* hp = H + (size_t)row * 1024 + col0; GAS bf16_t* bp = HB + (size_t)row * 1024 + col0;
#pragma unroll
                for (int bj = 0; bj < 2; ++bj)
#pragma unroll
                    for (int n = 0; n < 2; ++n) {
                        f32x4 hv = *(GAS f32x4*)(hp + bj * 128 + n * 16) + acc[ai][bj][m][n];
                        *(GAS f32x4*)(hp + bj * 128 + n * 16) = hv;
                        s += (hv[0] * hv[0] + hv[1] * hv[1]) + (hv[2] * hv[2] + hv[3] * hv[3]);
                        u32x2 w; w.x = pk2(hv[0], hv[1]); w.y = pk2(hv[2], hv[3]);
                        *(GAS u32x2*)(bp + bj * 128 + n * 16) = w;
                    }
                s += __shfl_xor(s, 16); s += __shfl_xor(s, 32);
                if (fq == 0) ss[(size_t)row * 16 + u.pn * 4 + wc] = s;
            }
    }
};

struct Args {
    const float* in[17]; float* out; unsigned char* ws;
    double inv32[16]; double inv16[8];
};
struct Frame {
    LAS unsigned char* lds; GAS unsigned char* ws; int tid, lane, wave, G, gw, NGW;
};

__device__ __forceinline__ void p0_transpose_item(const float* W, int N, const float* gain, GAS bf16_t* WT, LAS float* scr, int item, int lane, int nblk) {
    const int kb = item / nblk, nb = item - kb * nblk, k0 = 64 * kb, n0 = 32 * nb;
    const int n = n0 + (lane & 31);
#pragma unroll 8
    for (int i = 0; i < 32; ++i) { const int kk = 2 * i + (lane >> 5); float v = 0.f; if (n < N) { v = W[(size_t)(k0 + kk) * N + n]; if (gain) v *= gain[k0 + kk]; } scr[kk * 33 + (lane & 31)] = v; }
    asm volatile("s_waitcnt lgkmcnt(0)" ::: "memory");
    const int c = lane & 7;
#pragma unroll
    for (int j = 0; j < 4; ++j) { const int nn = (lane >> 3) + 8 * j; const LAS float* s = scr + (8 * c) * 33 + nn;
        u32x4 o; o.x = pk2(s[0 * 33], s[1 * 33]); o.y = pk2(s[2 * 33], s[3 * 33]); o.z = pk2(s[4 * 33], s[5 * 33]); o.w = pk2(s[6 * 33], s[7 * 33]);
        *(GAS u32x4*)(WT + (size_t)(n0 + nn) * 1024 + k0 + 8 * c) = o; }
    asm volatile("s_waitcnt lgkmcnt(0)" ::: "memory");
}
__device__ __forceinline__ void sincos_rev(double ang, float& c, float& s) {
    double rev = ang * 0.15915494309189533577; rev -= rint(rev);
    const double r = rev * 6.28318530717958647692, r2 = r * r;
    double ts = r, ss = r, tc = 1.0, cc = 1.0;
#pragma unroll
    for (int k = 1; k <= 13; ++k) { tc *= -r2 / (double)((2 * k - 1) * (2 * k)); cc += tc; ts *= -r2 / (double)((2 * k) * (2 * k + 1)); ss += ts; }
    c = (float)cc; s = (float)ss;
}
__device__ __forceinline__ void phase_prologue(const Frame& F, const Args& a) {
    GAS unsigned char* ws = F.ws;
    {
        LAS float* scr = (LAS float*)(F.lds + F.wave * 8704);
        const float* a_norm = a.in[2]; const float* a_w_in = a.in[3]; const float* a_w_o = a.in[6]; const float* kv_norm = a.in[7]; const float* kv_w = a.in[8];
        const float* b_norm = a.in[9]; const float* b_w_q = a.in[10]; const float* b_w_o = a.in[11]; const float* ffn_norm = a.in[12]; const float* peer_w_q = a.in[13];
        constexpr int I2048 = 16 * 64, I1024 = 16 * 32, I512 = 16 * 16;
        constexpr int NITEMS = 2 * I2048 + 2 * I1024 + I512 + I1024 + I1024 + 2 * I1024 + 4 * I2048;
        for (int it = F.gw; it < NITEMS; it += F.NGW) {
            int r = it;
            if (r < 2 * I2048) { const int l = r / I2048; r -= l * I2048; p0_transpose_item(a_w_in + (size_t)l * 1024 * ACOLS, ACOLS, a_norm + l * 1024, (GAS bf16_t*)(ws + WS_WIN) + (size_t)l * 2048 * 1024, scr, r, F.lane, 64); continue; } r -= 2 * I2048;
            if (r < 2 * I1024) { const int l = r / I1024; r -= l * I1024; p0_transpose_item(a_w_o + (size_t)l * 1024 * 1024, 1024, nullptr, (GAS bf16_t*)(ws + WS_WOA) + (size_t)l * 1024 * 1024, scr, r, F.lane, 32); continue; } r -= 2 * I1024;
            if (r < I512) { p0_transpose_item(kv_w, 512, kv_norm, (GAS bf16_t*)(ws + WS_WKVQ), scr, r, F.lane, 16); continue; } r -= I512;
            if (r < I1024) { p0_transpose_item(b_w_q, 1024, b_norm, (GAS bf16_t*)(ws + WS_WKVQ) + (size_t)512 * 1024, scr, r, F.lane, 32); continue; } r -= I1024;
            if (r < I1024) { p0_transpose_item(b_w_q + (size_t)1024 * 1024, 1024, b_norm + 1024, (GAS bf16_t*)(ws + WS_WBQ1), scr, r, F.lane, 32); continue; } r -= I1024;
            if (r < 2 * I1024) { const int l = r / I1024; r -= l * I1024; p0_transpose_item(b_w_o + (size_t)l * 1024 * 1024, 1024, nullptr, (GAS bf16_t*)(ws + WS_WOB) + (size_t)l * 1024 * 1024, scr, r, F.lane, 32); continue; } r -= 2 * I1024;
            { const int l = r / I2048; r -= l * I2048; p0_transpose_item(peer_w_q + (size_t)l * 1024 * 2048, 2048, ffn_norm + l * 1024, (GAS bf16_t*)(ws + WS_WPQ) + (size_t)l * 2048 * 1024, scr, r, F.lane, 64); }
        }
    }
    const size_t gtid = (size_t)blockIdx.x * NT + F.tid, gthreads = (size_t)F.G * NT;
    {
        const float* pu = a.in[15]; const float* pv = a.in[16]; const float* ffn_norm = a.in[12];
        GAS bf16_t* U = (GAS bf16_t*)(ws + WS_U); GAS bf16_t* V = (GAS bf16_t*)(ws + WS_V);
        const size_t n8 = (size_t)4 * NEXP * 1024 / 8;
        for (size_t i = gtid; i < n8; i += gthreads) {
            const size_t e0 = i * 8; const int l = (int)(e0 / ((size_t)NEXP * 1024)); const int d = (int)(e0 & 1023);
            const f32x4 g0 = *(const f32x4*)(ffn_norm + l * 1024 + d), g1 = *(const f32x4*)(ffn_norm + l * 1024 + d + 4);
            const f32x4 u0 = __builtin_nontemporal_load((const f32x4*)(pu + e0)) * g0, u1 = __builtin_nontemporal_load((const f32x4*)(pu + e0 + 4)) * g1;
            u32x4 w; w.x = pk2(u0[0], u0[1]); w.y = pk2(u0[2], u0[3]); w.z = pk2(u1[0], u1[1]); w.w = pk2(u1[2], u1[3]);
            *(GAS u32x4*)(U + e0) = w;
            const f32x4 v0 = __builtin_nontemporal_load((const f32x4*)(pv + e0)), v1 = __builtin_nontemporal_load((const f32x4*)(pv + e0 + 4));
            w.x = pk2(v0[0], v0[1]); w.y = pk2(v0[2], v0[3]); w.z = pk2(v1[0], v1[1]); w.w = pk2(v1[2], v1[3]);
            *(GAS u32x4*)(V + e0) = w;
        }
    }
    { const float* sk = a.in[14]; GAS bf16_t* o = (GAS bf16_t*)(ws + WS_SK); for (size_t i = gtid; i < (size_t)4 * 2 * 128 * 128; i += gthreads) o[i] = (bf16_t)f2bf(sk[i]); }
    {
        GAS f32x2* r32 = (GAS f32x2*)(ws + WS_ROPE32); GAS f32x2* r16 = (GAS f32x2*)(ws + WS_ROPE16);
        for (size_t i = gtid; i < (size_t)TP * 24; i += gthreads) {
            const int t = (int)(i / 24), j = (int)(i - (size_t)t * 24); float c, s;
            if (j < 16) { sincos_rev((double)t * a.inv32[j], c, s); r32[t * 16 + j] = (f32x2){c, s}; }
            else { sincos_rev((double)t * a.inv16[j - 16], c, s); r16[t * 8 + (j - 16)] = (f32x2){c, s}; }
        }
    }
    {
        const float* x = a.in[0]; const float* meta = a.in[1];
        GAS float* H = (GAS float*)(ws + WS_H); GAS bf16_t* HB = (GAS bf16_t*)(ws + WS_HB); GAS float* SS = (GAS float*)(ws + WS_SS); GAS bf16_t* O = (GAS bf16_t*)(ws + WS_O);
        for (int row = F.gw; row < NR; row += F.NGW) {
            const int b = row / TP, t = row - b * TP;
            f32x4 v[4]; float s = 0.f;
#pragma unroll
            for (int j = 0; j < 4; ++j) {
                if (t < NMETA) v[j] = *(const f32x4*)(meta + (size_t)t * 1024 + 256 * j + 4 * F.lane);
                else if (t < TT) v[j] = *(const f32x4*)(x + ((size_t)b * SEQ + (t - NMETA)) * 1024 + 256 * j + 4 * F.lane);
                else v[j] = (f32x4){0.f, 0.f, 0.f, 0.f};
                s += (v[j][0] * v[j][0] + v[j][1] * v[j][1]) + (v[j][2] * v[j][2] + v[j][3] * v[j][3]);
            }
            s = wave_sum(s);
#pragma unroll
            for (int j = 0; j < 4; ++j) {
                *(GAS f32x4*)(H + (size_t)row * 1024 + 256 * j + 4 * F.lane) = v[j];
                u32x2 w; w.x = pk2(v[j][0], v[j][1]); w.y = pk2(v[j][2], v[j][3]);
                *(GAS u32x2*)(HB + (size_t)row * 1024 + 256 * j + 4 * F.lane) = w;
                if (t >= TT) *(GAS u32x2*)(O + (size_t)row * 1024 + 256 * j + 4 * F.lane) = (u32x2){0u, 0u};
            }
            if (F.lane < 16) SS[(size_t)row * 16 + F.lane] = (F.lane == 0) ? s : 0.f;
        }
    }
}
__device__ __forceinline__ void phase_a_post(const Frame& F, const float* qgain, const float* kgain) {
    GAS unsigned char* ws = F.ws;
    const GAS bf16_t* PROJ = (const GAS bf16_t*)(ws + WS_PROJ);
    GAS bf16_t* Q = (GAS bf16_t*)(ws + WS_Q); GAS bf16_t* KVA = (GAS bf16_t*)(ws + WS_KVA); GAS bf16_t* QI = (GAS bf16_t*)(ws + WS_QI); GAS bf16_t* KI = (GAS bf16_t*)(ws + WS_KI); GAS float* WI = (GAS float*)(ws + WS_WI);
    const GAS f32x2* r32 = (const GAS f32x2*)(ws + WS_ROPE32); const GAS f32x2* r16 = (const GAS f32x2*)(ws + WS_ROPE16);
    const int lane = F.lane;
    const float qg0 = qgain[lane], qg1 = qgain[64 + lane], kg0 = kgain[lane], kg1 = kgain[64 + lane];
    for (int row = F.gw; row < NR; row += F.NGW) {
        const int b = row / TP, t = row - b * TP;
        const GAS bf16_t* pr = PROJ + (size_t)row * 2048;
        const f32x2 cs32 = r32[t * 16 + (lane & 15)], cs16 = r16[t * 8 + (lane & 7)];
#pragma unroll
        for (int nh = 0; nh < 10; ++nh) {
            const float x0 = bf2f(pr[nh * 128 + lane]), x1 = bf2f(pr[nh * 128 + 64 + lane]);
            const float ssq = wave_sum(x0 * x0 + x1 * x1);
            const float ri = 1.0f / sqrtf(ssq * (1.0f / 128.0f) + RMS_EPS);
            float y0 = x0 * ri * (nh < 8 ? qg0 : kg0), y1 = x1 * ri * (nh < 8 ? qg1 : kg1);
            const float p = __shfl_xor(y0, 16);
            if (lane < 16) y0 = y0 * cs32.x - p * cs32.y; else if (lane < 32) y0 = y0 * cs32.x + p * cs32.y;
            if (nh < 8) { y0 *= 0.08838834764831845f; y1 *= 0.08838834764831845f; Q[(size_t)row * 1024 + nh * 128 + lane] = (bf16_t)f2bf(y0); Q[(size_t)row * 1024 + nh * 128 + 64 + lane] = (bf16_t)f2bf(y1); }
            else { KVA[(size_t)row * 512 + (nh - 8) * 128 + lane] = (bf16_t)f2bf(y0); KVA[(size_t)row * 512 + (nh - 8) * 128 + 64 + lane] = (bf16_t)f2bf(y1); }
        }
        *(GAS u32x2*)(KVA + (size_t)row * 512 + 256 + 4 * lane) = *(const GAS u32x2*)(pr + 1280 + 4 * lane);
#pragma unroll
        for (int hh = 0; hh < 5; ++hh) {
            float xv = bf2f(pr[1536 + hh * 64 + lane]);
            const float p = __shfl_xor(xv, 8);
            if (lane < 8) xv = xv * cs16.x - p * cs16.y; else if (lane < 16) xv = xv * cs16.x + p * cs16.y;
            if (hh < 4) QI[(size_t)row * 256 + hh * 64 + lane] = (bf16_t)f2bf(xv * 0.125f); else KI[(size_t)row * 64 + lane] = (bf16_t)f2bf(xv);
        }
        if (lane < 4) WI[(size_t)row * 4 + lane] = bf2f(pr[1856 + lane]) * 0.5f;
    }
}

constexpr int SCS = 4232;
constexpr int DSA_SC = 0, DSA_HIST = 8 * SCS * 4, DSA_SEL = DSA_HIST + 8 * 256 * 4;
__device__ __forceinline__ int wave_incl_scan(int v, int lane) {
#pragma unroll
    for (int o = 1; o < 64; o <<= 1) { const int t = __shfl_up(v, o); if (lane >= o) v += t; }
    return v;
}
__device__ __forceinline__ void phase_dsa(const Frame& F) {
    GAS unsigned char* ws = F.ws;
    const GAS bf16_t* Q = (const GAS bf16_t*)(ws + WS_Q); const GAS bf16_t* KVA = (const GAS bf16_t*)(ws + WS_KVA); const GAS bf16_t* QI = (const GAS bf16_t*)(ws + WS_QI);
    const GAS bf16_t* KI = (const GAS bf16_t*)(ws + WS_KI); const GAS float* WI = (const GAS float*)(ws + WS_WI); GAS bf16_t* O = (GAS bf16_t*)(ws + WS_O);
    LAS unsigned* SC = (LAS unsigned*)(F.lds + DSA_SC); LAS unsigned* HIST = (LAS unsigned*)(F.lds + DSA_HIST) + F.wave * 256; LAS unsigned* SEL = (LAS unsigned*)(F.lds + DSA_SEL) + F.wave * 256;
    const int lane = F.lane, wave = F.wave, r = lane & 15, g = lane >> 4;
    const unsigned long long ltmask = (1ull << lane) - 1ull;
    for (int it = blockIdx.x; it < BATCH * (TT / 8); it += F.G) {
        const int b = it & 3, qb = it >> 2, t0 = qb * 8, nkeys = t0 + 8;
        const size_t rb = (size_t)b * TP;
        {
            bf16x8 A[2][2]; f32x4 wv[2];
#pragma unroll
            for (int mt = 0; mt < 2; ++mt) {
                const GAS bf16_t* qp = QI + (rb + t0 + 4 * mt + (r >> 2)) * 256 + (r & 3) * 64 + 8 * g;
                A[mt][0] = *(const GAS bf16x8*)qp; A[mt][1] = *(const GAS bf16x8*)(qp + 32);
                wv[mt] = *(const GAS f32x4*)(WI + (rb + t0 + 4 * mt + g) * 4);
            }
            const int ntile = (nkeys + 15) >> 4;
            for (int kt = wave; kt < ntile; kt += 8) {
                const GAS bf16_t* kp = KI + (rb + kt * 16 + r) * 64 + 8 * g;
                const bf16x8 B0 = *(const GAS bf16x8*)kp, B1 = *(const GAS bf16x8*)(kp + 32);
                const int key = kt * 16 + r;
#pragma unroll
                for (int mt = 0; mt < 2; ++mt) {
                    f32x4 d = (f32x4){0.f, 0.f, 0.f, 0.f};
                    d = MFMA16(A[mt][0], B0, d); d = MFMA16(A[mt][1], B1, d);
                    float s = fmaxf(d[0], 0.f) * wv[mt][0] + fmaxf(d[1], 0.f) * wv[mt][1] + fmaxf(d[2], 0.f) * wv[mt][2] + fmaxf(d[3], 0.f) * wv[mt][3];
                    if (s == 0.f) s = 0.f;
                    const int qpos = t0 + 4 * mt + g;
                    SC[(4 * mt + g) * SCS + key] = (key <= qpos) ? mono_key(s) : 0u;
                }
            }
        }
        __syncthreads();
        const int qpos = t0 + wave, n = qpos + 1;
        LAS unsigned* row = SC + wave * SCS;
        int cnt;
        if (n <= TOPK) { for (int i = lane; i < n; i += 64) SEL[i] = (unsigned)i; cnt = n; }
        else {
            unsigned prefix = 0u, mask = 0u; int want = TOPK;
            for (int pass = 3; pass >= 0; --pass) {
                const int sh = pass * 8;
#pragma unroll
                for (int i = 0; i < 4; ++i) HIST[lane + 64 * i] = 0u;
                for (int i = lane; i < n; i += 64) { const unsigned k = row[i]; if ((k & mask) == prefix) __hip_atomic_fetch_add(&HIST[(k >> sh) & 255u], 1u, __ATOMIC_RELAXED, __HIP_MEMORY_SCOPE_WORKGROUP); }
                asm volatile("s_waitcnt lgkmcnt(0)" ::: "memory");
                const int h0 = (int)HIST[255 - 4 * lane], h1 = (int)HIST[254 - 4 * lane], h2 = (int)HIST[253 - 4 * lane], h3 = (int)HIST[252 - 4 * lane];
                const int local = h0 + h1 + h2 + h3, incl = wave_incl_scan(local, lane), excl = incl - local;
                const bool here = (excl < want) && (want <= incl);
                int bin = 0, above = 0;
                if (here) { int c = excl;
                    if (c + h0 >= want) { bin = 255 - 4 * lane; above = c; } else { c += h0;
                    if (c + h1 >= want) { bin = 254 - 4 * lane; above = c; } else { c += h1;
                    if (c + h2 >= want) { bin = 253 - 4 * lane; above = c; } else { c += h2; bin = 252 - 4 * lane; above = c; } } } }
                const unsigned long long bm = __ballot(here);
                const int src = (int)__builtin_ctzll(bm);
                bin = __shfl(bin, src); above = __shfl(above, src);
                want -= above; prefix |= (unsigned)bin << sh; mask |= 0xFFu << sh;
            }
            const unsigned T = prefix; const int need = want;
            int outbase = 0, eqbase = 0;
            for (int i0 = 0; i0 < n; i0 += 64) {
                const int i = i0 + lane; const bool in = i < n; const unsigned k = in ? row[i] : 0u;
                const bool gt = in && (k > T), eq = in && (k == T);
                const unsigned long long beq = __ballot(eq);
                const int eqrank = eqbase + __popcll(beq & ltmask);
                const bool take = gt || (eq && eqrank < need);
                const unsigned long long bt = __ballot(take);
                const int pos = outbase + __popcll(bt & ltmask);
                if (take && pos < TOPK) SEL[pos] = (unsigned)i;
                outbase += __popcll(bt); eqbase += __popcll(beq);
            }
            cnt = TOPK;
        }
        asm volatile("s_waitcnt lgkmcnt(0)" ::: "memory");
        LAS float* Pb = (LAS float*)row;
        const size_t qrow = rb + qpos;
#pragma unroll 1
        for (int kvh = 0; kvh < 2; ++kvh) {
            bf16x8 Aq[4];
            {
                const GAS bf16_t* qp = Q + qrow * 1024 + (kvh * 4 + (r & 3)) * 128 + g * 32;
#pragma unroll
                for (int ks = 0; ks < 4; ++ks) { bf16x8 v = *(const GAS bf16x8*)(qp + ks * 8); if (r >= 4) v = (bf16x8){0, 0, 0, 0, 0, 0, 0, 0}; Aq[ks] = v; }
            }
            float s[16][4];
#pragma unroll
            for (int tile = 0; tile < 16; ++tile) {
                const int kk = tile * 16 + r; const bool valid = kk < cnt; const int key = valid ? (int)SEL[kk] : 0;
                const GAS bf16_t* kp = KVA + (rb + key) * 512 + kvh * 128 + g * 32;
                f32x4 d = (f32x4){0.f, 0.f, 0.f, 0.f};
#pragma unroll
                for (int ks = 0; ks < 4; ++ks) d = MFMA16(Aq[ks], *(const GAS bf16x8*)(kp + ks * 8), d);
#pragma unroll
                for (int i = 0; i < 4; ++i) s[tile][i] = valid ? d[i] : -INFINITY;
            }
            float mx[4], sm[4];
#pragma unroll
            for (int i = 0; i < 4; ++i) { float m = s[0][i];
#pragma unroll
                for (int tile = 1; tile < 16; ++tile) m = fmaxf(m, s[tile][i]);
                m = fmaxf(m, __shfl_xor(m, 1)); m = fmaxf(m, __shfl_xor(m, 2)); m = fmaxf(m, __shfl_xor(m, 4)); m = fmaxf(m, __shfl_xor(m, 8)); mx[i] = m; sm[i] = 0.f; }
#pragma unroll
            for (int tile = 0; tile < 16; ++tile)
#pragma unroll
                for (int i = 0; i < 4; ++i) { const float e = __expf(s[tile][i] - mx[i]); s[tile][i] = e; sm[i] += e; }
#pragma unroll
            for (int i = 0; i < 4; ++i) { float t = sm[i]; t += __shfl_xor(t, 1); t += __shfl_xor(t, 2); t += __shfl_xor(t, 4); t += __shfl_xor(t, 8); sm[i] = 1.0f / t; }
            if (g == 0) {
#pragma unroll
                for (int tile = 0; tile < 16; ++tile) *(LAS f32x4*)(Pb + (tile * 16 + r) * 4) = (f32x4){s[tile][0] * sm[0], s[tile][1] * sm[1], s[tile][2] * sm[2], s[tile][3] * sm[3]};
            }
            asm volatile("s_waitcnt lgkmcnt(0)" ::: "memory");
            float acc[4][2];
#pragma unroll
            for (int i = 0; i < 4; ++i) { acc[i][0] = 0.f; acc[i][1] = 0.f; }
            const GAS bf16_t* vbase = KVA + rb * 512 + 256 + kvh * 128 + 2 * lane;
#pragma unroll 4
            for (int kk = 0; kk < cnt; ++kk) {
                const int key = (int)SEL[kk]; const f32x4 p = *(const LAS f32x4*)(Pb + kk * 4);
                const unsigned vv = *(const GAS unsigned*)(vbase + (size_t)key * 512);
                const float v0 = bflo(vv), v1 = bfhi(vv);
#pragma unroll
                for (int i = 0; i < 4; ++i) { acc[i][0] += p[i] * v0; acc[i][1] += p[i] * v1; }
            }
#pragma unroll
            for (int i = 0; i < 4; ++i) *(GAS unsigned*)(O + qrow * 1024 + (kvh * 4 + i) * 128 + 2 * lane) = pk2(acc[i][0], acc[i][1]);
            asm volatile("s_waitcnt lgkmcnt(0)" ::: "memory");
        }
        __syncthreads();
    }
}

__device__ __forceinline__ float softplus_f(float z) { return fmaxf(z, 0.f) + __logf(1.0f + __expf(-fabsf(z))); }
__device__ __forceinline__ void phase_stick(const Frame& F) {
    GAS unsigned char* ws = F.ws;
    const GAS bf16_t* BQ = (const GAS bf16_t*)(ws + WS_Q); const GAS bf16_t* SKV = (const GAS bf16_t*)(ws + WS_SKV); const GAS bf16_t* VT = (const GAS bf16_t*)(ws + WS_VT); GAS bf16_t* O = (GAS bf16_t*)(ws + WS_O);
    const int lane = F.lane, r = lane & 15, g = lane >> 4;
    constexpr int NQT = TT / 16;
    for (int it = F.gw; it < BATCH * 8 * NQT; it += F.NGW) {
        const int qt = it % NQT, hb = it / NQT, head = hb & 7, b = hb >> 3, kvh = head >> 2, t0 = qt * 16;
        const size_t rb = (size_t)b * TP;
        bf16x8 Bq[4];
        { const GAS bf16_t* qp = BQ + (rb + t0 + r) * 1024 + head * 128 + 8 * g;
#pragma unroll
          for (int ks = 0; ks < 4; ++ks) Bq[ks] = *(const GAS bf16x8*)(qp + ks * 32); }
        f32x4 Oa[8];
#pragma unroll
        for (int dt = 0; dt < 8; ++dt) Oa[dt] = (f32x4){0.f, 0.f, 0.f, 0.f};
        float carry = 0.f;
        const int qpos = t0 + r;
        const GAS bf16_t* vtb = VT + ((size_t)(b * 2 + kvh) * 128) * TP;
        for (int kb = t0; kb >= 0; kb -= 32) {
            float a_hi[4], a_lo[4];
            float zz[2][4], sp[2][4], tot[2];
#pragma unroll
            for (int tl = 0; tl < 2; ++tl) {
                const int kbase = kb - 16 * tl; int krow = kbase + r; krow = krow < 0 ? 0 : krow;
                const GAS bf16_t* kp = SKV + (rb + krow) * 512 + kvh * 128 + 8 * g;
                f32x4 z = (f32x4){0.f, 0.f, 0.f, 0.f};
#pragma unroll
                for (int ks = 0; ks < 4; ++ks) z = MFMA16(*(const GAS bf16x8*)(kp + ks * 32), Bq[ks], z);
                float gsum = 0.f;
#pragma unroll
                for (int i = 0; i < 4; ++i) { const int key = kbase + 4 * g + i; const bool valid = (key >= 0) && (key < qpos);
                    const float zv = z[i] * 0.08838834764831845f; zz[tl][i] = zv; const float s_ = valid ? softplus_f(zv) : 0.f; sp[tl][i] = s_; gsum += s_; }
                const float g0 = __shfl(gsum, r), g1 = __shfl(gsum, r + 16), g2 = __shfl(gsum, r + 32), g3 = __shfl(gsum, r + 48);
                tot[tl] = (g0 + g1) + (g2 + g3);
                float above = (g < 3 ? g3 : 0.f) + (g < 2 ? g2 : 0.f) + (g < 1 ? g1 : 0.f);
                float c3 = above + sp[tl][3], c2 = c3 + sp[tl][2], c1 = c2 + sp[tl][1], c0 = c1 + sp[tl][0];
                sp[tl][3] = c3; sp[tl][2] = c2; sp[tl][1] = c1; sp[tl][0] = c0;
            }
#pragma unroll
            for (int i = 0; i < 4; ++i) {
                const int khi = kb + 4 * g + i, klo = kb - 16 + 4 * g + i;
                a_hi[i] = (khi < qpos) ? __expf(zz[0][i] - (carry + sp[0][i])) : 0.f;
                a_lo[i] = (klo >= 0 && klo < qpos) ? __expf(zz[1][i] - (carry + tot[0] + sp[1][i])) : 0.f;
            }
            carry += tot[0] + tot[1];
            bf16x8 Pb;
            { const unsigned w0 = pk2(a_hi[0], a_hi[1]), w1 = pk2(a_hi[2], a_hi[3]), w2 = pk2(a_lo[0], a_lo[1]), w3 = pk2(a_lo[2], a_lo[3]);
              const u32x4 w = (u32x4){w0, w1, w2, w3}; Pb = __builtin_bit_cast(bf16x8, w); }
            const int tlo = (kb - 16) < 0 ? kb : (kb - 16);
#pragma unroll
            for (int dt = 0; dt < 8; ++dt) {
                const GAS bf16_t* vp = vtb + (size_t)(dt * 16 + r) * TP;
                const u32x2 vh = *(const GAS u32x2*)(vp + kb + 4 * g), vl = *(const GAS u32x2*)(vp + tlo + 4 * g);
                const u32x4 w = (u32x4){vh.x, vh.y, vl.x, vl.y};
                Oa[dt] = MFMA16(__builtin_bit_cast(bf16x8, w), Pb, Oa[dt]);
            }
            if (__all(carry > 104.0f)) break;
        }
        GAS bf16_t* op = O + (rb + t0 + r) * 1024 + head * 128 + 4 * g;
#pragma unroll
        for (int dt = 0; dt < 8; ++dt) { u32x2 w; w.x = pk2(Oa[dt][0], Oa[dt][1]); w.y = pk2(Oa[dt][2], Oa[dt][3]); *(GAS u32x2*)(op + dt * 16) = w; }
    }
}
constexpr int SCPS = 129;
constexpr int PE_SC = 0, PE_TOP = 16 * 16 * SCPS * 4  , PE_ROUTE_ID = 0, PE_ROUTE_G = 16 * 128 * 4;
__device__ __forceinline__ float gelu_erf(float v) { return 0.5f * v * (1.0f + erff(v * 0.70710678118654752f)); }
__device__ __forceinline__ void phase_peer(const Frame& F, int layer, float* dout) {
    GAS unsigned char* ws = F.ws;
    const GAS bf16_t* PQ = (const GAS bf16_t*)(ws + WS_PROJ); const GAS bf16_t* SK = (const GAS bf16_t*)(ws + WS_SK) + (size_t)layer * 2 * 128 * 128;
    const GAS bf16_t* U = (const GAS bf16_t*)(ws + WS_U) + (size_t)layer * NEXP * 1024; const GAS bf16_t* V = (const GAS bf16_t*)(ws + WS_V) + (size_t)layer * NEXP * 1024;
    GAS float* H = (GAS float*)(ws + WS_H); GAS bf16_t* HB = (GAS bf16_t*)(ws + WS_HB); GAS float* SS = (GAS float*)(ws + WS_SS);
    LAS float* SCP = (LAS float*)(F.lds + PE_SC); LAS unsigned* TOPL = (LAS unsigned*)(F.lds + PE_TOP);
    LAS unsigned* RID = (LAS unsigned*)(F.lds + PE_ROUTE_ID); LAS float* RG = (LAS float*)(F.lds + PE_ROUTE_G);
    const int lane = F.lane, wave = F.wave, tid = F.tid, r = lane & 15, g = lane >> 4;
    constexpr int NIT = BATCH * (TT / 16);
    for (int it = blockIdx.x; it < NIT; it += F.G) {
        const int b = it / (TT / 16), tb = it - b * (TT / 16);
        const size_t row0 = (size_t)b * TP + tb * 16;
        {
            const int h = wave;
#pragma unroll 1
            for (int c = 0; c < 2; ++c) {
                bf16x8 A[4];
                const GAS bf16_t* ap = PQ + (row0 + r) * 2048 + h * 256 + c * 128 + 8 * g;
#pragma unroll
                for (int ks = 0; ks < 4; ++ks) A[ks] = *(const GAS bf16x8*)(ap + ks * 32);
#pragma unroll 2
                for (int kt = 0; kt < 8; ++kt) {
                    const GAS bf16_t* bp = SK + ((size_t)c * 128 + kt * 16 + r) * 128 + 8 * g;
                    f32x4 d = (f32x4){0.f, 0.f, 0.f, 0.f};
#pragma unroll
                    for (int ks = 0; ks < 4; ++ks) d = MFMA16(A[ks], *(const GAS bf16x8*)(bp + ks * 32), d);
#pragma unroll
                    for (int i = 0; i < 4; ++i) SCP[((4 * g + i) * 16 + h * 2 + c) * SCPS + kt * 16 + r] = d[i];
                }
            }
        }
        __syncthreads();
        if (tid < 256) {
            const LAS float* lp = SCP + tid * SCPS;
            unsigned a[16];
#pragma unroll
            for (int i = 0; i < 16; ++i) a[i] = 0u;
#pragma unroll 4
            for (int k = 0; k < 128; ++k) {
                const unsigned x = (mono_key(lp[k]) & ~127u) | (unsigned)(127 - k);
#pragma unroll
                for (int i = 15; i >= 1; --i) a[i] = med3u(a[i - 1], a[i], x);
                a[0] = a[0] > x ? a[0] : x;
            }
#pragma unroll
            for (int i = 0; i < 16; ++i) TOPL[tid * 16 + i] = a[i];
        }
        __syncthreads();
        if (tid < 128) {
            const int token = tid >> 3, h = tid & 7;
            const LAS unsigned* L1 = TOPL + (token * 16 + h * 2) * 16; const LAS unsigned* L2 = L1 + 16;
            float v1[16], v2[16];
#pragma unroll
            for (int i = 0; i < 16; ++i) { v1[i] = unmono_key(L1[i] & ~127u); v2[i] = unmono_key(L2[i] & ~127u); }
            unsigned cc[16];
#pragma unroll
            for (int i = 0; i < 16; ++i) cc[i] = 0u;
#pragma unroll
            for (int ia = 0; ia < 16; ++ia)
#pragma unroll
                for (int ib = 0; ib < 16; ++ib) if ((ia + 1) * (ib + 1) <= 16) {
                    const unsigned x = (mono_key(v1[ia] + v2[ib]) & ~255u) | (unsigned)(255 - (ia * 16 + ib));
#pragma unroll
                    for (int i = 15; i >= 1; --i) cc[i] = med3u(cc[i - 1], cc[i], x);
                    cc[0] = cc[0] > x ? cc[0] : x;
                }
            const float bmax = unmono_key(cc[0] & ~255u);
            float e[16], esum = 0.f;
#pragma unroll
            for (int i = 0; i < 16; ++i) { e[i] = __expf(unmono_key(cc[i] & ~255u) - bmax); esum += e[i]; }
            const float inv = 1.0f / esum;
#pragma unroll
            for (int i = 0; i < 16; ++i) {
                const int flat = 255 - (int)(cc[i] & 255u), ia = flat >> 4, ib = flat & 15;
                const int i1 = 127 - (int)(L1[ia] & 127u), i2 = 127 - (int)(L2[ib] & 127u);
                RID[token * 128 + h * 16 + i] = (unsigned)(i1 * 128 + i2); RG[token * 128 + h * 16 + i] = e[i] * inv;
            }
        }
        __syncthreads();
#pragma unroll 1
        for (int tk = wave; tk < 16; tk += 8) {
            const size_t row = row0 + tk;
            const unsigned id0 = RID[tk * 128 + lane], id1 = RID[tk * 128 + 64 + lane];
            const float gt0 = RG[tk * 128 + lane], gt1 = RG[tk * 128 + 64 + lane];
            const u32x4 xa = *(const GAS u32x4*)(HB + row * 1024 + 8 * lane), xb = *(const GAS u32x4*)(HB + row * 1024 + 512 + 8 * lane);
            const float ri = row_rinv(SS, (int)row);
            float pre0 = 0.f, pre1 = 0.f;
#pragma unroll 1
            for (int e0 = 0; e0 < 128; e0 += 8) {
                float p[8];
#pragma unroll
                for (int j = 0; j < 8; ++j) {
                    const int e = e0 + j;
                    const unsigned id = (unsigned)__builtin_amdgcn_readlane((int)(e < 64 ? id0 : id1), e & 63);
                    const GAS bf16_t* up = U + (size_t)id * 1024 + 8 * lane;
                    const u32x4 ua = *(const GAS u32x4*)up, ub = *(const GAS u32x4*)(up + 512);
                    float s = dot2bf(ua.x, xa.x, 0.f); s = dot2bf(ua.y, xa.y, s); s = dot2bf(ua.z, xa.z, s); s = dot2bf(ua.w, xa.w, s);
                    s = dot2bf(ub.x, xb.x, s); s = dot2bf(ub.y, xb.y, s); s = dot2bf(ub.z, xb.z, s); s = dot2bf(ub.w, xb.w, s);
                    p[j] = s;
                }
#pragma unroll
                for (int j = 0; j < 8; ++j) { const float t = wave_sum(p[j]); const int e = e0 + j; if (e < 64) { if (lane == e) pre0 = t; } else { if (lane == e - 64) pre1 = t; } }
            }
            const float act0 = gelu_erf(pre0 * ri) * gt0, act1 = gelu_erf(pre1 * ri) * gt1;
            float acc[16];
#pragma unroll
            for (int i = 0; i < 16; ++i) acc[i] = 0.f;
#pragma unroll 1
            for (int e0 = 0; e0 < 128; e0 += 4) {
#pragma unroll
                for (int j = 0; j < 4; ++j) {
                    const int e = e0 + j;
                    const unsigned id = (unsigned)__builtin_amdgcn_readlane((int)(e < 64 ? id0 : id1), e & 63);
                    const float av = __builtin_bit_cast(float, __builtin_amdgcn_readlane(__builtin_bit_cast(int, e < 64 ? act0 : act1), e & 63));
                    const GAS bf16_t* vp = V + (size_t)id * 1024 + 8 * lane;
                    const u32x4 va = *(const GAS u32x4*)vp, vb = *(const GAS u32x4*)(vp + 512);
                    acc[0] += av * bflo(va.x); acc[1] += av * bfhi(va.x); acc[2] += av * bflo(va.y); acc[3] += av * bfhi(va.y);
                    acc[4] += av * bflo(va.z); acc[5] += av * bfhi(va.z); acc[6] += av * bflo(va.w); acc[7] += av * bfhi(va.w);
                    acc[8] += av * bflo(vb.x); acc[9] += av * bfhi(vb.x); acc[10] += av * bflo(vb.y); acc[11] += av * bfhi(vb.y);
                    acc[12] += av * bflo(vb.z); acc[13] += av * bfhi(vb.z); acc[14] += av * bflo(vb.w); acc[15] += av * bfhi(vb.w);
                }
            }
            GAS float* hp = H + row * 1024 + 8 * lane;
            f32x4 h0 = *(GAS f32x4*)hp, h1 = *(GAS f32x4*)(hp + 4), h2 = *(GAS f32x4*)(hp + 512), h3 = *(GAS f32x4*)(hp + 516);
            h0 += (f32x4){acc[0], acc[1], acc[2], acc[3]}; h1 += (f32x4){acc[4], acc[5], acc[6], acc[7]};
            h2 += (f32x4){acc[8], acc[9], acc[10], acc[11]}; h3 += (f32x4){acc[12], acc[13], acc[14], acc[15]};
            *(GAS f32x4*)hp = h0; *(GAS f32x4*)(hp + 4) = h1; *(GAS f32x4*)(hp + 512) = h2; *(GAS f32x4*)(hp + 516) = h3;
            u32x4 w0, w1; w0.x = pk2(h0[0], h0[1]); w0.y = pk2(h0[2], h0[3]); w0.z = pk2(h1[0], h1[1]); w0.w = pk2(h1[2], h1[3]);
            w1.x = pk2(h2[0], h2[1]); w1.y = pk2(h2[2], h2[3]); w1.z = pk2(h3[0], h3[1]); w1.w = pk2(h3[2], h3[3]);
            *(GAS u32x4*)(HB + row * 1024 + 8 * lane) = w0; *(GAS u32x4*)(HB + row * 1024 + 512 + 8 * lane) = w1;
            float sq = (h0[0] * h0[0] + h0[1] * h0[1]) + (h0[2] * h0[2] + h0[3] * h0[3]) + (h1[0] * h1[0] + h1[1] * h1[1]) + (h1[2] * h1[2] + h1[3] * h1[3])
                     + (h2[0] * h2[0] + h2[1] * h2[1]) + (h2[2] * h2[2] + h2[3] * h2[3]) + (h3[0] * h3[0] + h3[1] * h3[1]) + (h3[2] * h3[2] + h3[3] * h3[3]);
            sq = wave_sum(sq);
            if (lane < 16) SS[row * 16 + lane] = (lane == 0) ? sq : 0.f;
            if (dout) {
                const int t = tb * 16 + tk;
                if (t >= NMETA) { float* op = dout + ((size_t)b * SEQ + (t - NMETA)) * 1024 + 8 * lane;
                    *(f32x4*)op = h0; *(f32x4*)(op + 4) = h1; *(f32x4*)(op + 512) = h2; *(f32x4*)(op + 516) = h3; }
            }
        }
        __syncthreads();
    }
}

#define PHASE_FRAME() Frame F; { unsigned long long ws_ = (unsigned long long)a.ws; asm volatile("" : "+s"(ws_)); int tid_ = threadIdx.x; asm volatile("" : "+v"(tid_)); \
    F.lds = (LAS unsigned char*)lds; F.ws = (GAS unsigned char*)ws_; F.tid = tid_; F.lane = tid_ & 63; F.wave = __builtin_amdgcn_readfirstlane(tid_ >> 6); F.G = gridDim.x; F.gw = blockIdx.x * NWAVES + F.wave; F.NGW = F.G * NWAVES; } \
    GAS unsigned char* ws = F.ws; (void)ws
__global__ void __launch_bounds__(NT, 2) mk_fwd(Args a) {
    extern __shared__ __attribute__((aligned(16))) unsigned char lds[];
    volatile LAS unsigned* MISC = (volatile LAS unsigned*)((LAS unsigned char*)lds + MISC_OFF);
    if (threadIdx.x < 16) MISC[threadIdx.x] = 0u;
    __syncthreads();
    XcdBarrier bar = xcd_barrier_post((unsigned*)(a.ws + WS_CTL), MISC);
    PG8_LAS unsigned char* glds = (PG8_LAS unsigned char*)lds;

    { PHASE_FRAME(); phase_prologue(F, a); }
    xcd_barrier(bar);
#pragma unroll 1
    for (int layer = 0; layer < 4; ++layer) {
        {
            PHASE_FRAME();
            const GAS bf16_t* Bt; int N; EpiScale E;
            E.ss = (const GAS float*)(ws + WS_SS); E.vT = nullptr;
            if (layer < 2) { Bt = (const GAS bf16_t*)(ws + WS_WIN) + (size_t)layer * 2048 * 1024; N = 2048; E.O0 = (GAS bf16_t*)(ws + WS_PROJ); E.ld0 = 2048; E.split = 2048; E.O1 = E.O0; E.ld1 = 2048; }
            else if (layer == 2) { Bt = (const GAS bf16_t*)(ws + WS_WKVQ); N = 1536; E.O0 = (GAS bf16_t*)(ws + WS_SKV); E.ld0 = 512; E.split = 512; E.O1 = (GAS bf16_t*)(ws + WS_Q); E.ld1 = 1024; E.vT = (GAS bf16_t*)(ws + WS_VT); }
            else { Bt = (const GAS bf16_t*)(ws + WS_WBQ1); N = 1024; E.O0 = (GAS bf16_t*)(ws + WS_Q); E.ld0 = 1024; E.split = 1024; E.O1 = E.O0; E.ld1 = 1024; }
            pg8::Gemm gm{(const bf16_t*)(ws + WS_HB), (const bf16_t*)Bt, NR, N, 1024}; pg8::StaticOrder S; S.init(NR, N, F.G, (int)blockIdx.x);
            pg8::gemm_phase<EpiScale, pg8::StaticOrder>(glds, gm, S, E);
        }
        xcd_barrier(bar);
        if (layer < 2) {
            { PHASE_FRAME(); phase_a_post(F, a.in[4] + layer * 128, a.in[5] + layer * 128); }
            xcd_barrier(bar);
            { PHASE_FRAME(); phase_dsa(F); }
        } else {
            PHASE_FRAME(); phase_stick(F);
        }
        xcd_barrier(bar);
        {
            PHASE_FRAME();
            const GAS bf16_t* Bt = (layer < 2) ? (const GAS bf16_t*)(ws + WS_WOA) + (size_t)layer * 1024 * 1024 : (const GAS bf16_t*)(ws + WS_WOB) + (size_t)(layer - 2) * 1024 * 1024;
            EpiResid E; E.H = (GAS float*)(ws + WS_H); E.HB = (GAS bf16_t*)(ws + WS_HB); E.ss = (GAS float*)(ws + WS_SS);
            pg8::Gemm gm{(const bf16_t*)(ws + WS_O), (const bf16_t*)Bt, NR, 1024, 1024}; pg8::StaticOrder S; S.init(NR, 1024, F.G, (int)blockIdx.x);
            pg8::gemm_phase<EpiResid, pg8::StaticOrder>(glds, gm, S, E);
        }
        xcd_barrier(bar);
        {
            PHASE_FRAME();
            EpiScale E; E.ss = (const GAS float*)(ws + WS_SS); E.vT = nullptr; E.O0 = (GAS bf16_t*)(ws + WS_PROJ); E.ld0 = 2048; E.split = 2048; E.O1 = E.O0; E.ld1 = 2048;
            pg8::Gemm gm{(const bf16_t*)(ws + WS_HB), (const bf16_t*)((const GAS bf16_t*)(ws + WS_WPQ) + (size_t)layer * 2048 * 1024), NR, 2048, 1024}; pg8::StaticOrder S; S.init(NR, 2048, F.G, (int)blockIdx.x);
            pg8::gemm_phase<EpiScale, pg8::StaticOrder>(glds, gm, S, E);
        }
        xcd_barrier(bar);
        { PHASE_FRAME(); phase_peer(F, layer, layer == 3 ? a.out : nullptr); }
        xcd_barrier(bar);
    }
}

extern "C" void kernel_launch(void* const* d_in, const int* in_sizes, int n_in, void* d_out, int out_size, void* d_ws, size_t ws_size, hipStream_t stream) {
    static int grid = 0;
    if (grid == 0) {
        if (n_in != 17 || out_size != BATCH * SEQ * DM || ws_size < WS_END) { fprintf(stderr, "kernel_launch: unexpected shapes (n_in %d out %d ws %zu need %zu)\n", n_in, out_size, ws_size, (size_t)WS_END); grid = -1; return; }
        int dev = 0, cus = 0, per_cu = 0;
        if (hipGetDevice(&dev) != hipSuccess || hipDeviceGetAttribute(&cus, hipDeviceAttributeMultiprocessorCount, dev) != hipSuccess) { grid = -1; return; }
        if (hipFuncSetAttribute((const void*)mk_fwd, hipFuncAttributeMaxDynamicSharedMemorySize, LDS_BYTES) != hipSuccess) { fprintf(stderr, "kernel_launch: hipFuncSetAttribute failed\n"); grid = -1; return; }
        if (hipOccupancyMaxActiveBlocksPerMultiprocessor(&per_cu, (const void*)mk_fwd, NT, LDS_BYTES) != hipSuccess || per_cu < 1) fprintf(stderr, "kernel_launch: occupancy query says %d blocks/CU\n", per_cu);
        (void)hipGetLastError();
        grid = cus;
    }
    if (grid < 0) return;
    if (hipMemsetAsync((char*)d_ws + WS_CTL, 0, 65536, stream) != hipSuccess) return;
    Args a{};
    for (int i = 0; i < 17; ++i) a.in[i] = (const float*)d_in[i];
    a.out = (float*)d_out; a.ws = (unsigned char*)d_ws;
    for (int i = 0; i < 16; ++i) a.inv32[i] = pow(500000.0, -(double)(2 * i) / 32.0);
    for (int i = 0; i < 8; ++i) a.inv16[i] = pow(500000.0, -(double)(2 * i) / 16.0);
    hipLaunchKernelGGL(mk_fwd, dim3(grid), dim3(NT), LDS_BYTES, stream, a);
}
```

```cpp
#include <hip/hip_runtime.h>
#include <cstdio>
#include <cmath>
#define LAS __attribute__((address_space(3)))
#define GAS __attribute__((address_space(1)))
typedef unsigned short bf16_t;
typedef short bf16x8 __attribute__((ext_vector_type(8)));
typedef short s16x4 __attribute__((ext_vector_type(4)));
typedef float f32x4 __attribute__((ext_vector_type(4)));
typedef float f32x2 __attribute__((ext_vector_type(2)));
typedef unsigned u32x4 __attribute__((ext_vector_type(4)));
typedef unsigned u32x2 __attribute__((ext_vector_type(2)));
typedef __bf16 bf16x2_t __attribute__((ext_vector_type(2)));
constexpr float U_SCALE = 1024.0f, V_SCALE = 256.0f, X_SCALE = 16.0f, Q_SCALE = 128.0f, K_SCALE = 16.0f, V8_SCALE = 16.0f, P8_SCALE = 256.0f;

constexpr int BATCH = 4, SEQ = 4096, DM = 1024, NMETA = 16, TT = SEQ + NMETA  , TP = 4224, NR = BATCH * TP  ;
constexpr int HD = 128, TOPK = 256;
constexpr int ACOLS = 1860, ACOLS_P = 2048;
constexpr int NEXP = 16384;
constexpr float RMS_EPS = 1e-6f;
constexpr int NT = 512, NWAVES = 8;
constexpr int LDS_BYTES = 160 * 1024;
constexpr int MISC_OFF = LDS_BYTES - 64;
constexpr size_t CTL_XRANK = 16384;

constexpr size_t al256(size_t x) { return (x + 255) & ~(size_t)255; }
constexpr size_t WS_CTL   = 0;
constexpr size_t WS_WIN   = 65536;
constexpr size_t WS_WOA   = WS_WIN  + (size_t)2 * 2048 * 1024 * 2;
constexpr size_t WS_WKVQ  = WS_WOA  + (size_t)2 * 1024 * 1024 * 2;
constexpr size_t WS_WBQ1  = WS_WKVQ + (size_t)1536 * 1024 * 2;
constexpr size_t WS_WOB   = WS_WBQ1 + (size_t)1024 * 1024 * 2;
constexpr size_t WS_WPQ   = WS_WOB  + (size_t)2 * 1024 * 1024 * 2;
constexpr size_t WS_SK    = WS_WPQ  + (size_t)4 * 2048 * 1024 * 2;
constexpr size_t WS_ROPE32= WS_SK   + (size_t)4 * 2 * 128 * 128 * 2;
constexpr size_t WS_ROPE16= WS_ROPE32 + (size_t)TP * 16 * 8;
constexpr size_t WS_U     = al256(WS_ROPE16 + (size_t)TP * 8 * 8);
constexpr size_t WS_V     = WS_U    + (size_t)4 * NEXP * 1024 * 2;
constexpr size_t WS_H     = WS_V    + (size_t)4 * NEXP * 1024 * 2;
constexpr size_t WS_HB    = WS_H    + (size_t)NR * 1024 * 4;
constexpr size_t WS_SS    = WS_HB   + (size_t)NR * 1024 * 2;
constexpr size_t WS_PROJ  = WS_SS   + (size_t)NR * 16 * 4;
constexpr size_t WS_Q     = WS_PROJ + (size_t)NR * 2048 * 2;
constexpr size_t WS_KVA   = WS_Q    + (size_t)NR * 1024 * 2;
constexpr size_t WS_QI    = WS_KVA  + (size_t)NR * 512 * 2;
constexpr size_t WS_KI    = WS_QI   + (size_t)NR * 256 * 2;
constexpr size_t WS_WI    = WS_KI   + (size_t)NR * 64 * 2;
constexpr size_t WS_O     = WS_WI   + (size_t)NR * 4 * 4;
constexpr size_t WS_SKV   = WS_O    + (size_t)NR * 1024 * 2;
constexpr size_t WS_VT    = WS_SKV  + (size_t)NR * 512 * 2;
constexpr size_t WS_RID   = WS_VT   + (size_t)BATCH * 2 * 128 * TP * 2;
constexpr size_t WS_RG    = WS_RID  + (size_t)NR * 128 * 4;
constexpr size_t WS_SELG  = WS_RG   + (size_t)NR * 128 * 4;
constexpr size_t WS_ACT   = WS_SELG + (size_t)NR * 256 * 2;
constexpr size_t WS_PART  = WS_ACT  + (size_t)NR * 128 * 4;
constexpr size_t WS_HB8   = WS_PART + (size_t)16 * NR * 128 * 4;
constexpr size_t WS_RIDT  = WS_HB8  + (size_t)NR * 1024;
constexpr size_t WS_Q8    = WS_RIDT + (size_t)NR * 128 * 2;
constexpr size_t WS_K8    = WS_Q8   + (size_t)NR * 1024;
constexpr size_t WS_V8    = WS_K8   + (size_t)NR * 256;
constexpr size_t WS_END   = WS_V8   + (size_t)NR * 256;

__device__ __forceinline__ float bf2f(unsigned b) { return __uint_as_float(b << 16); }
__device__ __forceinline__ float bflo(unsigned w) { return __uint_as_float(w << 16); }
__device__ __forceinline__ float bfhi(unsigned w) { return __uint_as_float(w & 0xffff0000u); }
__device__ __forceinline__ unsigned f2bf(float f) { unsigned u = __float_as_uint(f); return (u + 0x7fffu + ((u >> 16) & 1u)) >> 16; }
__device__ __forceinline__ unsigned pk2(float lo, float hi) { return f2bf(lo) | (f2bf(hi) << 16); }
__device__ __forceinline__ int lane_id_() { return (int)__builtin_amdgcn_mbcnt_hi(~0u, __builtin_amdgcn_mbcnt_lo(~0u, 0u)); }
__device__ __forceinline__ float wave_sum(float v) {
#pragma unroll
    for (int o = 1; o < 64; o <<= 1) v += __shfl_xor(v, o);
    return v;
}
__device__ __forceinline__ int wave_sum_dpp_i(int x) {
    x += __builtin_amdgcn_update_dpp(0, x, 0xB1, 0xf, 0xf, false);
    x += __builtin_amdgcn_update_dpp(0, x, 0x4E, 0xf, 0xf, false);
    x += __builtin_amdgcn_update_dpp(0, x, 0x141, 0xf, 0xf, false);
    x += __builtin_amdgcn_update_dpp(0, x, 0x140, 0xf, 0xf, false);
    return __builtin_amdgcn_readlane(x, 0) + __builtin_amdgcn_readlane(x, 16) + __builtin_amdgcn_readlane(x, 32) + __builtin_amdgcn_readlane(x, 48);
}
__device__ __forceinline__ unsigned mono_key(float s) { const unsigned u = __float_as_uint(s); return u ^ ((u >> 31) ? 0xFFFFFFFFu : 0x80000000u); }
__device__ __forceinline__ float unmono_key(unsigned k) { const unsigned u = (k >> 31) ? (k ^ 0x80000000u) : ~k; return __uint_as_float(u); }
__device__ __forceinline__ unsigned med3u(unsigned a, unsigned b, unsigned c) { unsigned r; asm("v_med3_u32 %0, %1, %2, %3" : "=v"(r) : "v"(a), "v"(b), "v"(c)); return r; }
__device__ __forceinline__ float dot2bf(unsigned a, unsigned b, float c) { return __builtin_amdgcn_fdot2_f32_bf16(__builtin_bit_cast(bf16x2_t, a), __builtin_bit_cast(bf16x2_t, b), c, false); }
#define MFMA16(a, b, c) __builtin_amdgcn_mfma_f32_16x16x32_bf16((a), (b), (c), 0, 0, 0)

#define XB_TMO      128
#define XB_XCNT(j)  (256  + 64 * (j))
#define XB_XSUB(j)  (1280 + 64 * (j))
#define XB_XGEN(j)  (2304 + 64 * (j))
#define XB_TOP      3328
#define XB_TOPGEN   3392
#define XCD_BAR_WORDS 3456
#define XB_SPIN_CAP (1u << 22)
__device__ __forceinline__ unsigned xb_ld(unsigned* p)              { return __hip_atomic_load((GAS unsigned*)p, __ATOMIC_RELAXED, __HIP_MEMORY_SCOPE_AGENT); }
__device__ __forceinline__ unsigned xb_add(unsigned* p, unsigned v) { return __hip_atomic_fetch_add((GAS unsigned*)p, v, __ATOMIC_RELAXED, __HIP_MEMORY_SCOPE_AGENT); }
__device__ __forceinline__ unsigned xb_xcc_id() { return (unsigned)__builtin_amdgcn_s_getreg((3 << 11) | 20) & 0xFu; }
#define XB_SPIN(cond, bar) do { unsigned _sp = 0; while (cond) { __builtin_amdgcn_s_sleep(1); \
    if ((++_sp & 255u) == 0u) { if (xb_ld(&(bar)[XB_TMO])) break; if (_sp > XB_SPIN_CAP) { xb_add(&(bar)[XB_TMO], 1u); break; } } } } while (0)
struct XcdBarrier { unsigned* bar; unsigned x; volatile LAS unsigned* st; };
__device__ __forceinline__ XcdBarrier xcd_barrier_post(unsigned* bar, volatile LAS unsigned* st) {
    XcdBarrier b; b.bar = bar; b.x = xb_xcc_id(); b.st = st;
    if (threadIdx.x == 0) (void)xb_add(&bar[XB_XCNT(b.x)], 1u);
    return b;
}
__device__ __forceinline__ void xcd_barrier_complete(unsigned* bar, unsigned x, unsigned& nloc, unsigned& nx) {
    const unsigned G = gridDim.x * gridDim.y * gridDim.z;
    unsigned sum, cnt, mine, sp = 0u;
    for (;;) {
        sum = 0u; cnt = 0u; mine = 0u;
#pragma unroll
        for (unsigned j = 0; j < 16; ++j) { const unsigned c = xb_ld(&bar[XB_XCNT(j)]); sum += c; cnt += (c > 0u) ? 1u : 0u; mine = (j == x) ? c : mine; }
        if (sum == G) break;
        __builtin_amdgcn_s_sleep(1);
        if ((++sp & 255u) == 0u) { if (xb_ld(&bar[XB_TMO])) break; if (sp > XB_SPIN_CAP) { xb_add(&bar[XB_TMO], 1u); break; } }
    }
    nloc = mine > 0u ? mine : 1u; nx = cnt > 0u ? cnt : 1u;
}
__device__ __forceinline__ void xcd_barrier(const XcdBarrier& b) {
    asm volatile("s_waitcnt vmcnt(0)" ::: "memory");
    __syncthreads();
    if (threadIdx.x == 0) {
        unsigned* bar = b.bar;
        __builtin_amdgcn_s_waitcnt(0);
        unsigned nloc = b.st[0], nx = b.st[1];
        if (nloc == 0u) { xcd_barrier_complete(bar, b.x, nloc, nx); b.st[0] = nloc; b.st[1] = nx; }
        const unsigned old = xb_add(&bar[XB_XSUB(b.x)], 1u);
        const unsigned gen = old / nloc;
        if (old + 1u == (gen + 1u) * nloc) {
            __builtin_amdgcn_fence(__ATOMIC_RELEASE, "agent");
            asm volatile("s_waitcnt vmcnt(0)" ::: "memory");
            const unsigned og = xb_add(&bar[XB_TOP], 1u);
            const unsigned tg = og / nx;
            if (og + 1u == (tg + 1u) * nx) xb_add(&bar[XB_TOPGEN], 1u);
            else XB_SPIN(xb_ld(&bar[XB_TOPGEN]) == tg, bar);
            __builtin_amdgcn_fence(__ATOMIC_ACQUIRE, "agent");
            xb_add(&bar[XB_XGEN(b.x)], 1u);
            asm volatile("s_waitcnt vmcnt(0)" ::: "memory");
        } else {
            XB_SPIN(xb_ld(&bar[XB_XGEN(b.x)]) == gen, bar);
            __builtin_amdgcn_fence(__ATOMIC_ACQUIRE, "agent");
            asm volatile("s_waitcnt vmcnt(0)" ::: "memory");
        }
    }
    __syncthreads();
}
namespace pg8 {
#define PG8_LAS __attribute__((address_space(3)))
typedef unsigned short bf16_t;
typedef short bf16x8 __attribute__((ext_vector_type(8)));
typedef float f32x4 __attribute__((ext_vector_type(4)));
typedef unsigned u32x4 __attribute__((ext_vector_type(4)));
constexpr int BM = 256, BK = 64, HALF = 128, HTB = HALF * BK * 2  , STAGE_BYTES = 8 * HTB, NXCD = 8, WGM = 8;

__host__ __device__ __forceinline__ int lds_byte(int r, int c) { const int st = (r >> 4) * 2 + (c >> 5), rr = r & 15, cc = c & 31, ob = rr * 64 + cc * 2; return st * 1024 + (ob ^ (((ob >> 9) & 1) << 5)); }
__host__ __device__ __forceinline__ void stage_rc(int b, int& R, int& C) { const int st = b / 1024, sb = b % 1024, swz = sb ^ (((sb >> 9) & 1) << 5); R = (st >> 1) * 16 + swz / 64; C = (st & 1) * 32 + (swz % 64) / 2; }
__host__ __device__ __forceinline__ int perm32(int rho) { const int n = rho >> 4, i = rho & 15; return 8 * (i >> 2) + 4 * n + (i & 3); }

__host__ __device__ __forceinline__ int tile_row(int pm) { return (pm >> 4) * 4224 + 16 + (pm & 15) * 256; }
struct Unit { int pm, pn; };
struct Gemm { const bf16_t* A; const bf16_t* Bt; int M, N, K; };

struct StaticOrder {
    int nM, nN, nwg, G, c;
    __host__ __device__ void init(int M, int N, int G_, int c_) { nM = M / BM; nN = N / BM; nwg = nM * nN; G = G_; c = c_; }
    __host__ __device__ bool next(int i, Unit& u) const {
        const long L = (long)i * G + c; if (L >= nwg) return false;
        int wgid = (int)L; { const int q = nwg / NXCD, r = nwg % NXCD, xcd = wgid % NXCD, off = wgid / NXCD; wgid = (xcd < r ? xcd * (q + 1) : r * (q + 1) + (xcd - r) * q) + off; }
        const int nig = WGM * nN, gid = wgid / nig, fm = gid * WGM, gsz = (nM - fm) < WGM ? (nM - fm) : WGM;
        u.pm = fm + ((wgid % nig) % gsz); u.pn = (wgid % nig) / gsz; return true;
    }
    __device__ __forceinline__ void a_ready(const Unit&) const {}
    __device__ __forceinline__ void done(const Unit&) const {}
};
__device__ __forceinline__ unsigned cvt_pk_bf16(float lo, float hi) { unsigned r; asm volatile("v_cvt_pk_bf16_f32 %0, %1, %2" : "=v"(r) : "v"(lo), "v"(hi)); return r; }
template <class Epi, class Sched>
__device__ __forceinline__ void gemm_phase(PG8_LAS unsigned char* lds, const Gemm g, const Sched& S, const Epi& E) {
    int tid_l = threadIdx.x; asm volatile("" : "+v"(tid_l));
    const int tid = tid_l, wid = __builtin_amdgcn_readfirstlane(tid >> 6), lane = tid & 63, wr = wid >> 2, wc = wid & 3, fr = lane & 15, fq = lane >> 4;
    const int K = g.K, nt = K / BK;
    unsigned voffA[2], voffB[2];
#pragma unroll
    for (int i = 0; i < 2; ++i) { int R, C; stage_rc(tid * 16 + i * 8192, R, C); const int Rb = Epi::PERM ? ((R & ~31) + perm32(R & 31)) : R;
        voffA[i] = (unsigned)(R * K + C) * 2u; voffB[i] = (unsigned)(Rb * K + C) * 2u; }
    const size_t kstep = (size_t)(BK * 2);
    const size_t hstep = (size_t)HALF * K * 2;
    const size_t tstep = 2 * hstep;
    const unsigned ldsw = (unsigned)wid * 1024u;
    const int aoff = lds_byte(wr * 64 + fr, fq * 8), boff = lds_byte(wc * 32 + fr, fq * 8);
#define PG8_SA(b, h) (((b) * 2 + (h)) * HTB)
#define PG8_SB(b, h) ((4 + (b) * 2 + (h)) * HTB)
#define PG8_STAGE(bufoff, gbase, voff) do { _Pragma("unroll") for (int _i = 0; _i < 2; ++_i) \
        __builtin_amdgcn_global_load_lds((const unsigned*)((const char*)(gbase) + (voff)[_i]), (PG8_LAS unsigned*)(lds + (bufoff) + ldsw + _i * 8192), 16, 0, 0); } while (0)
#define PG8_LDA(dst, b, h) do { _Pragma("unroll") for (int m = 0; m < 4; ++m) _Pragma("unroll") for (int k = 0; k < 2; ++k) dst[m][k] = *(const PG8_LAS bf16x8*)(lds + PG8_SA(b, h) + aoff + m * 2048 + k * 1024); } while (0)
#define PG8_LDB(dst, b, h) do { _Pragma("unroll") for (int n = 0; n < 2; ++n) _Pragma("unroll") for (int k = 0; k < 2; ++k) dst[n][k] = *(const PG8_LAS bf16x8*)(lds + PG8_SB(b, h) + boff + n * 2048 + k * 1024); } while (0)
#define PG8_MMA(ai, bj, At, Bt) do { __builtin_amdgcn_s_setprio(1); _Pragma("unroll") for (int m = 0; m < 4; ++m) _Pragma("unroll") for (int n = 0; n < 2; ++n) _Pragma("unroll") for (int k = 0; k < 2; ++k) \
        acc[ai][bj][m][n] = __builtin_amdgcn_mfma_f32_16x16x32_bf16(Bt[n][k], At[m][k], acc[ai][bj][m][n], 0, 0, 0); __builtin_amdgcn_s_setprio(0); } while (0)
#define PG8_WAIT_V(n) asm volatile("s_waitcnt vmcnt(" #n ")" ::: "memory")
#define PG8_WAIT_L(n) asm volatile("s_waitcnt lgkmcnt(" #n ")" ::: "memory")
#define PG8_BAR __builtin_amdgcn_s_barrier()
#define PG8_SCHED __builtin_amdgcn_sched_barrier(0)
    Unit cur, nxt; int ui = 0;
    if (!S.next(0, cur)) return;
    f32x4 acc[2][2][4][2];
#pragma unroll
    for (int a = 0; a < 2; ++a)
#pragma unroll
        for (int b = 0; b < 2; ++b)
#pragma unroll
            for (int m = 0; m < 4; ++m)
#pragma unroll
                for (int n = 0; n < 2; ++n) acc[a][b][m][n] = (f32x4){0.f, 0.f, 0.f, 0.f};
    bf16x8 At[4][2], B0[2][2], B1[2][2];
    const char* cA = (const char*)g.A + (size_t)tile_row(cur.pm) * K * 2; const char* cB = (const char*)g.Bt + (size_t)cur.pn * tstep;
    S.a_ready(cur);
    PG8_STAGE(PG8_SB(0, 0), cB, voffB); PG8_STAGE(PG8_SA(0, 0), cA, voffA); PG8_STAGE(PG8_SB(0, 1), cB + hstep, voffB); PG8_STAGE(PG8_SA(0, 1), cA + hstep, voffA);
    if (wr == 1) PG8_BAR;
    PG8_WAIT_V(4); PG8_BAR;
    PG8_STAGE(PG8_SB(1, 0), cB + kstep, voffB); PG8_STAGE(PG8_SA(1, 0), cA + kstep, voffA); PG8_STAGE(PG8_SB(1, 1), cB + hstep + kstep, voffB);
    PG8_WAIT_V(6); PG8_BAR;
    for (;;) {
        const bool has_next = S.next(ui + 1, nxt);
        const char* nA = has_next ? (const char*)g.A + (size_t)tile_row(nxt.pm) * K * 2 : cA; const char* nB = has_next ? (const char*)g.Bt + (size_t)nxt.pn * tstep : cB;
        for (int t = 0; t < nt; t += 2) {
            const bool last = (t == nt - 2);
            const char* a1 = cA + (size_t)(t + 1) * kstep;
            const char* a2 = last ? nA : cA + (size_t)(t + 2) * kstep; const char* b2 = last ? nB : cB + (size_t)(t + 2) * kstep;
            const char* a3 = a2 + kstep; const char* b3 = b2 + kstep;
            if (last && has_next) S.a_ready(nxt);
            PG8_LDB(B0, 0, 0); PG8_SCHED; PG8_LDA(At, 0, 0); PG8_STAGE(PG8_SA(1, 1), a1 + hstep, voffA);
            PG8_WAIT_L(8); PG8_BAR; PG8_WAIT_L(0); PG8_MMA(0, 0, At, B0); PG8_BAR; PG8_SCHED;
            PG8_LDB(B1, 0, 1); PG8_STAGE(PG8_SB(0, 0), b2, voffB);
            PG8_BAR; PG8_WAIT_L(0); PG8_MMA(0, 1, At, B1); PG8_BAR;
            PG8_LDA(At, 0, 1); PG8_STAGE(PG8_SA(0, 0), a2, voffA);
            PG8_BAR; PG8_WAIT_L(0); PG8_MMA(1, 0, At, B0); PG8_BAR; PG8_SCHED;
            PG8_STAGE(PG8_SB(0, 1), b2 + hstep, voffB);
            PG8_WAIT_V(6); PG8_BAR; PG8_MMA(1, 1, At, B1); PG8_BAR;
            PG8_LDB(B0, 1, 0); PG8_SCHED; PG8_LDA(At, 1, 0); PG8_STAGE(PG8_SA(0, 1), a2 + hstep, voffA);
            PG8_WAIT_L(8); PG8_BAR; PG8_WAIT_L(0); PG8_MMA(0, 0, At, B0); PG8_BAR; PG8_SCHED;
            PG8_LDB(B1, 1, 1); PG8_STAGE(PG8_SB(1, 0), b3, voffB);
            PG8_BAR; PG8_WAIT_L(0); PG8_MMA(0, 1, At, B1); PG8_BAR;
            PG8_LDA(At, 1, 1); PG8_STAGE(PG8_SA(1, 0), a3, voffA);
            PG8_BAR; PG8_WAIT_L(0); PG8_MMA(1, 0, At, B0); PG8_BAR; PG8_SCHED;
            PG8_STAGE(PG8_SB(1, 1), b3 + hstep, voffB);
            PG8_WAIT_V(6); PG8_BAR; PG8_MMA(1, 1, At, B1); PG8_BAR;
        }
        if constexpr (!Epi::AFTER_DRAIN) { E(acc, cur, wr, wc, fr, fq); S.done(cur); }
        if (!has_next) break;
#pragma unroll
        for (int a = 0; a < 2; ++a)
#pragma unroll
            for (int b = 0; b < 2; ++b)
#pragma unroll
                for (int m = 0; m < 4; ++m)
#pragma unroll
                    for (int n = 0; n < 2; ++n) acc[a][b][m][n] = (f32x4){0.f, 0.f, 0.f, 0.f};
        cur = nxt; cA = nA; cB = nB; ++ui;
    }
    PG8_WAIT_V(0);
    if (wr == 0) PG8_BAR;
    PG8_BAR;
    if constexpr (Epi::AFTER_DRAIN) { E.fused(acc, cur, wr, wc, fr, fq, lds, wid, lane); S.done(cur); }
#undef PG8_SA
#undef PG8_SB
#undef PG8_STAGE
#undef PG8_LDA
#undef PG8_LDB
#undef PG8_MMA
#undef PG8_WAIT_V
#undef PG8_WAIT_L
#undef PG8_BAR
#undef PG8_SCHED
}
}
__device__ __forceinline__ float row_rinv(const GAS float* ss, int row) {
    const GAS f32x4* p = (const GAS f32x4*)(ss + (size_t)row * 16);
    const f32x4 a = p[0], b = p[1], c = p[2], d = p[3];
    const float s = ((a[0] + a[1]) + (a[2] + a[3])) + ((b[0] + b[1]) + (b[2] + b[3])) + ((c[0] + c[1]) + (c[2] + c[3])) + ((d[0] + d[1]) + (d[2] + d[3]));
    return 1.0f / sqrtf(s * (1.0f / 1024.0f) + RMS_EPS);
}
struct EpiScale {
    static constexpr bool PERM = true, AFTER_DRAIN = false;
    GAS bf16_t* O0; int ld0; int split; GAS bf16_t* O1; int ld1; const GAS float* ss; GAS bf16_t* vT;
    __device__ __forceinline__ void operator()(const f32x4 (&acc)[2][2][4][2], const pg8::Unit& u, int wr, int wc, int fr, int fq) const {
        asm volatile("" : "+v"(fr), "+v"(fq));
        const int row0 = pg8::tile_row(u.pm) + wr * 64 + fr; const int colt = u.pn * 256;
        GAS bf16_t* base; int ldc, c0;
        if (colt < split) { base = O0; ldc = ld0; c0 = colt; } else { base = O1; ldc = ld1; c0 = colt - split; }
        const int col0 = c0 + wc * 32 + 8 * fq;
        const bool dovt = (vT != nullptr) && (colt == 256);
#pragma unroll
        for (int ai = 0; ai < 2; ++ai)
#pragma unroll
            for (int m = 0; m < 4; ++m) {
                const int row = row0 + ai * 128 + m * 16;
                float ri; { const f32x4 q4 = *(const GAS f32x4*)(ss + (size_t)row * 16 + 4 * fq); float s4 = (q4[0] + q4[1]) + (q4[2] + q4[3]); s4 += __shfl_xor(s4, 16); s4 += __shfl_xor(s4, 32);
                            ri = 1.0f / sqrtf(s4 * (1.0f / 1024.0f) + RMS_EPS); }
                GAS bf16_t* rowp = base + (size_t)row * ldc + col0;
#pragma unroll
                for (int bj = 0; bj < 2; ++bj) {
                    const f32x4 v0 = acc[ai][bj][m][0] * ri, v1 = acc[ai][bj][m][1] * ri;
                    u32x4 w; w.x = pk2(v0[0], v0[1]); w.y = pk2(v0[2], v0[3]); w.z = pk2(v1[0], v1[1]); w.w = pk2(v1[2], v1[3]);
                    *(GAS u32x4*)(rowp + bj * 128) = w;
                    if (dovt) {
                        const int b = row / TP, t = row - b * TP;
                        GAS bf16_t* vp = vT + ((size_t)(b * 2 + bj) * 128 + wc * 32 + 8 * fq) * TP + t;
                        vp[0 * TP] = (bf16_t)(w.x & 0xffff); vp[1 * TP] = (bf16_t)(w.x >> 16); vp[2 * TP] = (bf16_t)(w.y & 0xffff); vp[3 * TP] = (bf16_t)(w.y >> 16);
                        vp[4 * TP] = (bf16_t)(w.z & 0xffff); vp[5 * TP] = (bf16_t)(w.z >> 16); vp[6 * TP] = (bf16_t)(w.w & 0xffff); vp[7 * TP] = (bf16_t)(w.w >> 16);
                    }
                }
            }
    }
    __device__ __forceinline__ void tail(const f32x4 (&acc)[4], int b, int ng, int lane) const {
        const int colt = (ng * 64) & ~255; GAS bf16_t* base; int ldc, c0;
        if (colt < split) { base = O0; ldc = ld0; c0 = ng * 64; } else { base = O1; ldc = ld1; c0 = ng * 64 - split; }
        const bool dovt = (vT != nullptr) && (colt == 256);
#pragma unroll
        for (int i = 0; i < 4; ++i) {
            const int t = 4 * (lane >> 4) + i, row = b * TP + t; const float ri = row_rinv(ss, row);
#pragma unroll
            for (int nt = 0; nt < 4; ++nt) {
                const int col = c0 + nt * 16 + (lane & 15); const bf16_t w = (bf16_t)f2bf(acc[nt][i] * ri);
                base[(size_t)row * ldc + col] = w;
                if (dovt) { const int vc = ng * 64 - 256 + nt * 16 + (lane & 15); vT[((size_t)(b * 2 + (vc >> 7)) * 128 + (vc & 127)) * TP + t] = w; }
            }
        }
    }
};
struct EpiResid {
    static constexpr bool PERM = false, AFTER_DRAIN = false;
    GAS float* H; GAS bf16_t* HB; GAS float* ss; GAS unsigned char* HB8;
    __device__ __forceinline__ void operator()(const f32x4 (&acc)[2][2][4][2], const pg8::Unit& u, int wr, int wc, int fr, int fq) const {
        asm volatile("" : "+v"(fr), "+v"(fq));
        const int row0 = pg8::tile_row(u.pm) + wr * 64 + fr, col0 = u.pn * 256 + wc * 32 + 4 * fq;
        f32x4 hn[4];
#pragma unroll
        for (int q = 0; q < 4; ++q) hn[q] = *(const GAS f32x4*)(H + (size_t)row0 * 1024 + col0 + (q >> 1) * 128 + (q & 1) * 16);
#pragma unroll
        for (int gi = 0; gi < 8; ++gi) {
            const int ai = gi >> 2, m = gi & 3;
            const int row = row0 + ai * 128 + m * 16; float s = 0.f;
            GAS float* hp = H + (size_t)row * 1024 + col0; GAS bf16_t* bp = HB + (size_t)row * 1024 + col0;
            f32x4 hc[4];
#pragma unroll
            for (int q = 0; q < 4; ++q) hc[q] = hn[q];
            if (gi < 7) { const int rown = row0 + ((gi + 1) >> 2) * 128 + ((gi + 1) & 3) * 16;
#pragma unroll
                for (int q = 0; q < 4; ++q) hn[q] = *(const GAS f32x4*)(H + (size_t)rown * 1024 + col0 + (q >> 1) * 128 + (q & 1) * 16); }
#pragma unroll
            for (int bj = 0; bj < 2; ++bj)
#pragma unroll
                for (int n = 0; n < 2; ++n) {
                    const f32x4 hv = hc[bj * 2 + n] + acc[ai][bj][m][n];
                    *(GAS f32x4*)(hp + bj * 128 + n * 16) = hv;
                    s += (hv[0] * hv[0] + hv[1] * hv[1]) + (hv[2] * hv[2] + hv[3] * hv[3]);
                    u32x2 w; w.x = pk2(hv[0], hv[1]); w.y = pk2(hv[2], hv[3]);
                    *(GAS u32x2*)(bp + bj * 128 + n * 16) = w;
                }
            s += __shfl_xor(s, 16); s += __shfl_xor(s, 32);
            if (fq == 0) ss[(size_t)row * 16 + u.pn * 4 + wc] = s;
        }
    }
    __device__ __forceinline__ void tail(const f32x4 (&acc)[4], int b, int ng, int lane) const {
#pragma unroll
        for (int i = 0; i < 4; ++i) {
            const int t = 4 * (lane >> 4) + i, row = b * TP + t; float s = 0.f;
#pragma unroll
            for (int nt = 0; nt < 4; ++nt) {
                const int col = ng * 64 + nt * 16 + (lane & 15); const size_t o = (size_t)row * 1024 + col;
                const float hv = H[o] + acc[nt][i]; H[o] = hv; HB[o] = (bf16_t)f2bf(hv); s += hv * hv;
            }
            s += __shfl_xor(s, 1); s += __shfl_xor(s, 2); s += __shfl_xor(s, 4); s += __shfl_xor(s, 8);
            if ((lane & 15) == 0) ss[(size_t)row * 16 + ng] = s;
        }
    }
};

template <class Epi>
__device__ __forceinline__ void gemm_tail(const GAS bf16_t* A, const GAS bf16_t* Bt, int N, const Epi& E, int gw, int NGW, int lane, LAS unsigned char* lds) {
    const int r = lane & 15, g = lane >> 4, njobs = BATCH * (N / 64);
    const int G_ = NGW / NWAVES, wv_ = gw % NWAVES, bk_ = gw / NWAVES;
    LAS f32x4* RED = (LAS f32x4*)lds;
#pragma unroll 1
    for (int job = bk_; job < njobs; job += G_) {
        const int b = job & 3, ng = job >> 2;
        const GAS bf16_t* ap = A + ((size_t)b * TP + r) * 1024 + 8 * g + wv_ * 128; const GAS bf16_t* bp = Bt + ((size_t)ng * 64 + r) * 1024 + 8 * g + wv_ * 128;
        bf16x8 af[4], bf[4][4];
#pragma unroll
        for (int ks = 0; ks < 4; ++ks) { af[ks] = *(const GAS bf16x8*)(ap + ks * 32);
#pragma unroll
            for (int nt = 0; nt < 4; ++nt) bf[nt][ks] = *(const GAS bf16x8*)(bp + (size_t)nt * 16 * 1024 + ks * 32); }
        f32x4 acc[4];
#pragma unroll
        for (int nt = 0; nt < 4; ++nt) { acc[nt] = (f32x4){0.f, 0.f, 0.f, 0.f};
#pragma unroll
            for (int ks = 0; ks < 4; ++ks) acc[nt] = MFMA16(af[ks], bf[nt][ks], acc[nt]); }
#pragma unroll
        for (int nt = 0; nt < 4; ++nt) RED[(wv_ * 4 + nt) * 64 + lane] = acc[nt];
        __syncthreads();
        if (wv_ == 0) {
#pragma unroll
            for (int nt = 0; nt < 4; ++nt) {
#pragma unroll
                for (int w = 1; w < 8; ++w) acc[nt] += RED[(w * 4 + nt) * 64 + lane];
            }
            E.tail(acc, b, ng, lane);
        }
        __syncthreads();
    }
}

struct Args {
    const float* in[17]; float* out; unsigned char* ws;
    double inv32[16]; double inv16[8];
};
struct Frame {
    LAS unsigned char* lds; GAS unsigned char* ws; int tid, lane, wave, G, gw, NGW;
};

__device__ __forceinline__ void p0_transpose_item(const float* W, int N, const float* gain, GAS bf16_t* WT, LAS float* scr, int item, int lane, int nblk) {
    const int kb = item / nblk, nb = item - kb * nblk, k0 = 64 * kb, n0 = 32 * nb;
    const int n = n0 + (lane & 31);
#pragma unroll 8
    for (int i = 0; i < 32; ++i) { const int kk = 2 * i + (lane >> 5); float v = 0.f; if (n < N) { v = W[(size_t)(k0 + kk) * N + n]; if (gain) v *= gain[k0 + kk]; } scr[kk * 33 + (lane & 31)] = v; }
    asm volatile("s_waitcnt lgkmcnt(0)" ::: "memory");
    const int c = lane & 7;
#pragma unroll
    for (int j = 0; j < 4; ++j) { const int nn = (lane >> 3) + 8 * j; const LAS float* s = scr + (8 * c) * 33 + nn;
        u32x4 o; o.x = pk2(s[0 * 33], s[1 * 33]); o.y = pk2(s[2 * 33], s[3 * 33]); o.z = pk2(s[4 * 33], s[5 * 33]); o.w = pk2(s[6 * 33], s[7 * 33]);
        *(GAS u32x4*)(WT + (size_t)(n0 + nn) * 1024 + k0 + 8 * c) = o; }
    asm volatile("s_waitcnt lgkmcnt(0)" ::: "memory");
}
__device__ __forceinline__ void sincos_rev(double ang, float& c, float& s) {
    double rev = ang * 0.15915494309189533577; rev -= rint(rev);
    const double r = rev * 6.28318530717958647692, r2 = r * r;
    double ts = r, ss = r, tc = 1.0, cc = 1.0;
#pragma unroll
    for (int k = 1; k <= 13; ++k) { tc *= -r2 / (double)((2 * k - 1) * (2 * k)); cc += tc; ts *= -r2 / (double)((2 * k) * (2 * k + 1)); ss += ts; }
    c = (float)cc; s = (float)ss;
}
__device__ __forceinline__ void phase_prologue(const Frame& F, const Args& a) {
    GAS unsigned char* ws = F.ws;
    {
        LAS float* scr = (LAS float*)(F.lds + F.wave * 8704);
        const float* a_norm = a.in[2]; const float* a_w_in = a.in[3]; const float* a_w_o = a.in[6]; const float* kv_norm = a.in[7]; const float* kv_w = a.in[8];
        const float* b_norm = a.in[9]; const float* b_w_q = a.in[10]; const float* b_w_o = a.in[11]; const float* ffn_norm = a.in[12]; const float* peer_w_q = a.in[13];
        constexpr int I2048 = 16 * 64, I1024 = 16 * 32, I512 = 16 * 16;
        constexpr int NITEMS = 2 * I2048 + 2 * I1024 + I512 + I1024 + I1024 + 2 * I1024 + 4 * I2048;
        for (int it = F.gw; it < NITEMS; it += F.NGW) {
            int r = it;
            if (r < 2 * I2048) { const int l = r / I2048; r -= l * I2048; p0_transpose_item(a_w_in + (size_t)l * 1024 * ACOLS, ACOLS, a_norm + l * 1024, (GAS bf16_t*)(ws + WS_WIN) + (size_t)l * 2048 * 1024, scr, r, F.lane, 64); continue; } r -= 2 * I2048;
            if (r < 2 * I1024) { const int l = r / I1024; r -= l * I1024; p0_transpose_item(a_w_o + (size_t)l * 1024 * 1024, 1024, nullptr, (GAS bf16_t*)(ws + WS_WOA) + (size_t)l * 1024 * 1024, scr, r, F.lane, 32); continue; } r -= 2 * I1024;
            if (r < I512) { p0_transpose_item(kv_w, 512, kv_norm, (GAS bf16_t*)(ws + WS_WKVQ), scr, r, F.lane, 16); continue; } r -= I512;
            if (r < I1024) { p0_transpose_item(b_w_q, 1024, b_norm, (GAS bf16_t*)(ws + WS_WKVQ) + (size_t)512 * 1024, scr, r, F.lane, 32); continue; } r -= I1024;
            if (r < I1024) { p0_transpose_item(b_w_q + (size_t)1024 * 1024, 1024, b_norm + 1024, (GAS bf16_t*)(ws + WS_WBQ1), scr, r, F.lane, 32); continue; } r -= I1024;
            if (r < 2 * I1024) { const int l = r / I1024; r -= l * I1024; p0_transpose_item(b_w_o + (size_t)l * 1024 * 1024, 1024, nullptr, (GAS bf16_t*)(ws + WS_WOB) + (size_t)l * 1024 * 1024, scr, r, F.lane, 32); continue; } r -= 2 * I1024;
            { const int l = r / I2048; r -= l * I2048; p0_transpose_item(peer_w_q + (size_t)l * 1024 * 2048, 2048, ffn_norm + l * 1024, (GAS bf16_t*)(ws + WS_WPQ) + (size_t)l * 2048 * 1024, scr, r, F.lane, 64); }
        }
    }
    const size_t gtid = (size_t)blockIdx.x * NT + F.tid, gthreads = (size_t)F.G * NT;
    {
        const float* pu = a.in[15]; const float* pv = a.in[16]; const float* ffn_norm = a.in[12];
        GAS unsigned char* U = (GAS unsigned char*)(ws + WS_U); GAS unsigned char* V = (GAS unsigned char*)(ws + WS_V);
        const int lane = F.lane;
#pragma unroll 1
        for (int l = 0; l < 4; ++l) {
            f32x4 gq[4];
#pragma unroll
            for (int q = 0; q < 4; ++q) gq[q] = *(const f32x4*)(ffn_norm + l * 1024 + 256 * q + 4 * lane) * U_SCALE;
#pragma unroll 2
            for (int ex = F.gw; ex < NEXP; ex += F.NGW) {
                const size_t ro = ((size_t)l * NEXP + ex) * 1024 + 4 * lane;
                f32x4 u4[4], v4[4];
#pragma unroll
                for (int q = 0; q < 4; ++q) { u4[q] = __builtin_nontemporal_load((const f32x4*)(pu + ro + 256 * q)); v4[q] = __builtin_nontemporal_load((const f32x4*)(pv + ro + 256 * q)); }
#pragma unroll
                for (int q = 0; q < 4; ++q) {
                    f32x4 u0 = u4[q] * gq[q], v0 = v4[q] * V_SCALE;
#pragma unroll
                    for (int k = 0; k < 4; ++k) { u0[k] = fminf(fmaxf(u0[k], -416.f), 416.f); v0[k] = fminf(fmaxf(v0[k], -416.f), 416.f); }
                    int wu = __builtin_amdgcn_cvt_pk_fp8_f32(u0[0], u0[1], 0, false); wu = __builtin_amdgcn_cvt_pk_fp8_f32(u0[2], u0[3], wu, true);
                    int wv = __builtin_amdgcn_cvt_pk_fp8_f32(v0[0], v0[1], 0, false); wv = __builtin_amdgcn_cvt_pk_fp8_f32(v0[2], v0[3], wv, true);
                    const size_t so = (((size_t)l * 8 + 2 * q + (lane >> 5)) * NEXP + ex) * 128 + 4 * (lane & 31);
                    *(GAS unsigned*)(U + so) = (unsigned)wu; *(GAS unsigned*)(V + so) = (unsigned)wv;
                }
            }
        }
    }
    { const float* sk = a.in[14]; GAS bf16_t* o = (GAS bf16_t*)(ws + WS_SK); for (size_t i = gtid; i < (size_t)4 * 2 * 128 * 128; i += gthreads) o[i] = (bf16_t)f2bf(sk[i]); }
    {
        GAS f32x2* r32 = (GAS f32x2*)(ws + WS_ROPE32); GAS f32x2* r16 = (GAS f32x2*)(ws + WS_ROPE16);
        for (size_t i = gtid; i < (size_t)TP * 24; i += gthreads) {
            const int t = (int)(i / 24), j = (int)(i - (size_t)t * 24); float c, s;
            if (j < 16) { sincos_rev((double)t * a.inv32[j], c, s); r32[t * 16 + j] = (f32x2){c, s}; }
            else { sincos_rev((double)t * a.inv16[j - 16], c, s); r16[t * 8 + (j - 16)] = (f32x2){c, s}; }
        }
    }
    {
        const float* x = a.in[0]; const float* meta = a.in[1];
        GAS float* H = (GAS float*)(ws + WS_H); GAS bf16_t* HB = (GAS bf16_t*)(ws + WS_HB); GAS float* SS = (GAS float*)(ws + WS_SS); GAS bf16_t* O = (GAS bf16_t*)(ws + WS_O);
        for (int row = F.gw; row < NR; row += F.NGW) {
            const int b = row / TP, t = row - b * TP;
            f32x4 v[4]; float s = 0.f;
#pragma unroll
            for (int j = 0; j < 4; ++j) {
                if (t < NMETA) v[j] = *(const f32x4*)(meta + (size_t)t * 1024 + 256 * j + 4 * F.lane);
                else if (t < TT) v[j] = *(const f32x4*)(x + ((size_t)b * SEQ + (t - NMETA)) * 1024 + 256 * j + 4 * F.lane);
                else v[j] = (f32x4){0.f, 0.f, 0.f, 0.f};
                s += (v[j][0] * v[j][0] + v[j][1] * v[j][1]) + (v[j][2] * v[j][2] + v[j][3] * v[j][3]);
            }
            s = wave_sum(s);
#pragma unroll
            for (int j = 0; j < 4; ++j) {
                *(GAS f32x4*)(H + (size_t)row * 1024 + 256 * j + 4 * F.lane) = v[j];
                u32x2 w; w.x = pk2(v[j][0], v[j][1]); w.y = pk2(v[j][2], v[j][3]);
                *(GAS u32x2*)(HB + (size_t)row * 1024 + 256 * j + 4 * F.lane) = w;
                if (t >= TT) *(GAS u32x2*)(O + (size_t)row * 1024 + 256 * j + 4 * F.lane) = (u32x2){0u, 0u};
            }
            if (F.lane < 16) SS[(size_t)row * 16 + F.lane] = (F.lane == 0) ? s : 0.f;
        }
    }
}
#ifndef TRB8_HYP
#define TRB8_HYP 0
#endif
#if TRB8_HYP == 0
#define TRB8_ROW(r) ((r) >> 1)
#define TRB8_COL(r) ((r) & 1)
#else
#define TRB8_ROW(r) ((r) & 7)
#define TRB8_COL(r) ((r) >> 3)
#endif
__device__ __forceinline__ void unpack8(const u32x4& w, float (&x)[8]) {
#pragma unroll
    for (int k = 0; k < 4; ++k) { x[2 * k] = bflo(w[k]); x[2 * k + 1] = bfhi(w[k]); }
}
__device__ __forceinline__ u32x4 pack8(const float (&x)[8]) { u32x4 w; w.x = pk2(x[0], x[1]); w.y = pk2(x[2], x[3]); w.z = pk2(x[4], x[5]); w.w = pk2(x[6], x[7]); return w; }
__device__ __forceinline__ void phase_a_post(const Frame& F, const float* qgain, const float* kgain) {
    GAS unsigned char* ws = F.ws;
    const GAS bf16_t* PROJ = (const GAS bf16_t*)(ws + WS_PROJ);
    GAS unsigned char* Q8 = ws + WS_Q8; GAS unsigned char* K8 = ws + WS_K8; GAS unsigned char* V8 = ws + WS_V8; GAS bf16_t* QI = (GAS bf16_t*)(ws + WS_QI); GAS bf16_t* KI = (GAS bf16_t*)(ws + WS_KI); GAS float* WI = (GAS float*)(ws + WS_WI);
    const GAS f32x2* r32 = (const GAS f32x2*)(ws + WS_ROPE32); const GAS f32x2* r16 = (const GAS f32x2*)(ws + WS_ROPE16);
    const int lane = F.lane, l16 = lane & 15;
    float qg[8], kg[8];
#pragma unroll
    for (int j = 0; j < 8; ++j) { qg[j] = qgain[l16 * 8 + j]; kg[j] = kgain[l16 * 8 + j]; }
    for (int rown = F.gw; rown < BATCH * TT; rown += F.NGW) {
        const int b = rown / TT, t = rown - b * TT; const int row = b * TP + t;
        const GAS bf16_t* pr = PROJ + (size_t)row * 2048;
        const u32x4 wA = *(const GAS u32x4*)(pr + 8 * lane), wB = *(const GAS u32x4*)(pr + 512 + 8 * lane), wC = *(const GAS u32x4*)(pr + 1024 + 8 * lane), wD = *(const GAS u32x4*)(pr + 1536 + 8 * lane);
        f32x2 cs32[8], cs16[8];
#pragma unroll
        for (int j = 0; j < 8; ++j) { cs32[j] = r32[t * 16 + (lane & 1) * 8 + j]; cs16[j] = r16[t * 8 + j]; }
#pragma unroll
        for (int gp = 0; gp < 3; ++gp) {
            float x[8]; unpack8(gp == 0 ? wA : (gp == 1 ? wB : wC), x);
            float ssq = 0.f;
#pragma unroll
            for (int j = 0; j < 8; ++j) ssq += x[j] * x[j];
            ssq += __shfl_xor(ssq, 1); ssq += __shfl_xor(ssq, 2); ssq += __shfl_xor(ssq, 4); ssq += __shfl_xor(ssq, 8);
            const float ri = 1.0f / sqrtf(ssq * (1.0f / 128.0f) + RMS_EPS);
            const bool rot = l16 < 4, second = (lane & 2) != 0;
#pragma unroll
            for (int j = 0; j < 8; ++j) {
                float y = x[j] * ri * (gp < 2 ? qg[j] : kg[j]);
                const float p = __shfl_xor(y, 2);
                if (rot) y = second ? (y * cs32[j].x + p * cs32[j].y) : (y * cs32[j].x - p * cs32[j].y);
                x[j] = (gp < 2) ? y * 0.08838834764831845f : y;
            }
            {
                const float sc = (gp < 2) ? Q_SCALE : K_SCALE; float y8[8];
#pragma unroll
                for (int j = 0; j < 8; ++j) y8[j] = fminf(fmaxf(x[j] * sc, -416.f), 416.f);
                int w0 = __builtin_amdgcn_cvt_pk_fp8_f32(y8[0], y8[1], 0, false); w0 = __builtin_amdgcn_cvt_pk_fp8_f32(y8[2], y8[3], w0, true);
                int w1 = __builtin_amdgcn_cvt_pk_fp8_f32(y8[4], y8[5], 0, false); w1 = __builtin_amdgcn_cvt_pk_fp8_f32(y8[6], y8[7], w1, true);
                if (gp < 2) *(GAS u32x2*)(Q8 + (size_t)row * 1024 + gp * 512 + 8 * lane) = (u32x2){(unsigned)w0, (unsigned)w1};
                else if (lane < 32) *(GAS u32x2*)(K8 + (size_t)row * 256 + 8 * lane) = (u32x2){(unsigned)w0, (unsigned)w1};
            }
            if (gp == 2 && lane >= 32) {
                float xv[8]; unpack8(wC, xv);
#pragma unroll
                for (int j = 0; j < 8; ++j) xv[j] = fminf(fmaxf(xv[j] * V8_SCALE, -416.f), 416.f);
                int w0 = __builtin_amdgcn_cvt_pk_fp8_f32(xv[0], xv[1], 0, false); w0 = __builtin_amdgcn_cvt_pk_fp8_f32(xv[2], xv[3], w0, true);
                int w1 = __builtin_amdgcn_cvt_pk_fp8_f32(xv[4], xv[5], 0, false); w1 = __builtin_amdgcn_cvt_pk_fp8_f32(xv[6], xv[7], w1, true);
                *(GAS u32x2*)(V8 + (size_t)row * 256 + 8 * (lane - 32)) = (u32x2){(unsigned)w0, (unsigned)w1};
            }
        }
        {
            float x[8]; unpack8(wD, x);
            const bool rot = (lane & 7) < 2 && lane < 40, second = (lane & 1) != 0;
#pragma unroll
            for (int j = 0; j < 8; ++j) {
                float y = x[j]; const float p = __shfl_xor(y, 1);
                if (rot) y = second ? (y * cs16[j].x + p * cs16[j].y) : (y * cs16[j].x - p * cs16[j].y);
                x[j] = (lane < 32) ? y * 0.125f : y;
            }
            if (lane < 32) *(GAS u32x4*)(QI + (size_t)row * 256 + 8 * lane) = pack8(x);
            else if (lane < 40) *(GAS u32x4*)(KI + (size_t)row * 64 + 8 * (lane - 32)) = pack8(x);
            else if (lane == 40) *(GAS f32x4*)(WI + (size_t)row * 4) = (f32x4){x[0] * 0.5f, x[1] * 0.5f, x[2] * 0.5f, x[3] * 0.5f};
        }
    }
}

constexpr int SCS = 4232;
constexpr int DSA_SC = 0, DSA_HIST = 8 * SCS * 4, DSA_SEL = DSA_HIST + 8 * 256 * 4;
__device__ __forceinline__ int wave_incl_scan(int v, int lane) {
#pragma unroll
    for (int o = 1; o < 64; o <<= 1) { const int t = __shfl_up(v, o); if (lane >= o) v += t; }
    return v;
}
__device__ __forceinline__ void phase_dsa_sel(const Frame& F) {
    GAS unsigned char* ws = F.ws;
    GAS bf16_t* SELG = (GAS bf16_t*)(ws + WS_SELG); const GAS bf16_t* QI = (const GAS bf16_t*)(ws + WS_QI);
    const GAS bf16_t* KI = (const GAS bf16_t*)(ws + WS_KI); const GAS float* WI = (const GAS float*)(ws + WS_WI);
    LAS unsigned* SC = (LAS unsigned*)(F.lds + DSA_SC); LAS unsigned* HIST = (LAS unsigned*)(F.lds + DSA_HIST) + F.wave * 256; LAS unsigned* SEL = (LAS unsigned*)(F.lds + DSA_SEL) + F.wave * 256;
    const int lane = F.lane, wave = F.wave, r = lane & 15, g = lane >> 4;
    const unsigned long long ltmask = (1ull << lane) - 1ull;
    constexpr int NITEM = BATCH * (TT / 8), NFIRST = (NITEM / 256) * 256;
    for (int it = blockIdx.x; it < NITEM; it += F.G) {
        const int b = it & 3, qb = (it < NFIRST) ? (it >> 2) + (NITEM - NFIRST) / 4 : (it - NFIRST) >> 2, t0 = qb * 8, nkeys = t0 + 8;
        const size_t rb = (size_t)b * TP;
        {
            bf16x8 A[2][2]; f32x4 wv[2];
#pragma unroll
            for (int mt = 0; mt < 2; ++mt) {
                const GAS bf16_t* qp = QI + (rb + t0 + 4 * mt + (r >> 2)) * 256 + (r & 3) * 64 + 8 * g;
                A[mt][0] = *(const GAS bf16x8*)qp; A[mt][1] = *(const GAS bf16x8*)(qp + 32);
                wv[mt] = *(const GAS f32x4*)(WI + (rb + t0 + 4 * mt + g) * 4);
            }
            const int ntile = (nkeys + 15) >> 4;
            LAS unsigned char* KTL = F.lds + DSA_HIST + wave * 2048;
            const int kq8 = lane >> 3, c8 = lane & 7;
#pragma unroll 1
            for (int kt0 = wave; kt0 < ntile; kt0 += 32) {
                u32x4 kl[4][2];
#pragma unroll
                for (int u = 0; u < 4; ++u)
#pragma unroll
                    for (int h = 0; h < 2; ++h) kl[u][h] = *(const GAS u32x4*)(KI + (rb + (kt0 + 8 * u) * 16 + 8 * h + kq8) * 64 + 8 * c8);
#pragma unroll
                for (int u = 0; u < 4; ++u) {
                    const int kt = kt0 + 8 * u;
                    if (kt < ntile) {
#pragma unroll
                        for (int h = 0; h < 2; ++h) { const int rw = 8 * h + kq8; *(LAS u32x4*)(KTL + rw * 128 + ((c8 ^ (rw & 7)) << 4)) = kl[u][h]; }
                        const bf16x8 B0 = *(const LAS bf16x8*)(KTL + r * 128 + ((g ^ (r & 7)) << 4)), B1 = *(const LAS bf16x8*)(KTL + r * 128 + (((4 + g) ^ (r & 7)) << 4));
                        const int key = kt * 16 + r;
#pragma unroll
                        for (int mt = 0; mt < 2; ++mt) {
                            f32x4 d = (f32x4){0.f, 0.f, 0.f, 0.f};
                            d = MFMA16(A[mt][0], B0, d); d = MFMA16(A[mt][1], B1, d);
                            float s = fmaxf(d[0], 0.f) * wv[mt][0] + fmaxf(d[1], 0.f) * wv[mt][1] + fmaxf(d[2], 0.f) * wv[mt][2] + fmaxf(d[3], 0.f) * wv[mt][3];
                            if (s == 0.f) s = 0.f;
                            const int qpos = t0 + 4 * mt + g;
                            SC[(4 * mt + g) * SCS + key] = (key <= qpos) ? mono_key(s) : 0u;
                        }
                    }
                }
            }
        }
        __syncthreads();
        const int qpos = t0 + wave, n = qpos + 1;
        LAS unsigned* row = SC + wave * SCS;
        int cnt;
        if (n <= TOPK) { for (int i = lane; i < TOPK; i += 64) SEL[i] = (i < n) ? (unsigned)i : 0u; cnt = n; }
        else {
            unsigned kreg[65];
#pragma unroll
            for (int c = 0; c < 65; ++c) { const int i = 64 * c + lane; kreg[c] = (i < n) ? row[i] : 0u; }
            const int nch = (n + 63) >> 6;
            unsigned prefix = 0u, mask = 0u; int want = TOPK;
#pragma unroll 1
            for (int pass = 3; pass >= 0; --pass) {
                const int sh = pass * 8;
#pragma unroll
                for (int i = 0; i < 4; ++i) HIST[lane + 64 * i] = 0u;
#pragma unroll
                for (int cb = 0; cb < 65; cb += 13) {
                    if (cb < nch) {
#pragma unroll
                        for (int c = cb; c < cb + 13; ++c) { const unsigned k = kreg[c]; if ((64 * c + lane) < n && (k & mask) == prefix) __hip_atomic_fetch_add(&HIST[(k >> sh) & 255u], 1u, __ATOMIC_RELAXED, __HIP_MEMORY_SCOPE_WORKGROUP); }
                    }
                }
                asm volatile("s_waitcnt lgkmcnt(0)" ::: "memory");
                const int h0 = (int)HIST[255 - 4 * lane], h1 = (int)HIST[254 - 4 * lane], h2 = (int)HIST[253 - 4 * lane], h3 = (int)HIST[252 - 4 * lane];
                const int local = h0 + h1 + h2 + h3, incl = wave_incl_scan(local, lane), excl = incl - local;
                const bool here = (excl < want) && (want <= incl);
                int bin = 0, above = 0;
                if (here) { int c = excl;
                    if (c + h0 >= want) { bin = 255 - 4 * lane; above = c; } else { c += h0;
                    if (c + h1 >= want) { bin = 254 - 4 * lane; above = c; } else { c += h1;
                    if (c + h2 >= want) { bin = 253 - 4 * lane; above = c; } else { c += h2; bin = 252 - 4 * lane; above = c; } } } }
                const unsigned long long bm = __ballot(here);
                const int src = (int)__builtin_ctzll(bm);
                bin = __shfl(bin, src); above = __shfl(above, src);
                want -= above; prefix |= (unsigned)bin << sh; mask |= 0xFFu << sh;
            }
            const unsigned T = prefix; const int need = want;
            int outbase = 0, eqbase = 0;
#pragma unroll
            for (int cb = 0; cb < 65; cb += 13) {
                if (cb < nch) {
#pragma unroll
                    for (int c = cb; c < cb + 13; ++c) {
                        const int i = 64 * c + lane; const unsigned k = kreg[c];
                        const bool gt = k > T, eq = (k == T) && (i < n);
                        const unsigned long long beq = __ballot(eq);
                        const int eqrank = eqbase + __popcll(beq & ltmask);
                        const bool take = gt || (eq && eqrank < need);
                        const unsigned long long bt = __ballot(take);
                        const int pos = outbase + __popcll(bt & ltmask);
                        if (take && pos < TOPK) SEL[pos] = (unsigned)i;
                        outbase += __popcll(bt); eqbase += __popcll(beq);
                    }
                }
            }
            cnt = TOPK;
        }
        asm volatile("s_waitcnt lgkmcnt(0)" ::: "memory");
        { const unsigned s0 = SEL[4 * lane], s1 = SEL[4 * lane + 1], s2 = SEL[4 * lane + 2], s3 = SEL[4 * lane + 3];
          *(GAS u32x2*)(SELG + (rb + qpos) * 256 + 4 * lane) = (u32x2){s0 | (s1 << 16), s2 | (s3 << 16)}; }
        (void)cnt;
        __syncthreads();
    }
}

__device__ __forceinline__ void phase_dsa_attn(const Frame& F) {
    GAS unsigned char* ws = F.ws;
    const GAS unsigned char* Q8 = ws + WS_Q8; const GAS unsigned char* K8 = ws + WS_K8; const GAS unsigned char* V8 = ws + WS_V8; const GAS bf16_t* SELG = (const GAS bf16_t*)(ws + WS_SELG); GAS bf16_t* O = (GAS bf16_t*)(ws + WS_O);
    const int lane = F.lane, wave = F.wave, r = lane & 15, g = lane >> 4;
    volatile LAS unsigned* MISC = (volatile LAS unsigned*)(F.lds + MISC_OFF);
    const int xp = (int)MISC[4], nx = (int)MISC[5], xrank = (int)MISC[6], xn = (int)MISC[7];
    LAS unsigned* SEL = (LAS unsigned*)(F.lds) + wave * 256; LAS float* Pb = (LAS float*)(F.lds + 8192) + wave * 1024; LAS unsigned char* KT = F.lds + 40960 + wave * 8704; LAS unsigned char* PT8 = F.lds + 110592 + wave * 1024;
    const int wrank = xrank * NWAVES + wave, nw = xn * NWAVES;
#pragma unroll 1
    for (int P = xp; P < 2 * BATCH; P += nx) {
        const int b = P >> 1, kvh = P & 1;
        const size_t rb = (size_t)b * TP;
#pragma unroll 1
        for (int qpos = wrank; qpos < TT; qpos += nw) {
            const size_t qrow = rb + qpos;
            const int cnt = (qpos + 1 < TOPK) ? qpos + 1 : TOPK;
            { const u32x2 sw = *(const GAS u32x2*)(SELG + qrow * 256 + 4 * lane);
              SEL[4 * lane] = sw.x & 0xffffu; SEL[4 * lane + 1] = sw.x >> 16; SEL[4 * lane + 2] = sw.y & 0xffffu; SEL[4 * lane + 3] = sw.y >> 16; }
            asm volatile("s_waitcnt lgkmcnt(0)" ::: "memory");
            long Aq[4];
            {
                const GAS unsigned char* qp = Q8 + qrow * 1024 + (kvh * 4 + (r & 3)) * 128 + g * 32;
                u32x4 q0 = *(const GAS u32x4*)qp, q1 = *(const GAS u32x4*)(qp + 16);
                if (r >= 4) { q0 = (u32x4){0u, 0u, 0u, 0u}; q1 = q0; }
                Aq[0] = (long)(((unsigned long long)q0.y << 32) | q0.x); Aq[1] = (long)(((unsigned long long)q0.w << 32) | q0.z);
                Aq[2] = (long)(((unsigned long long)q1.y << 32) | q1.x); Aq[3] = (long)(((unsigned long long)q1.w << 32) | q1.z);
            }
#ifndef NO_QK
            {
                const int kq8 = lane >> 3, c8 = lane & 7;
                const GAS unsigned char* kbase = K8 + rb * 256 + kvh * 128 + 16 * c8;
                u32x4 ka[4], kb2[4];
#define DSA_LOADK(buf, st) do { _Pragma("unroll") for (int u_ = 0; u_ < 4; ++u_) { const int key_ = (int)SEL[(st) * 32 + 8 * u_ + kq8]; buf[u_] = *(const GAS u32x4*)(kbase + (size_t)key_ * 256); } } while (0)
#define DSA_QKSTEP(buf, st) do { _Pragma("unroll") for (int u_ = 0; u_ < 4; ++u_) *(LAS u32x4*)(KT + (8 * u_ + kq8) * 144 + 16 * c8) = buf[u_]; \
                    _Pragma("unroll") for (int h_ = 0; h_ < 2; ++h_) { f32x4 d_ = (f32x4){0.f, 0.f, 0.f, 0.f}; \
                        const u32x4 k0_ = *(const LAS u32x4*)(KT + (16 * h_ + r) * 144 + g * 32), k1_ = *(const LAS u32x4*)(KT + (16 * h_ + r) * 144 + g * 32 + 16); \
                        d_ = __builtin_amdgcn_mfma_f32_16x16x32_fp8_fp8(Aq[0], (long)(((unsigned long long)k0_.y << 32) | k0_.x), d_, 0, 0, 0); \
                        d_ = __builtin_amdgcn_mfma_f32_16x16x32_fp8_fp8(Aq[1], (long)(((unsigned long long)k0_.w << 32) | k0_.z), d_, 0, 0, 0); \
                        d_ = __builtin_amdgcn_mfma_f32_16x16x32_fp8_fp8(Aq[2], (long)(((unsigned long long)k1_.y << 32) | k1_.x), d_, 0, 0, 0); \
                        d_ = __builtin_amdgcn_mfma_f32_16x16x32_fp8_fp8(Aq[3], (long)(((unsigned long long)k1_.w << 32) | k1_.z), d_, 0, 0, 0); \
                        d_ *= (1.0f / (Q_SCALE * K_SCALE)); \
                        const int kk_ = (st) * 32 + 16 * h_ + r; if (kk_ >= cnt) d_ = (f32x4){-INFINITY, -INFINITY, -INFINITY, -INFINITY}; \
                        if (g == 0) *(LAS f32x4*)(Pb + kk_ * 4) = d_; } } while (0)
                DSA_LOADK(ka, 0);
#pragma unroll 1
                for (int st = 0; st < 8; st += 2) {
                    DSA_LOADK(kb2, st + 1);
                    DSA_QKSTEP(ka, st);
                    if (st + 2 < 8) DSA_LOADK(ka, st + 2);
                    DSA_QKSTEP(kb2, st + 1);
                }
            }
#endif
            asm volatile("s_waitcnt lgkmcnt(0)" ::: "memory");
            {
                f32x4 sv[4];
#pragma unroll
                for (int j = 0; j < 4; ++j) sv[j] = *(const LAS f32x4*)(Pb + (lane + 64 * j) * 4);
                float mx[4], sm[4];
#pragma unroll
                for (int i = 0; i < 4; ++i) { float m = fmaxf(fmaxf(sv[0][i], sv[1][i]), fmaxf(sv[2][i], sv[3][i]));
#pragma unroll
                    for (int o = 1; o < 64; o <<= 1) m = fmaxf(m, __shfl_xor(m, o));
                    mx[i] = m; }
#pragma unroll
                for (int i = 0; i < 4; ++i) { float t = 0.f;
#pragma unroll
                    for (int j = 0; j < 4; ++j) { const float e = __expf(sv[j][i] - mx[i]); sv[j][i] = e; t += e; }
                    sm[i] = 1.0f / wave_sum(t); }
#pragma unroll
                for (int j = 0; j < 4; ++j)
#pragma unroll
                    for (int i = 0; i < 4; ++i) { const int w8 = __builtin_amdgcn_cvt_pk_fp8_f32(sv[j][i] * sm[i] * P8_SCALE, 0.f, 0, false); PT8[i * 256 + lane + 64 * j] = (unsigned char)(w8 & 0xff); }
            }
            asm volatile("s_waitcnt lgkmcnt(0)" ::: "memory");
#ifndef NO_PV
            {
                const int kq8 = lane >> 3, c8 = lane & 7;
                const GAS unsigned char* vbase = V8 + rb * 256 + kvh * 128 + 16 * c8;
                f32x4 Od[8];
#pragma unroll
                for (int c = 0; c < 8; ++c) Od[c] = (f32x4){0.f, 0.f, 0.f, 0.f};
                const unsigned vt_lane = (unsigned)(size_t)KT + (unsigned)((8 * g + TRB8_ROW(r)) * 144 + 8 * TRB8_COL(r));
                u32x4 va[4], vb[4];
#define DSA_LOADV(buf, ks) do { _Pragma("unroll") for (int u_ = 0; u_ < 4; ++u_) { const int key_ = (int)SEL[(ks) * 32 + 8 * u_ + kq8]; buf[u_] = *(const GAS u32x4*)(vbase + (size_t)key_ * 256); } } while (0)
#define DSA_PVSTEP(buf, ks) do { _Pragma("unroll") for (int u_ = 0; u_ < 4; ++u_) *(LAS u32x4*)(KT + (8 * u_ + kq8) * 144 + 16 * c8) = buf[u_]; \
                    const u32x2 pw_ = *(const LAS u32x2*)(PT8 + (r & 3) * 256 + (ks) * 32 + 8 * g); const long pa_ = (long)(((unsigned long long)pw_.y << 32) | pw_.x); \
                    long t0_, t1_, t2_, t3_, t4_, t5_, t6_, t7_; \
                    asm volatile("ds_read_b64_tr_b8 %0, %8\n\tds_read_b64_tr_b8 %1, %8 offset:16\n\tds_read_b64_tr_b8 %2, %8 offset:32\n\tds_read_b64_tr_b8 %3, %8 offset:48\n\t" \
                                 "ds_read_b64_tr_b8 %4, %8 offset:64\n\tds_read_b64_tr_b8 %5, %8 offset:80\n\tds_read_b64_tr_b8 %6, %8 offset:96\n\tds_read_b64_tr_b8 %7, %8 offset:112\n\t" \
                                 "s_waitcnt lgkmcnt(0)" \
                                 : "=&v"(t0_), "=&v"(t1_), "=&v"(t2_), "=&v"(t3_), "=&v"(t4_), "=&v"(t5_), "=&v"(t6_), "=&v"(t7_) : "v"(vt_lane) : "memory"); \
                    __builtin_amdgcn_sched_barrier(0); \
                    Od[0] = __builtin_amdgcn_mfma_f32_16x16x32_fp8_fp8(pa_, t0_, Od[0], 0, 0, 0); Od[1] = __builtin_amdgcn_mfma_f32_16x16x32_fp8_fp8(pa_, t1_, Od[1], 0, 0, 0); \
                    Od[2] = __builtin_amdgcn_mfma_f32_16x16x32_fp8_fp8(pa_, t2_, Od[2], 0, 0, 0); Od[3] = __builtin_amdgcn_mfma_f32_16x16x32_fp8_fp8(pa_, t3_, Od[3], 0, 0, 0); \
                    Od[4] = __builtin_amdgcn_mfma_f32_16x16x32_fp8_fp8(pa_, t4_, Od[4], 0, 0, 0); Od[5] = __builtin_amdgcn_mfma_f32_16x16x32_fp8_fp8(pa_, t5_, Od[5], 0, 0, 0); \
                    Od[6] = __builtin_amdgcn_mfma_f32_16x16x32_fp8_fp8(pa_, t6_, Od[6], 0, 0, 0); Od[7] = __builtin_amdgcn_mfma_f32_16x16x32_fp8_fp8(pa_, t7_, Od[7], 0, 0, 0); } while (0)
                DSA_LOADV(va, 0);
#pragma unroll 1
                for (int ks = 0; ks < 8; ks += 2) {
                    DSA_LOADV(vb, ks + 1);
                    DSA_PVSTEP(va, ks);
                    if (ks + 2 < 8) DSA_LOADV(va, ks + 2);
                    DSA_PVSTEP(vb, ks + 1);
                }
                if (g == 0) {
#pragma unroll
                    for (int c = 0; c < 8; ++c)
#pragma unroll
                        for (int i = 0; i < 4; ++i) Pb[i * 128 + c * 16 + r] = Od[c][i] * (1.0f / (P8_SCALE * V8_SCALE));
                }
                asm volatile("s_waitcnt lgkmcnt(0)" ::: "memory");
                { const int kq = lane >> 4, c16 = lane & 15;
                  const f32x4 o0 = *(const LAS f32x4*)(Pb + kq * 128 + 8 * c16), o1 = *(const LAS f32x4*)(Pb + kq * 128 + 8 * c16 + 4);
                  u32x4 w; w.x = pk2(o0[0], o0[1]); w.y = pk2(o0[2], o0[3]); w.z = pk2(o1[0], o1[1]); w.w = pk2(o1[2], o1[3]);
                  *(GAS u32x4*)(O + qrow * 1024 + (kvh * 4 + kq) * 128 + 8 * c16) = w; }
            }
#endif
            asm volatile("s_waitcnt lgkmcnt(0)" ::: "memory");
            asm volatile("s_waitcnt lgkmcnt(0)" ::: "memory");
        }
    }
}

__device__ __forceinline__ float softplus_f(float z) { return fmaxf(z, 0.f) + __logf(1.0f + __expf(-fabsf(z))); }
__device__ __forceinline__ void phase_stick(const Frame& F) {
    GAS unsigned char* ws = F.ws;
    const GAS bf16_t* BQ = (const GAS bf16_t*)(ws + WS_Q); const GAS bf16_t* SKV = (const GAS bf16_t*)(ws + WS_SKV); const GAS bf16_t* VT = (const GAS bf16_t*)(ws + WS_VT); GAS bf16_t* O = (GAS bf16_t*)(ws + WS_O);
    const int lane = F.lane, r = lane & 15, g = lane >> 4;
    constexpr int NQT = TT / 16;
    constexpr int NH = 2;
    for (int it = F.gw; it < BATCH * (8 / NH) * NQT; it += F.NGW) {
        constexpr int NMAIN = BATCH * (8 / NH) * (NQT - 1);
        const int qt = (it < NMAIN) ? (it % (NQT - 1)) + 1 : 0, hb = (it < NMAIN) ? it / (NQT - 1) : it - NMAIN, head0 = (hb % (8 / NH)) * NH, b = hb / (8 / NH), kvh = head0 >> 2, t0 = qt * 16;
        const size_t rb = (size_t)b * TP;
        bf16x8 Bq[NH][4];
#pragma unroll
        for (int hh = 0; hh < NH; ++hh) { const GAS bf16_t* qp = BQ + (rb + t0 + r) * 1024 + (head0 + hh) * 128 + 8 * g;
#pragma unroll
          for (int ks = 0; ks < 4; ++ks) Bq[hh][ks] = *(const GAS bf16x8*)(qp + ks * 32); }
        f32x4 Oa[NH][8];
#pragma unroll
        for (int hh = 0; hh < NH; ++hh)
#pragma unroll
            for (int dt = 0; dt < 8; ++dt) Oa[hh][dt] = (f32x4){0.f, 0.f, 0.f, 0.f};
        float carry[NH];
#pragma unroll
        for (int hh = 0; hh < NH; ++hh) carry[hh] = 0.f;
        const int qpos = t0 + r;
        const GAS bf16_t* vtb = VT + ((size_t)(b * 2 + kvh) * 128) * TP;
        for (int kb = t0; kb >= 0; kb -= 32) {
            bf16x8 Kf[2][4];
#pragma unroll
            for (int tl = 0; tl < 2; ++tl) { int krow = kb - 16 * tl + r; krow = krow < 0 ? 0 : krow; const GAS bf16_t* kp = SKV + (rb + krow) * 512 + kvh * 128 + 8 * g;
#pragma unroll
                for (int ks = 0; ks < 4; ++ks) Kf[tl][ks] = *(const GAS bf16x8*)(kp + ks * 32); }
            bool done = true;
            bf16x8 Pbh[NH];
#pragma unroll
            for (int hh = 0; hh < NH; ++hh) {
                float a_hi[4], a_lo[4];
                float zz[2][4], sp[2][4], tot[2];
#pragma unroll
                for (int tl = 0; tl < 2; ++tl) {
                    const int kbase = kb - 16 * tl;
                    f32x4 z = (f32x4){0.f, 0.f, 0.f, 0.f};
#pragma unroll
                    for (int ks = 0; ks < 4; ++ks) z = MFMA16(Kf[tl][ks], Bq[hh][ks], z);
                    float gsum = 0.f;
#pragma unroll
                    for (int i = 0; i < 4; ++i) { const int key = kbase + 4 * g + i; const bool valid = (key >= 0) && (key < qpos);
                        const float zv = z[i] * 0.08838834764831845f; zz[tl][i] = zv; const float s_ = valid ? softplus_f(zv) : 0.f; sp[tl][i] = s_; gsum += s_; }
                    const float g0 = __shfl(gsum, r), g1 = __shfl(gsum, r + 16), g2 = __shfl(gsum, r + 32), g3 = __shfl(gsum, r + 48);
                    tot[tl] = (g0 + g1) + (g2 + g3);
                    float above = (g < 3 ? g3 : 0.f) + (g < 2 ? g2 : 0.f) + (g < 1 ? g1 : 0.f);
                    float c3 = above + sp[tl][3], c2 = c3 + sp[tl][2], c1 = c2 + sp[tl][1], c0 = c1 + sp[tl][0];
                    sp[tl][3] = c3; sp[tl][2] = c2; sp[tl][1] = c1; sp[tl][0] = c0;
                }
#pragma unroll
                for (int i = 0; i < 4; ++i) {
                    const int khi = kb + 4 * g + i, klo = kb - 16 + 4 * g + i;
                    a_hi[i] = (khi < qpos) ? __expf(zz[0][i] - (carry[hh] + sp[0][i])) : 0.f;
                    a_lo[i] = (klo >= 0 && klo < qpos) ? __expf(zz[1][i] - (carry[hh] + tot[0] + sp[1][i])) : 0.f;
                }
                carry[hh] += tot[0] + tot[1];
                { const unsigned w0 = pk2(a_hi[0], a_hi[1]), w1 = pk2(a_hi[2], a_hi[3]), w2 = pk2(a_lo[0], a_lo[1]), w3 = pk2(a_lo[2], a_lo[3]);
                  const u32x4 w = (u32x4){w0, w1, w2, w3}; Pbh[hh] = __builtin_bit_cast(bf16x8, w); }
                done = done && (carry[hh] > 104.0f);
            }
            const int tlo = (kb - 16) < 0 ? kb : (kb - 16);
#pragma unroll
            for (int dh = 0; dh < 8; dh += 4) {
                bf16x8 Vf[4];
#pragma unroll
                for (int d4 = 0; d4 < 4; ++d4) { const GAS bf16_t* vp = vtb + (size_t)((dh + d4) * 16 + r) * TP;
                    const u32x2 vh = *(const GAS u32x2*)(vp + kb + 4 * g), vl = *(const GAS u32x2*)(vp + tlo + 4 * g);
                    const u32x4 w = (u32x4){vh.x, vh.y, vl.x, vl.y}; Vf[d4] = __builtin_bit_cast(bf16x8, w); }
#pragma unroll
                for (int hh = 0; hh < NH; ++hh)
#pragma unroll
                    for (int d4 = 0; d4 < 4; ++d4) Oa[hh][dh + d4] = MFMA16(Vf[d4], Pbh[hh], Oa[hh][dh + d4]);
            }
            if (__all(done)) break;
        }
#pragma unroll
        for (int hh = 0; hh < NH; ++hh) {
            GAS bf16_t* op = O + (rb + t0 + r) * 1024 + (head0 + hh) * 128 + 4 * g;
#pragma unroll
            for (int dt = 0; dt < 8; ++dt) { u32x2 w; w.x = pk2(Oa[hh][dt][0], Oa[hh][dt][1]); w.y = pk2(Oa[hh][dt][2], Oa[hh][dt][3]); *(GAS u32x2*)(op + dt * 16) = w; }
        }
    }
}
constexpr int SCPH = 130;
constexpr int SKP = 272;
constexpr int PE_SC = 0, PE_TOP = 256 * SCPH * 2  , PE_SK = PE_TOP + 16384, PE_END = PE_SK + 2 * 128 * SKP;
__device__ __forceinline__ float gelu_erf(float v) { return 0.5f * v * (1.0f + erff(v * 0.70710678118654752f)); }
__device__ __forceinline__ void phase_peer_route(const Frame& F, int layer) {
    GAS unsigned char* ws = F.ws;
    const GAS bf16_t* PQ = (const GAS bf16_t*)(ws + WS_PROJ); const GAS bf16_t* SK = (const GAS bf16_t*)(ws + WS_SK) + (size_t)layer * 2 * 128 * 128;
    LAS _Float16* SCP = (LAS _Float16*)(F.lds + PE_SC); LAS unsigned* TOPL = (LAS unsigned*)(F.lds + PE_TOP); LAS unsigned char* SKL = F.lds + PE_SK;
    static_assert(PE_END <= MISC_OFF, "PEER routing LDS");
    for (int i = F.tid; i < 2 * 128 * 16; i += NT) { const int rw = i >> 4, ch = i & 15; *(LAS u32x4*)(SKL + rw * SKP + ch * 16) = *(const GAS u32x4*)(SK + (size_t)rw * 128 + ch * 8); }
    __syncthreads();
    GAS bf16_t* RIDG = (GAS bf16_t*)(ws + WS_RID); GAS bf16_t* RIDT = (GAS bf16_t*)(ws + WS_RIDT); GAS float* RGG = (GAS float*)(ws + WS_RG);
    const int lane = F.lane, wave = F.wave, tid = F.tid, r = lane & 15, g = lane >> 4;
    constexpr int NIT = BATCH * (TT / 16);
    for (int it = blockIdx.x; it < NIT; it += F.G) {
        const int b = it / (TT / 16), tb = it - b * (TT / 16);
        const size_t row0 = (size_t)b * TP + tb * 16;
#ifndef PROBE_ROUTE
#define PROBE_ROUTE 0
#endif
        for (int rp = 0; rp < ((PROBE_ROUTE & 1) ? 2 : 1); ++rp) {
            const int h = wave;
#pragma unroll 1
            for (int c = 0; c < 2; ++c) {
                bf16x8 A[4];
                const GAS bf16_t* ap = PQ + (row0 + r) * 2048 + h * 256 + c * 128 + 8 * g;
#pragma unroll
                for (int ks = 0; ks < 4; ++ks) A[ks] = *(const GAS bf16x8*)(ap + ks * 32);
#pragma unroll
                for (int kt = 0; kt < 8; ++kt) {
                    const LAS unsigned char* bp = SKL + (c * 128 + kt * 16 + r) * SKP + 16 * g;
                    f32x4 d = (f32x4){0.f, 0.f, 0.f, 0.f};
#pragma unroll
                    for (int ks = 0; ks < 4; ++ks) d = MFMA16(A[ks], *(const LAS bf16x8*)(bp + ks * 64), d);
#pragma unroll
                    for (int i = 0; i < 4; ++i) SCP[((4 * g + i) * 16 + h * 2 + c) * SCPH + kt * 16 + r] = (_Float16)d[i];
                }
            }
        }
        __syncthreads();
        for (int rp = 0; rp < ((PROBE_ROUTE & 2) ? 2 : 1); ++rp) {
            if (rp) __syncthreads();
            const int list = tid >> 1, half = tid & 1;
            const LAS _Float16* lp = SCP + list * SCPH + 64 * half;
            unsigned a[16];
#pragma unroll
            for (int i = 0; i < 16; ++i) a[i] = 0u;
#pragma unroll 4
            for (int k = 0; k < 64; ++k) {
                const unsigned x = (mono_key((float)lp[k]) & ~127u) | (unsigned)(127 - (64 * half + k));
#pragma unroll
                for (int i = 15; i >= 1; --i) a[i] = med3u(a[i - 1], a[i], x);
                a[0] = a[0] > x ? a[0] : x;
            }
            if (half) {
#pragma unroll
                for (int i = 0; i < 16; ++i) TOPL[list * 16 + i] = a[i];
            }
            __syncthreads();
            if (!half) {
#pragma unroll 4
                for (int k = 0; k < 16; ++k) {
                    const unsigned x = TOPL[list * 16 + k];
#pragma unroll
                    for (int i = 15; i >= 1; --i) a[i] = med3u(a[i - 1], a[i], x);
                    a[0] = a[0] > x ? a[0] : x;
                }
            }
            __syncthreads();
            if (!half) {
#pragma unroll
                for (int i = 0; i < 16; ++i) TOPL[list * 16 + i] = a[i];
            }
        }
        __syncthreads();
        for (int rp = 0; rp < ((PROBE_ROUTE & 4) ? 2 : 1); ++rp)
        if (tid < 128) {
            const int token = tid >> 3, h = tid & 7;
            const LAS unsigned* L1 = TOPL + (token * 16 + h * 2) * 16; const LAS unsigned* L2 = L1 + 16;
            float v1[16], v2[16];
#pragma unroll
            for (int i = 0; i < 16; ++i) { v1[i] = unmono_key(L1[i] & ~127u); v2[i] = unmono_key(L2[i] & ~127u); }
            unsigned cc[16];
#pragma unroll
            for (int i = 0; i < 16; ++i) cc[i] = 0u;
#pragma unroll
            for (int ia = 0; ia < 16; ++ia)
#pragma unroll
                for (int ib = 0; ib < 16; ++ib) if ((ia + 1) * (ib + 1) <= 16) {
                    const unsigned x = (mono_key(v1[ia] + v2[ib]) & ~255u) | (unsigned)(255 - (ia * 16 + ib));
#pragma unroll
                    for (int i = 15; i >= 1; --i) cc[i] = med3u(cc[i - 1], cc[i], x);
                    cc[0] = cc[0] > x ? cc[0] : x;
                }
            const float bmax = unmono_key(cc[0] & ~255u);
            float e[16], esum = 0.f;
#pragma unroll
            for (int i = 0; i < 16; ++i) { e[i] = __expf(unmono_key(cc[i] & ~255u) - bmax); esum += e[i]; }
            const float inv = 1.0f / esum;
#pragma unroll
            for (int i = 0; i < 16; ++i) {
                const int flat = 255 - (int)(cc[i] & 255u), ia = flat >> 4, ib = flat & 15;
                const int i1 = 127 - (int)(L1[ia] & 127u), i2 = 127 - (int)(L2[ib] & 127u);
                RIDG[(row0 + token) * 128 + h * 16 + i] = (bf16_t)(i1 * 128 + i2); RIDT[(row0 + token) * 128 + i * 8 + h] = (bf16_t)(i1 * 128 + i2); RGG[(row0 + token) * 128 + h * 16 + i] = e[i] * inv;
            }
        }
        __syncthreads();
    }
}

constexpr int NTOK = BATCH * TT;
#define XCC_FRAME() volatile LAS unsigned* MISC_ = (volatile LAS unsigned*)(F.lds + MISC_OFF); \
    const int xp = (int)MISC_[4], nx = (int)MISC_[5], wrank = (int)MISC_[6] * NWAVES + F.wave, nw = (int)MISC_[7] * NWAVES
__device__ __forceinline__ unsigned id_of(const u32x4& a, const u32x4& b, int k) {
    const unsigned w = (k < 8) ? a[(k >> 1) & 3] : b[(k >> 1) & 3]; return (k & 1) ? (w >> 16) : (w & 0xffffu);
}
#define FP8X2(w, hi) __builtin_amdgcn_cvt_pk_f32_fp8((int)(w), hi)
__device__ __forceinline__ size_t tok_row(int tokn) { const int bsel = tokn / TT; return (size_t)bsel * TP + (tokn - bsel * TT); }
#define LDG16(base, off) (*(const GAS u32x4*)((const GAS unsigned char*)(base) + (unsigned)(off)))
__device__ __forceinline__ void phase_peer_u(const Frame& F, int layer) {
    GAS unsigned char* ws = F.ws;
    const GAS unsigned char* HBb = ws + WS_HB; const GAS unsigned char* RIDb = ws + WS_RID;
    const int lane = F.lane, j = lane >> 3, c = lane & 7;
    LAS unsigned char* MET = F.lds + 16384 + F.wave * 1024;
    XCC_FRAME();
#pragma unroll 1
    for (int s = xp; s < 8; s += nx) {
        const GAS unsigned char* Us = ws + WS_U + ((size_t)layer * 8 + s) * NEXP * 128;
        GAS unsigned char* Ps = ws + WS_PART + (size_t)s * NR * 128 * 4;
        const unsigned uo = 16u * c;
#define PU_FETCH(tk) do { const int tk_ = (tk) < NTOK ? (tk) : NTOK - 1; const unsigned r_ = (unsigned)tok_row(tk_); \
        pid = *(const GAS unsigned*)(RIDb + (r_ * 256u + 4u * lane)); px = *(const GAS unsigned*)(HBb + (r_ * 2048u + 256u * s + 4u * lane)); } while (0)
#define PU_STAGE(slot) do { *(LAS unsigned*)(MET + (slot) * 512 + 4 * lane) = pid; *(LAS unsigned*)(MET + (slot) * 512 + 256 + 4 * lane) = px; } while (0)
        unsigned pid, px; int it = 0;
        PU_FETCH(wrank); PU_STAGE(0); PU_FETCH(wrank + nw);
#pragma unroll 1
        for (int tokn = wrank; tokn < NTOK; tokn += nw, ++it) {
            const unsigned row = (unsigned)tok_row(tokn);
            const int sl = it & 1;
            PU_STAGE(sl ^ 1);
            const u32x4 ia = *(const LAS u32x4*)(MET + sl * 512 + 32 * j), ib = *(const LAS u32x4*)(MET + sl * 512 + 32 * j + 16);
            u32x4 u[16];
#pragma unroll
            for (int b = 0; b < 16; ++b) u[b] = LDG16(Us, id_of(ia, ib, b) * 128u + uo);
            PU_FETCH(tokn + 2 * nw);
            const u32x4 xa = *(const LAS u32x4*)(MET + sl * 512 + 256 + 32 * c), xb = *(const LAS u32x4*)(MET + sl * 512 + 256 + 32 * c + 16);
            __builtin_amdgcn_sched_barrier(0);
            f32x2 xf[8];
#pragma unroll
            for (int k = 0; k < 4; ++k) { xf[k] = (f32x2){bflo(xa[k]), bfhi(xa[k])}; xf[4 + k] = (f32x2){bflo(xb[k]), bfhi(xb[k])}; }
            float p[16];
#pragma unroll
            for (int b = 0; b < 16; ++b) {
                unsigned w0 = u[b].x, w1 = u[b].y, w2 = u[b].z, w3 = u[b].w;
                f32x2 t2 = FP8X2(w0, false) * xf[0], t3 = FP8X2(w0, true) * xf[1];
                t2 += FP8X2(w1, false) * xf[2]; t3 += FP8X2(w1, true) * xf[3];
                t2 += FP8X2(w2, false) * xf[4]; t3 += FP8X2(w2, true) * xf[5]; t2 += FP8X2(w3, false) * xf[6]; t3 += FP8X2(w3, true) * xf[7];
                t2 += t3;
                float t = t2.x + t2.y;
                if (b < 14 && (b & 1)) asm volatile("" : "+v"(u[b + 1].x), "+v"(u[b + 1].y), "+v"(u[b + 1].z), "+v"(u[b + 1].w), "+v"(u[b + 2].x), "+v"(u[b + 2].y), "+v"(u[b + 2].z), "+v"(u[b + 2].w) : "v"(t));
                p[b] = t; }
            float q[8], r4[4], t2[2];
            { const bool hi = (c & 4) != 0;
#pragma unroll
              for (int i = 0; i < 8; ++i) q[i] = (hi ? p[8 + i] : p[i]) + __shfl_xor(hi ? p[i] : p[8 + i], 4); }
            { const bool hi = (c & 2) != 0;
#pragma unroll
              for (int i = 0; i < 4; ++i) r4[i] = (hi ? q[4 + i] : q[i]) + __shfl_xor(hi ? q[i] : q[4 + i], 2); }
            { const bool hi = (c & 1) != 0;
#pragma unroll
              for (int i = 0; i < 2; ++i) t2[i] = (hi ? r4[2 + i] : r4[i]) + __shfl_xor(hi ? r4[i] : r4[2 + i], 1); }
            *(GAS f32x2*)(Ps + (row * 512u + 64u * j + 8u * c)) = (f32x2){t2[0], t2[1]};
        }
    }
}
__device__ __forceinline__ void phase_peer_act(const Frame& F) {
    GAS unsigned char* ws = F.ws;
    const GAS float* PART = (const GAS float*)(ws + WS_PART); const GAS float* RGG = (const GAS float*)(ws + WS_RG); const GAS float* SS = (const GAS float*)(ws + WS_SS); GAS bf16_t* ACT = (GAS bf16_t*)(ws + WS_ACT);
    const size_t n4 = (size_t)NTOK * 32;
    for (size_t i = (size_t)blockIdx.x * NT + F.tid; i < n4; i += (size_t)F.G * NT) {
        const int tokn = (int)(i >> 5), q4 = (int)(i & 31); const int bsel = tokn / TT; const size_t row = (size_t)bsel * TP + (tokn - bsel * TT);
        const size_t o = row * 128 + 4 * q4;
        f32x4 acc = *(const GAS f32x4*)(PART + o);
#pragma unroll
        for (int s = 1; s < 8; ++s) acc += *(const GAS f32x4*)(PART + (size_t)s * NR * 128 + o);
        const float ri = row_rinv(SS, (int)row) * (1.0f / U_SCALE); const f32x4 gt = *(const GAS f32x4*)(RGG + o) * (1.0f / V_SCALE);
        *(GAS u32x2*)(ACT + o) = (u32x2){pk2(gelu_erf(acc[0] * ri) * gt[0], gelu_erf(acc[1] * ri) * gt[1]), pk2(gelu_erf(acc[2] * ri) * gt[2], gelu_erf(acc[3] * ri) * gt[3])};
    }
}
__device__ __forceinline__ void phase_peer_v(const Frame& F, int layer, float* dout, size_t dry_off = 0) {
    GAS unsigned char* ws = F.ws;
    const GAS unsigned char* RIDb = ws + WS_RID; const GAS unsigned char* ACTb = ws + WS_ACT;
    GAS unsigned char* Hb = ws + WS_H + dry_off; GAS unsigned char* HBb = ws + WS_HB + dry_off; GAS float* SS = (GAS float*)(ws + WS_SS + dry_off);
    const int lane = F.lane, j = lane >> 3, c = lane & 7;
    LAS unsigned char* MET = F.lds + F.wave * 1024;
    XCC_FRAME();
#pragma unroll 1
    for (int s = xp; s < 8; s += nx) {
        const GAS unsigned char* Vs = ws + WS_V + ((size_t)layer * 8 + s) * NEXP * 128;
        const unsigned vo = 16u * c;
#define PV_FETCH(tk) do { const int tk_ = (tk) < NTOK ? (tk) : NTOK - 1; const unsigned r_ = (unsigned)tok_row(tk_); \
        pid = *(const GAS unsigned*)(RIDb + (r_ * 256u + 4u * lane)); pact = *(const GAS unsigned*)(ACTb + (r_ * 256u + 4u * lane)); } while (0)
#define PV_STAGE(slot) do { *(LAS unsigned*)(MET + (slot) * 512 + 4 * lane) = pid; *(LAS unsigned*)(MET + (slot) * 512 + 256 + 4 * lane) = pact; } while (0)
        unsigned pid, pact; int it = 0;
        PV_FETCH(wrank); PV_STAGE(0); PV_FETCH(wrank + nw);
#pragma unroll 1
        for (int tokn = wrank; tokn < NTOK; tokn += nw, ++it) {
            const int bsel = tokn / TT, tsel = tokn - bsel * TT; const unsigned row = (unsigned)(bsel * TP + tsel);
            const int sl = it & 1;
            PV_STAGE(sl ^ 1);
            const u32x4 ia = *(const LAS u32x4*)(MET + sl * 512 + 32 * j), ib = *(const LAS u32x4*)(MET + sl * 512 + 32 * j + 16);
            u32x4 v[16];
#pragma unroll
            for (int b = 0; b < 16; ++b) v[b] = LDG16(Vs, id_of(ia, ib, b) * 128u + vo);
            PV_FETCH(tokn + 2 * nw);
            const unsigned col = 128u * s + 16u * c + 2u * j;
            const f32x2 hold = *(const GAS f32x2*)(Hb + (row * 4096u + col * 4u));
            __builtin_amdgcn_sched_barrier(0);
            const u32x4 av0 = *(const LAS u32x4*)(MET + sl * 512 + 256 + 32 * j), av1 = *(const LAS u32x4*)(MET + sl * 512 + 256 + 32 * j + 16);
            float acc[16];
#pragma unroll
            for (int i = 0; i < 16; ++i) acc[i] = 0.f;
#pragma unroll
            for (int b = 0; b < 16; ++b) { const unsigned aw_ = (b < 8) ? av0[(b >> 1) & 3] : av1[(b >> 1) & 3]; const float a_ = (b & 1) ? bfhi(aw_) : bflo(aw_);
#pragma unroll
                for (int k = 0; k < 4; ++k) { const f32x2 lo = FP8X2(v[b][k], false), hi = FP8X2(v[b][k], true);
                    acc[4 * k] += a_ * lo.x; acc[4 * k + 1] += a_ * lo.y; acc[4 * k + 2] += a_ * hi.x; acc[4 * k + 3] += a_ * hi.y; }
                if (b < 14 && (b & 1)) asm volatile("" : "+v"(v[b + 1].x), "+v"(v[b + 1].y), "+v"(v[b + 1].z), "+v"(v[b + 1].w), "+v"(v[b + 2].x), "+v"(v[b + 2].y), "+v"(v[b + 2].z), "+v"(v[b + 2].w) : "v"(acc[0])); }
            float q[8], r4[4], o2[2];
            { const bool hi = (lane & 32) != 0;
#pragma unroll
              for (int i = 0; i < 8; ++i) q[i] = (hi ? acc[8 + i] : acc[i]) + __shfl_xor(hi ? acc[i] : acc[8 + i], 32); }
            { const bool hi = (lane & 16) != 0;
#pragma unroll
              for (int i = 0; i < 4; ++i) r4[i] = (hi ? q[4 + i] : q[i]) + __shfl_xor(hi ? q[i] : q[4 + i], 16); }
            { const bool hi = (lane & 8) != 0;
#pragma unroll
              for (int i = 0; i < 2; ++i) o2[i] = (hi ? r4[2 + i] : r4[i]) + __shfl_xor(hi ? r4[i] : r4[2 + i], 8); }
            f32x2 hv = hold; hv.x += o2[0]; hv.y += o2[1];
            *(GAS f32x2*)(Hb + (row * 4096u + col * 4u)) = hv; *(GAS unsigned*)(HBb + (row * 2048u + col * 2u)) = pk2(hv.x, hv.y);
            const float sq = wave_sum(hv.x * hv.x + hv.y * hv.y);
            if (lane == 0) { SS[(size_t)row * 16 + s] = sq; SS[(size_t)row * 16 + 8 + s] = 0.f; }
            if (dout && tsel >= NMETA) *(f32x2*)(dout + ((size_t)bsel * SEQ + (tsel - NMETA)) * 1024 + col) = hv;
        }
    }
}

#define PHASE_FRAME() Frame F; { unsigned long long ws_ = wsu; asm volatile("" : "+s"(ws_)); int tid_ = threadIdx.x; asm volatile("" : "+v"(tid_)); \
    F.lds = (LAS unsigned char*)lds; F.ws = (GAS unsigned char*)ws_; F.tid = tid_; F.lane = tid_ & 63; F.wave = __builtin_amdgcn_readfirstlane(tid_ >> 6); F.G = gridDim.x; F.gw = blockIdx.x * NWAVES + F.wave; F.NGW = F.G * NWAVES; } \
    GAS unsigned char* ws = F.ws; (void)ws
__global__ void __launch_bounds__(NT, 2) mk_fwd(Args a) {
    extern __shared__ __attribute__((aligned(16))) unsigned char lds[];
    unsigned long long wsu = (unsigned long long)a.ws; asm volatile("" : "+s"(wsu));
    unsigned long long outu = (unsigned long long)a.out; asm volatile("" : "+s"(outu));
    volatile LAS unsigned* MISC = (volatile LAS unsigned*)((LAS unsigned char*)lds + MISC_OFF);
    if (threadIdx.x < 16) MISC[threadIdx.x] = 0u;
    __syncthreads();
    XcdBarrier bar = xcd_barrier_post((unsigned*)((unsigned char*)wsu + WS_CTL), MISC);
    if (threadIdx.x == 0) MISC[6] = xb_add((unsigned*)((unsigned char*)wsu + WS_CTL + CTL_XRANK) + 64 * bar.x, 1u);
    PG8_LAS unsigned char* glds = (PG8_LAS unsigned char*)lds;

#ifndef PROBE_DUP
#define PROBE_DUP 0
#endif
    constexpr size_t DRY_OFF = WS_END - WS_H;
    { PHASE_FRAME(); phase_prologue(F, a); }
    xcd_barrier(bar);
    if (threadIdx.x == 0) {
        unsigned nx = 0, xp = 0, xn = 1;
        for (unsigned j = 0; j < 16; ++j) { const unsigned c = xb_ld((unsigned*)((unsigned char*)wsu + WS_CTL + CTL_XRANK) + 64 * j); if (j == bar.x) { xp = nx; xn = c ? c : 1u; } nx += (c > 0u) ? 1u : 0u; }
        MISC[4] = xp; MISC[5] = nx ? nx : 1u; MISC[7] = xn;
    }
    __syncthreads();
    if (PROBE_DUP & 1) { { PHASE_FRAME(); phase_prologue(F, a); } xcd_barrier(bar); }
#pragma unroll 1
    for (int layer = 0; layer < 4; ++layer) {
        for (int rep = 0; rep < ((PROBE_DUP & 2) ? 2 : 1); ++rep) {
            PHASE_FRAME();
            const GAS bf16_t* Bt; int N; EpiScale E;
            E.ss = (const GAS float*)(ws + WS_SS); E.vT = nullptr;
            if (layer < 2) { Bt = (const GAS bf16_t*)(ws + WS_WIN) + (size_t)layer * 2048 * 1024; N = 2048; E.O0 = (GAS bf16_t*)(ws + WS_PROJ); E.ld0 = 2048; E.split = 2048; E.O1 = E.O0; E.ld1 = 2048; }
            else if (layer == 2) { Bt = (const GAS bf16_t*)(ws + WS_WKVQ); N = 1536; E.O0 = (GAS bf16_t*)(ws + WS_SKV); E.ld0 = 512; E.split = 512; E.O1 = (GAS bf16_t*)(ws + WS_Q); E.ld1 = 1024; E.vT = (GAS bf16_t*)(ws + WS_VT); }
            else { Bt = (const GAS bf16_t*)(ws + WS_WBQ1); N = 1024; E.O0 = (GAS bf16_t*)(ws + WS_Q); E.ld0 = 1024; E.split = 1024; E.O1 = E.O0; E.ld1 = 1024; }
            pg8::Gemm gm{(const bf16_t*)(ws + WS_HB), (const bf16_t*)Bt, BATCH * SEQ, N, 1024}; pg8::StaticOrder S; S.init(BATCH * SEQ, N, F.G, (int)blockIdx.x);
            pg8::gemm_phase<EpiScale, pg8::StaticOrder>(glds, gm, S, E);
            gemm_tail<EpiScale>((const GAS bf16_t*)(ws + WS_HB), Bt, N, E, F.gw, F.NGW, F.lane, F.lds);
            if (rep == 0 && (PROBE_DUP & 2)) xcd_barrier(bar);
        }
        xcd_barrier(bar);
        if (layer < 2) {
            for (int rep = 0; rep < ((PROBE_DUP & 4) ? 2 : 1); ++rep) {
            { PHASE_FRAME(); phase_a_post(F, a.in[4] + layer * 128, a.in[5] + layer * 128); }
            xcd_barrier(bar);
            for (int rep2 = 0; rep2 < ((PROBE_DUP & 512) ? 2 : 1); ++rep2) { { PHASE_FRAME(); phase_dsa_sel(F); } xcd_barrier(bar); }
            for (int rep2 = 0; rep2 < ((PROBE_DUP & 1024) ? 2 : 1); ++rep2) { { PHASE_FRAME(); phase_dsa_attn(F); } if (rep2 == 0 && (PROBE_DUP & 1024)) xcd_barrier(bar); }
            if (rep == 0 && (PROBE_DUP & 4)) xcd_barrier(bar);
            }
        } else {
            for (int rep = 0; rep < ((PROBE_DUP & 8) ? 2 : 1); ++rep) {
            PHASE_FRAME(); phase_stick(F);
            if (rep == 0 && (PROBE_DUP & 8)) xcd_barrier(bar);
            }
        }
        xcd_barrier(bar);
        for (int rep = ((PROBE_DUP & 16) ? 1 : 0); rep >= 0; --rep) {
            PHASE_FRAME();
            const GAS bf16_t* Bt = (layer < 2) ? (const GAS bf16_t*)(ws + WS_WOA) + (size_t)layer * 1024 * 1024 : (const GAS bf16_t*)(ws + WS_WOB) + (size_t)(layer - 2) * 1024 * 1024;
            EpiResid E; E.H = (GAS float*)(ws + WS_H + (rep ? DRY_OFF : 0)); E.HB = (GAS bf16_t*)(ws + WS_HB + (rep ? DRY_OFF : 0)); E.ss = (GAS float*)(ws + WS_SS + (rep ? DRY_OFF : 0)); E.HB8 = ws + WS_HB8;
            pg8::Gemm gm{(const bf16_t*)(ws + WS_O), (const bf16_t*)Bt, BATCH * SEQ, 1024, 1024}; pg8::StaticOrder S; S.init(BATCH * SEQ, 1024, F.G, (int)blockIdx.x);
            pg8::gemm_phase<EpiResid, pg8::StaticOrder>(glds, gm, S, E);
            gemm_tail<EpiResid>((const GAS bf16_t*)(ws + WS_O), Bt, 1024, E, F.gw, F.NGW, F.lane, F.lds);
            if (rep) xcd_barrier(bar);
        }
        xcd_barrier(bar);
        for (int rep = 0; rep < ((PROBE_DUP & 32) ? 2 : 1); ++rep) {
            PHASE_FRAME();
            EpiScale E; E.ss = (const GAS float*)(ws + WS_SS); E.vT = nullptr; E.O0 = (GAS bf16_t*)(ws + WS_PROJ); E.ld0 = 2048; E.split = 2048; E.O1 = E.O0; E.ld1 = 2048;
            pg8::Gemm gm{(const bf16_t*)(ws + WS_HB), (const bf16_t*)((const GAS bf16_t*)(ws + WS_WPQ) + (size_t)layer * 2048 * 1024), BATCH * SEQ, 2048, 1024}; pg8::StaticOrder S; S.init(BATCH * SEQ, 2048, F.G, (int)blockIdx.x);
            pg8::gemm_phase<EpiScale, pg8::StaticOrder>(glds, gm, S, E);
            gemm_tail<EpiScale>((const GAS bf16_t*)(ws + WS_HB), (const GAS bf16_t*)(ws + WS_WPQ) + (size_t)layer * 2048 * 1024, 2048, E, F.gw, F.NGW, F.lane, F.lds);
            if (rep == 0 && (PROBE_DUP & 32)) xcd_barrier(bar);
        }
        xcd_barrier(bar);
        for (int rep = 0; rep < ((PROBE_DUP & 64) ? 2 : 1); ++rep) { { PHASE_FRAME(); phase_peer_route(F, layer); } xcd_barrier(bar); }
        for (int rep = 0; rep < ((PROBE_DUP & 128) ? 2 : 1); ++rep) { { PHASE_FRAME(); phase_peer_u(F, layer); } xcd_barrier(bar); }
        for (int rep = 0; rep < ((PROBE_DUP & 2048) ? 2 : 1); ++rep) { { PHASE_FRAME(); phase_peer_act(F); } xcd_barrier(bar); }
        if (PROBE_DUP & 4096) { { PHASE_FRAME(); phase_peer_v(F, layer, nullptr, DRY_OFF); } xcd_barrier(bar); }
        { PHASE_FRAME(); unsigned long long o_ = outu; asm volatile("" : "+s"(o_));
          phase_peer_v(F, layer, layer == 3 ? (float*)o_ : nullptr); }
        xcd_barrier(bar);
        if (PROBE_DUP & 256) { for (int rep = 0; rep < 8; ++rep) xcd_barrier(bar); }
    }
}

extern "C" void kernel_launch(void* const* d_in, const int* in_sizes, int n_in, void* d_out, int out_size, void* d_ws, size_t ws_size, hipStream_t stream) {
    static int grid = 0;
    if (grid == 0) {
        if (n_in != 17 || out_size != BATCH * SEQ * DM || ws_size < WS_END + (WS_PROJ - WS_H)) { fprintf(stderr, "kernel_launch: unexpected shapes (n_in %d out %d ws %zu need %zu)\n", n_in, out_size, ws_size, (size_t)WS_END); grid = -1; return; }
        int dev = 0, cus = 0, per_cu = 0;
        if (hipGetDevice(&dev) != hipSuccess || hipDeviceGetAttribute(&cus, hipDeviceAttributeMultiprocessorCount, dev) != hipSuccess) { grid = -1; return; }
        if (hipFuncSetAttribute((const void*)mk_fwd, hipFuncAttributeMaxDynamicSharedMemorySize, LDS_BYTES) != hipSuccess) { fprintf(stderr, "kernel_launch: hipFuncSetAttribute failed\n"); grid = -1; return; }
        if (hipOccupancyMaxActiveBlocksPerMultiprocessor(&per_cu, (const void*)mk_fwd, NT, LDS_BYTES) != hipSuccess || per_cu < 1) fprintf(stderr, "kernel_launch: occupancy query says %d blocks/CU\n", per_cu);
        (void)hipGetLastError();
        grid = cus;
    }
    if (grid < 0) return;
    if (hipMemsetAsync((char*)d_ws + WS_CTL, 0, 65536, stream) != hipSuccess) return;
    Args a{};
    for (int i = 0; i < 17; ++i) a.in[i] = (const float*)d_in[i];
    a.out = (float*)d_out; a.ws = (unsigned char*)d_ws;
    for (int i = 0; i < 16; ++i) a.inv32[i] = pow(500000.0, -(double)(2 * i) / 32.0);
    for (int i = 0; i < 8; ++i) a.inv16[i] = pow(500000.0, -(double)(2 * i) / 16.0);
    hipLaunchKernelGGL(mk_fwd, dim3(grid), dim3(NT), LDS_BYTES, stream, a);
}
```

```cpp
#include <hip/hip_runtime.h>
#include <cstdio>
#include <cmath>
#define LAS __attribute__((address_space(3)))
#define GAS __attribute__((address_space(1)))
typedef unsigned short bf16_t;
typedef short bf16x8 __attribute__((ext_vector_type(8)));
typedef short s16x4 __attribute__((ext_vector_type(4)));
typedef float f32x4 __attribute__((ext_vector_type(4)));
typedef float f32x2 __attribute__((ext_vector_type(2)));
typedef unsigned u32x4 __attribute__((ext_vector_type(4)));
typedef unsigned u32x2 __attribute__((ext_vector_type(2)));
typedef __bf16 bf16x2_t __attribute__((ext_vector_type(2)));
constexpr float U_SCALE = 1024.0f, V_SCALE = 256.0f, X_SCALE = 16.0f, Q_SCALE = 128.0f, K_SCALE = 16.0f, V8_SCALE = 16.0f, P8_SCALE = 256.0f;

constexpr int BATCH = 4, SEQ = 4096, DM = 1024, NMETA = 16, TT = SEQ + NMETA  , TP = 4224, NR = BATCH * TP  ;
constexpr int HD = 128, TOPK = 256;
constexpr int ACOLS = 1860, ACOLS_P = 2048;
constexpr int NEXP = 16384;
constexpr float RMS_EPS = 1e-6f;
constexpr int NT = 512, NWAVES = 8;
constexpr int LDS_BYTES = 160 * 1024;
constexpr int MISC_OFF = LDS_BYTES - 64;
constexpr size_t CTL_XRANK = 16384;

constexpr size_t al256(size_t x) { return (x + 255) & ~(size_t)255; }
constexpr size_t WS_CTL   = 0;
constexpr size_t WS_WIN   = 65536;
constexpr size_t WS_WOA   = WS_WIN  + (size_t)2 * 2048 * 1024 * 2;
constexpr size_t WS_WKVQ  = WS_WOA  + (size_t)2 * 1024 * 1024 * 2;
constexpr size_t WS_WBQ1  = WS_WKVQ + (size_t)1536 * 1024 * 2;
constexpr size_t WS_WOB   = WS_WBQ1 + (size_t)1024 * 1024 * 2;
constexpr size_t WS_WPQ   = WS_WOB  + (size_t)2 * 1024 * 1024 * 2;
constexpr size_t WS_SK    = WS_WPQ  + (size_t)4 * 2048 * 1024 * 2;
constexpr size_t WS_ROPE32= WS_SK   + (size_t)4 * 2 * 128 * 128 * 2;
constexpr size_t WS_ROPE16= WS_ROPE32 + (size_t)TP * 16 * 8;
constexpr size_t WS_U     = al256(WS_ROPE16 + (size_t)TP * 8 * 8);
constexpr size_t WS_V     = WS_U    + (size_t)4 * NEXP * 1024 * 2;
constexpr size_t WS_H     = WS_V    + (size_t)4 * NEXP * 1024 * 2;
constexpr size_t WS_HB    = WS_H    + (size_t)NR * 1024 * 4;
constexpr size_t WS_SS    = WS_HB   + (size_t)NR * 1024 * 2;
constexpr size_t WS_PROJ  = WS_SS   + (size_t)NR * 16 * 4;
constexpr size_t WS_Q     = WS_PROJ + (size_t)NR * 2048 * 2;
constexpr size_t WS_KVA   = WS_Q    + (size_t)NR * 1024 * 2;
constexpr size_t WS_QI    = WS_KVA  + (size_t)NR * 512 * 2;
constexpr size_t WS_KI    = WS_QI   + (size_t)NR * 256 * 2;
constexpr size_t WS_WI    = WS_KI   + (size_t)NR * 64 * 2;
constexpr size_t WS_O     = WS_WI   + (size_t)NR * 4 * 4;
constexpr size_t WS_SKV   = WS_O    + (size_t)NR * 1024 * 2;
constexpr size_t WS_VT    = WS_SKV  + (size_t)NR * 512 * 2;
constexpr size_t WS_RID   = WS_VT   + (size_t)BATCH * 2 * 128 * TP * 2;
constexpr size_t WS_RG    = WS_RID  + (size_t)NR * 128 * 4;
constexpr size_t WS_SELG  = WS_RG   + (size_t)NR * 128 * 4;
constexpr size_t WS_ACT   = WS_SELG + (size_t)NR * 256 * 2;
constexpr size_t WS_PART  = WS_ACT  + (size_t)NR * 128 * 4;
constexpr size_t WS_HB8   = WS_PART + (size_t)16 * NR * 128 * 4;
constexpr size_t WS_RIDT  = WS_HB8  + (size_t)NR * 1024;
constexpr size_t WS_Q8    = WS_RIDT + (size_t)NR * 128 * 2;
constexpr size_t WS_K8    = WS_Q8   + (size_t)NR * 1024;
constexpr size_t WS_V8    = WS_K8   + (size_t)NR * 256;
constexpr size_t WS_END   = WS_V8   + (size_t)NR * 256;

__device__ __forceinline__ float bf2f(unsigned b) { return __uint_as_float(b << 16); }
__device__ __forceinline__ float bflo(unsigned w) { return __uint_as_float(w << 16); }
__device__ __forceinline__ float bfhi(unsigned w) { return __uint_as_float(w & 0xffff0000u); }
__device__ __forceinline__ unsigned f2bf(float f) { unsigned u = __float_as_uint(f); return (u + 0x7fffu + ((u >> 16) & 1u)) >> 16; }
__device__ __forceinline__ unsigned pk2(float lo, float hi) { return f2bf(lo) | (f2bf(hi) << 16); }
__device__ __forceinline__ int lane_id_() { return (int)__builtin_amdgcn_mbcnt_hi(~0u, __builtin_amdgcn_mbcnt_lo(~0u, 0u)); }
__device__ __forceinline__ float wave_sum(float v) {
#pragma unroll
    for (int o = 1; o < 64; o <<= 1) v += __shfl_xor(v, o);
    return v;
}
__device__ __forceinline__ int wave_sum_dpp_i(int x) {
    x += __builtin_amdgcn_update_dpp(0, x, 0xB1, 0xf, 0xf, false);
    x += __builtin_amdgcn_update_dpp(0, x, 0x4E, 0xf, 0xf, false);
    x += __builtin_amdgcn_update_dpp(0, x, 0x141, 0xf, 0xf, false);
    x += __builtin_amdgcn_update_dpp(0, x, 0x140, 0xf, 0xf, false);
    return __builtin_amdgcn_readlane(x, 0) + __builtin_amdgcn_readlane(x, 16) + __builtin_amdgcn_readlane(x, 32) + __builtin_amdgcn_readlane(x, 48);
}
__device__ __forceinline__ unsigned mono_key(float s) { const unsigned u = __float_as_uint(s); return u ^ ((u >> 31) ? 0xFFFFFFFFu : 0x80000000u); }
__device__ __forceinline__ float unmono_key(unsigned k) { const unsigned u = (k >> 31) ? (k ^ 0x80000000u) : ~k; return __uint_as_float(u); }
__device__ __forceinline__ unsigned med3u(unsigned a, unsigned b, unsigned c) { unsigned r; asm("v_med3_u32 %0, %1, %2, %3" : "=v"(r) : "v"(a), "v"(b), "v"(c)); return r; }
__device__ __forceinline__ float dot2bf(unsigned a, unsigned b, float c) { return __builtin_amdgcn_fdot2_f32_bf16(__builtin_bit_cast(bf16x2_t, a), __builtin_bit_cast(bf16x2_t, b), c, false); }
#define MFMA16(a, b, c) __builtin_amdgcn_mfma_f32_16x16x32_bf16((a), (b), (c), 0, 0, 0)

#define XB_TMO      128
#define XB_XCNT(j)  (256  + 64 * (j))
#define XB_XSUB(j)  (1280 + 64 * (j))
#define XB_XGEN(j)  (2304 + 64 * (j))
#define XB_TOP      3328
#define XB_TOPGEN   3392
#define XCD_BAR_WORDS 3456
#define XB_SPIN_CAP (1u << 22)
__device__ __forceinline__ unsigned xb_ld(unsigned* p)              { return __hip_atomic_load((GAS unsigned*)p, __ATOMIC_RELAXED, __HIP_MEMORY_SCOPE_AGENT); }
__device__ __forceinline__ unsigned xb_add(unsigned* p, unsigned v) { return __hip_atomic_fetch_add((GAS unsigned*)p, v, __ATOMIC_RELAXED, __HIP_MEMORY_SCOPE_AGENT); }
__device__ __forceinline__ unsigned xb_xcc_id() { return (unsigned)__builtin_amdgcn_s_getreg((3 << 11) | 20) & 0xFu; }
#define XB_SPIN(cond, bar) do { unsigned _sp = 0; while (cond) { __builtin_amdgcn_s_sleep(1); \
    if ((++_sp & 255u) == 0u) { if (xb_ld(&(bar)[XB_TMO])) break; if (_sp > XB_SPIN_CAP) { xb_add(&(bar)[XB_TMO], 1u); break; } } } } while (0)
struct XcdBarrier { unsigned* bar; unsigned x; volatile LAS unsigned* st; };
__device__ __forceinline__ XcdBarrier xcd_barrier_post(unsigned* bar, volatile LAS unsigned* st) {
    XcdBarrier b; b.bar = bar; b.x = xb_xcc_id(); b.st = st;
    if (threadIdx.x == 0) (void)xb_add(&bar[XB_XCNT(b.x)], 1u);
    return b;
}
__device__ __forceinline__ void xcd_barrier_complete(unsigned* bar, unsigned x, unsigned& nloc, unsigned& nx) {
    const unsigned G = gridDim.x * gridDim.y * gridDim.z;
    unsigned sum, cnt, mine, sp = 0u;
    for (;;) {
        sum = 0u; cnt = 0u; mine = 0u;
#pragma unroll
        for (unsigned j = 0; j < 16; ++j) { const unsigned c = xb_ld(&bar[XB_XCNT(j)]); sum += c; cnt += (c > 0u) ? 1u : 0u; mine = (j == x) ? c : mine; }
        if (sum == G) break;
        __builtin_amdgcn_s_sleep(1);
        if ((++sp & 255u) == 0u) { if (xb_ld(&bar[XB_TMO])) break; if (sp > XB_SPIN_CAP) { xb_add(&bar[XB_TMO], 1u); break; } }
    }
    nloc = mine > 0u ? mine : 1u; nx = cnt > 0u ? cnt : 1u;
}
__device__ __forceinline__ void xcd_barrier(const XcdBarrier& b) {
    asm volatile("s_waitcnt vmcnt(0)" ::: "memory");
    __syncthreads();
    if (threadIdx.x == 0) {
        unsigned* bar = b.bar;
        __builtin_amdgcn_s_waitcnt(0);
        unsigned nloc = b.st[0], nx = b.st[1];
        if (nloc == 0u) { xcd_barrier_complete(bar, b.x, nloc, nx); b.st[0] = nloc; b.st[1] = nx; }
        const unsigned old = xb_add(&bar[XB_XSUB(b.x)], 1u);
        const unsigned gen = old / nloc;
        if (old + 1u == (gen + 1u) * nloc) {
            __builtin_amdgcn_fence(__ATOMIC_RELEASE, "agent");
            asm volatile("s_waitcnt vmcnt(0)" ::: "memory");
            const unsigned og = xb_add(&bar[XB_TOP], 1u);
            const unsigned tg = og / nx;
            if (og + 1u == (tg + 1u) * nx) xb_add(&bar[XB_TOPGEN], 1u);
            else XB_SPIN(xb_ld(&bar[XB_TOPGEN]) == tg, bar);
            __builtin_amdgcn_fence(__ATOMIC_ACQUIRE, "agent");
            xb_add(&bar[XB_XGEN(b.x)], 1u);
            asm volatile("s_waitcnt vmcnt(0)" ::: "memory");
        } else {
            XB_SPIN(xb_ld(&bar[XB_XGEN(b.x)]) == gen, bar);
            __builtin_amdgcn_fence(__ATOMIC_ACQUIRE, "agent");
            asm volatile("s_waitcnt vmcnt(0)" ::: "memory");
        }
    }
    __syncthreads();
}
namespace pg8 {
#define PG8_LAS __attribute__((address_space(3)))
typedef unsigned short bf16_t;
typedef short bf16x8 __attribute__((ext_vector_type(8)));
typedef float f32x4 __attribute__((ext_vector_type(4)));
typedef unsigned u32x4 __attribute__((ext_vector_type(4)));
constexpr int BM = 256, BK = 64, HALF = 128, HTB = HALF * BK * 2  , STAGE_BYTES = 8 * HTB, NXCD = 8, WGM = 8;

__host__ __device__ __forceinline__ int lds_byte(int r, int c) { const int st = (r >> 4) * 2 + (c >> 5), rr = r & 15, cc = c & 31, ob = rr * 64 + cc * 2; return st * 1024 + (ob ^ (((ob >> 9) & 1) << 5)); }
__host__ __device__ __forceinline__ void stage_rc(int b, int& R, int& C) { const int st = b / 1024, sb = b % 1024, swz = sb ^ (((sb >> 9) & 1) << 5); R = (st >> 1) * 16 + swz / 64; C = (st & 1) * 32 + (swz % 64) / 2; }
__host__ __device__ __forceinline__ int perm32(int rho) { const int n = rho >> 4, i = rho & 15; return 8 * (i >> 2) + 4 * n + (i & 3); }

__host__ __device__ __forceinline__ int tile_row(int pm) { return (pm >> 4) * 4224 + 16 + (pm & 15) * 256; }
struct Unit { int pm, pn; };
struct Gemm { const bf16_t* A; const bf16_t* Bt; int M, N, K; };

struct StaticOrder {
    int nM, nN, nwg, G, c;
    __host__ __device__ void init(int M, int N, int G_, int c_) { nM = M / BM; nN = N / BM; nwg = nM * nN; G = G_; c = c_; }
    __host__ __device__ bool next(int i, Unit& u) const {
        const long L = (long)i * G + c; if (L >= nwg) return false;
        int wgid = (int)L; { const int q = nwg / NXCD, r = nwg % NXCD, xcd = wgid % NXCD, off = wgid / NXCD; wgid = (xcd < r ? xcd * (q + 1) : r * (q + 1) + (xcd - r) * q) + off; }
        const int nig = WGM * nN, gid = wgid / nig, fm = gid * WGM, gsz = (nM - fm) < WGM ? (nM - fm) : WGM;
        u.pm = fm + ((wgid % nig) % gsz); u.pn = (wgid % nig) / gsz; return true;
    }
    __device__ __forceinline__ void a_ready(const Unit&) const {}
    __device__ __forceinline__ void done(const Unit&) const {}
};
__device__ __forceinline__ unsigned cvt_pk_bf16(float lo, float hi) { unsigned r; asm volatile("v_cvt_pk_bf16_f32 %0, %1, %2" : "=v"(r) : "v"(lo), "v"(hi)); return r; }
template <class Epi, class Sched>
__device__ __forceinline__ void gemm_phase(PG8_LAS unsigned char* lds, const Gemm g, const Sched& S, const Epi& E) {
    int tid_l = threadIdx.x; asm volatile("" : "+v"(tid_l));
    const int tid = tid_l, wid = __builtin_amdgcn_readfirstlane(tid >> 6), lane = tid & 63, wr = wid >> 2, wc = wid & 3, fr = lane & 15, fq = lane >> 4;
    const int K = g.K, nt = K / BK;
    unsigned voffA[2], voffB[2];
#pragma unroll
    for (int i = 0; i < 2; ++i) { int R, C; stage_rc(tid * 16 + i * 8192, R, C); const int Rb = Epi::PERM ? ((R & ~31) + perm32(R & 31)) : R;
        voffA[i] = (unsigned)(R * K + C) * 2u; voffB[i] = (unsigned)(Rb * K + C) * 2u; }
    const size_t kstep = (size_t)(BK * 2);
    const size_t hstep = (size_t)HALF * K * 2;
    const size_t tstep = 2 * hstep;
    const unsigned ldsw = (unsigned)wid * 1024u;
    const int aoff = lds_byte(wr * 64 + fr, fq * 8), boff = lds_byte(wc * 32 + fr, fq * 8);
#define PG8_SA(b, h) (((b) * 2 + (h)) * HTB)
#define PG8_SB(b, h) ((4 + (b) * 2 + (h)) * HTB)
#define PG8_STAGE(bufoff, gbase, voff) do { _Pragma("unroll") for (int _i = 0; _i < 2; ++_i) \
        __builtin_amdgcn_global_load_lds((const unsigned*)((const char*)(gbase) + (voff)[_i]), (PG8_LAS unsigned*)(lds + (bufoff) + ldsw + _i * 8192), 16, 0, 0); } while (0)
#define PG8_LDA(dst, b, h) do { _Pragma("unroll") for (int m = 0; m < 4; ++m) _Pragma("unroll") for (int k = 0; k < 2; ++k) dst[m][k] = *(const PG8_LAS bf16x8*)(lds + PG8_SA(b, h) + aoff + m * 2048 + k * 1024); } while (0)
#define PG8_LDB(dst, b, h) do { _Pragma("unroll") for (int n = 0; n < 2; ++n) _Pragma("unroll") for (int k = 0; k < 2; ++k) dst[n][k] = *(const PG8_LAS bf16x8*)(lds + PG8_SB(b, h) + boff + n * 2048 + k * 1024); } while (0)
#define PG8_MMA(ai, bj, At, Bt) do { __builtin_amdgcn_s_setprio(1); _Pragma("unroll") for (int m = 0; m < 4; ++m) _Pragma("unroll") for (int n = 0; n < 2; ++n) _Pragma("unroll") for (int k = 0; k < 2; ++k) \
        acc[ai][bj][m][n] = __builtin_amdgcn_mfma_f32_16x16x32_bf16(Bt[n][k], At[m][k], acc[ai][bj][m][n], 0, 0, 0); __builtin_amdgcn_s_setprio(0); } while (0)
#define PG8_WAIT_V(n) asm volatile("s_waitcnt vmcnt(" #n ")" ::: "memory")
#define PG8_WAIT_L(n) asm volatile("s_waitcnt lgkmcnt(" #n ")" ::: "memory")
#define PG8_BAR __builtin_amdgcn_s_barrier()
#define PG8_SCHED __builtin_amdgcn_sched_barrier(0)
    Unit cur, nxt; int ui = 0;
    if (!S.next(0, cur)) return;
    f32x4 acc[2][2][4][2];
#pragma unroll
    for (int a = 0; a < 2; ++a)
#pragma unroll
        for (int b = 0; b < 2; ++b)
#pragma unroll
            for (int m = 0; m < 4; ++m)
#pragma unroll
                for (int n = 0; n < 2; ++n) acc[a][b][m][n] = (f32x4){0.f, 0.f, 0.f, 0.f};
    bf16x8 At[4][2], B0[2][2], B1[2][2];
    const char* cA = (const char*)g.A + (size_t)tile_row(cur.pm) * K * 2; const char* cB = (const char*)g.Bt + (size_t)cur.pn * tstep;
    S.a_ready(cur);
    PG8_STAGE(PG8_SB(0, 0), cB, voffB); PG8_STAGE(PG8_SA(0, 0), cA, voffA); PG8_STAGE(PG8_SB(0, 1), cB + hstep, voffB); PG8_STAGE(PG8_SA(0, 1), cA + hstep, voffA);
    if (wr == 1) PG8_BAR;
    PG8_WAIT_V(4); PG8_BAR;
    PG8_STAGE(PG8_SB(1, 0), cB + kstep, voffB); PG8_STAGE(PG8_SA(1, 0), cA + kstep, voffA); PG8_STAGE(PG8_SB(1, 1), cB + hstep + kstep, voffB);
    PG8_WAIT_V(6); PG8_BAR;
    for (;;) {
        const bool has_next = S.next(ui + 1, nxt);
        const char* nA = has_next ? (const char*)g.A + (size_t)tile_row(nxt.pm) * K * 2 : cA; const char* nB = has_next ? (const char*)g.Bt + (size_t)nxt.pn * tstep : cB;
        for (int t = 0; t < nt; t += 2) {
            const bool last = (t == nt - 2);
            const char* a1 = cA + (size_t)(t + 1) * kstep;
            const char* a2 = last ? nA : cA + (size_t)(t + 2) * kstep; const char* b2 = last ? nB : cB + (size_t)(t + 2) * kstep;
            const char* a3 = a2 + kstep; const char* b3 = b2 + kstep;
            if (last && has_next) S.a_ready(nxt);
            PG8_LDB(B0, 0, 0); PG8_SCHED; PG8_LDA(At, 0, 0); PG8_STAGE(PG8_SA(1, 1), a1 + hstep, voffA);
            PG8_WAIT_L(8); PG8_BAR; PG8_WAIT_L(0); PG8_MMA(0, 0, At, B0); PG8_BAR; PG8_SCHED;
            PG8_LDB(B1, 0, 1); PG8_STAGE(PG8_SB(0, 0), b2, voffB);
            PG8_BAR; PG8_WAIT_L(0); PG8_MMA(0, 1, At, B1); PG8_BAR;
            PG8_LDA(At, 0, 1); PG8_STAGE(PG8_SA(0, 0), a2, voffA);
            PG8_BAR; PG8_WAIT_L(0); PG8_MMA(1, 0, At, B0); PG8_BAR; PG8_SCHED;
            PG8_STAGE(PG8_SB(0, 1), b2 + hstep, voffB);
            PG8_WAIT_V(6); PG8_BAR; PG8_MMA(1, 1, At, B1); PG8_BAR;
            PG8_LDB(B0, 1, 0); PG8_SCHED; PG8_LDA(At, 1, 0); PG8_STAGE(PG8_SA(0, 1), a2 + hstep, voffA);
            PG8_WAIT_L(8); PG8_BAR; PG8_WAIT_L(0); PG8_MMA(0, 0, At, B0); PG8_BAR; PG8_SCHED;
            PG8_LDB(B1, 1, 1); PG8_STAGE(PG8_SB(1, 0), b3, voffB);
            PG8_BAR; PG8_WAIT_L(0); PG8_MMA(0, 1, At, B1); PG8_BAR;
            PG8_LDA(At, 1, 1); PG8_STAGE(PG8_SA(1, 0), a3, voffA);
            PG8_BAR; PG8_WAIT_L(0); PG8_MMA(1, 0, At, B0); PG8_BAR; PG8_SCHED;
            PG8_STAGE(PG8_SB(1, 1), b3 + hstep, voffB);
            PG8_WAIT_V(6); PG8_BAR; PG8_MMA(1, 1, At, B1); PG8_BAR;
        }
        if constexpr (!Epi::AFTER_DRAIN) { E(acc, cur, wr, wc, fr, fq); S.done(cur); }
        if (!has_next) break;
#pragma unroll
        for (int a = 0; a < 2; ++a)
#pragma unroll
            for (int b = 0; b < 2; ++b)
#pragma unroll
                for (int m = 0; m < 4; ++m)
#pragma unroll
                    for (int n = 0; n < 2; ++n) acc[a][b][m][n] = (f32x4){0.f, 0.f, 0.f, 0.f};
        cur = nxt; cA = nA; cB = nB; ++ui;
    }
    PG8_WAIT_V(0);
    if (wr == 0) PG8_BAR;
    PG8_BAR;
    if constexpr (Epi::AFTER_DRAIN) { E.fused(acc, cur, wr, wc, fr, fq, lds, wid, lane); S.done(cur); }
#undef PG8_SA
#undef PG8_SB
#undef PG8_STAGE
#undef PG8_LDA
#undef PG8_LDB
#undef PG8_MMA
#undef PG8_WAIT_V
#undef PG8_WAIT_L
#undef PG8_BAR
#undef PG8_SCHED
}
}
__device__ __forceinline__ float row_rinv(const GAS float* ss, int row) {
    const GAS f32x4* p = (const GAS f32x4*)(ss + (size_t)row * 16);
    const f32x4 a = p[0], b = p[1], c = p[2], d = p[3];
    const float s = ((a[0] + a[1]) + (a[2] + a[3])) + ((b[0] + b[1]) + (b[2] + b[3])) + ((c[0] + c[1]) + (c[2] + c[3])) + ((d[0] + d[1]) + (d[2] + d[3]));
    return 1.0f / sqrtf(s * (1.0f / 1024.0f) + RMS_EPS);
}
struct EpiScale {
    static constexpr bool PERM = true, AFTER_DRAIN = false;
    GAS bf16_t* O0; int ld0; int split; GAS bf16_t* O1; int ld1; const GAS float* ss; GAS bf16_t* vT;
    const LAS float* rinv_lds; const LAS int* pm_lds;
    __device__ __forceinline__ void operator()(const f32x4 (&acc)[2][2][4][2], const pg8::Unit& u, int wr, int wc, int fr, int fq) const {
        asm volatile("" : "+v"(fr), "+v"(fq));
        const int row0 = pg8::tile_row(u.pm) + wr * 64 + fr; const int colt = u.pn * 256;
        GAS bf16_t* base; int ldc, c0;
        if (colt < split) { base = O0; ldc = ld0; c0 = colt; } else { base = O1; ldc = ld1; c0 = colt - split; }
        const int col0 = c0 + wc * 32 + 8 * fq;
        const bool dovt = (vT != nullptr) && (colt == 256);
        int uslot = 0;
#pragma unroll
        for (int q = 1; q < 4; ++q) if (pm_lds[q] == u.pm && pm_lds[0] != u.pm) uslot = (uslot == 0) ? q : uslot;
#pragma unroll
        for (int ai = 0; ai < 2; ++ai)
#pragma unroll
            for (int m = 0; m < 4; ++m) {
                const int row = row0 + ai * 128 + m * 16;
                const float ri = rinv_lds[uslot * 256 + wr * 64 + fr + ai * 128 + m * 16];
                GAS bf16_t* rowp = base + (size_t)row * ldc + col0;
#pragma unroll
                for (int bj = 0; bj < 2; ++bj) {
                    const f32x4 v0 = acc[ai][bj][m][0] * ri, v1 = acc[ai][bj][m][1] * ri;
                    u32x4 w; w.x = pk2(v0[0], v0[1]); w.y = pk2(v0[2], v0[3]); w.z = pk2(v1[0], v1[1]); w.w = pk2(v1[2], v1[3]);
                    *(GAS u32x4*)(rowp + bj * 128) = w;
                    if (dovt) {
                        const int b = row / TP, t = row - b * TP;
                        GAS bf16_t* vp = vT + ((size_t)(b * 2 + bj) * 128 + wc * 32 + 8 * fq) * TP + t;
                        vp[0 * TP] = (bf16_t)(w.x & 0xffff); vp[1 * TP] = (bf16_t)(w.x >> 16); vp[2 * TP] = (bf16_t)(w.y & 0xffff); vp[3 * TP] = (bf16_t)(w.y >> 16);
                        vp[4 * TP] = (bf16_t)(w.z & 0xffff); vp[5 * TP] = (bf16_t)(w.z >> 16); vp[6 * TP] = (bf16_t)(w.w & 0xffff); vp[7 * TP] = (bf16_t)(w.w >> 16);
                    }
                }
            }
    }
    __device__ __forceinline__ void tail(const f32x4 (&acc)[4], int b, int ng, int lane) const {
        const int colt = (ng * 64) & ~255; GAS bf16_t* base; int ldc, c0;
        if (colt < split) { base = O0; ldc = ld0; c0 = ng * 64; } else { base = O1; ldc = ld1; c0 = ng * 64 - split; }
        const bool dovt = (vT != nullptr) && (colt == 256);
#pragma unroll
        for (int i = 0; i < 4; ++i) {
            const int t = 4 * (lane >> 4) + i, row = b * TP + t; const float ri = row_rinv(ss, row);
#pragma unroll
            for (int nt = 0; nt < 4; ++nt) {
                const int col = c0 + nt * 16 + (lane & 15); const bf16_t w = (bf16_t)f2bf(acc[nt][i] * ri);
                base[(size_t)row * ldc + col] = w;
                if (dovt) { const int vc = ng * 64 - 256 + nt * 16 + (lane & 15); vT[((size_t)(b * 2 + (vc >> 7)) * 128 + (vc & 127)) * TP + t] = w; }
            }
        }
    }
};
struct EpiResid {
    static constexpr bool PERM = false, AFTER_DRAIN = false;
    GAS float* H; GAS bf16_t* HB; GAS float* ss; GAS unsigned char* HB8;
    __device__ __forceinline__ void operator()(const f32x4 (&acc)[2][2][4][2], const pg8::Unit& u, int wr, int wc, int fr, int fq) const {
        asm volatile("" : "+v"(fr), "+v"(fq));
        const int row0 = pg8::tile_row(u.pm) + wr * 64 + fr, col0 = u.pn * 256 + wc * 32 + 4 * fq;
        f32x4 hn[4];
#pragma unroll
        for (int q = 0; q < 4; ++q) hn[q] = *(const GAS f32x4*)(H + (size_t)row0 * 1024 + col0 + (q >> 1) * 128 + (q & 1) * 16);
#pragma unroll
        for (int gi = 0; gi < 8; ++gi) {
            const int ai = gi >> 2, m = gi & 3;
            const int row = row0 + ai * 128 + m * 16; float s = 0.f;
            GAS float* hp = H + (size_t)row * 1024 + col0; GAS bf16_t* bp = HB + (size_t)row * 1024 + col0;
            f32x4 hc[4];
#pragma unroll
            for (int q = 0; q < 4; ++q) hc[q] = hn[q];
            if (gi < 7) { const int rown = row0 + ((gi + 1) >> 2) * 128 + ((gi + 1) & 3) * 16;
#pragma unroll
                for (int q = 0; q < 4; ++q) hn[q] = *(const GAS f32x4*)(H + (size_t)rown * 1024 + col0 + (q >> 1) * 128 + (q & 1) * 16); }
#pragma unroll
            for (int bj = 0; bj < 2; ++bj)
#pragma unroll
                for (int n = 0; n < 2; ++n) {
                    const f32x4 hv = hc[bj * 2 + n] + acc[ai][bj][m][n];
                    *(GAS f32x4*)(hp + bj * 128 + n * 16) = hv;
                    s += (hv[0] * hv[0] + hv[1] * hv[1]) + (hv[2] * hv[2] + hv[3] * hv[3]);
                    u32x2 w; w.x = pk2(hv[0], hv[1]); w.y = pk2(hv[2], hv[3]);
                    *(GAS u32x2*)(bp + bj * 128 + n * 16) = w;
                }
            s += __shfl_xor(s, 16); s += __shfl_xor(s, 32);
            if (fq == 0) ss[(size_t)row * 16 + u.pn * 4 + wc] = s;
        }
    }
    __device__ __forceinline__ void tail(const f32x4 (&acc)[4], int b, int ng, int lane) const {
#pragma unroll
        for (int i = 0; i < 4; ++i) {
            const int t = 4 * (lane >> 4) + i, row = b * TP + t; float s = 0.f;
#pragma unroll
            for (int nt = 0; nt < 4; ++nt) {
                const int col = ng * 64 + nt * 16 + (lane & 15); const size_t o = (size_t)row * 1024 + col;
                const float hv = H[o] + acc[nt][i]; H[o] = hv; HB[o] = (bf16_t)f2bf(hv); s += hv * hv;
            }
            s += __shfl_xor(s, 1); s += __shfl_xor(s, 2); s += __shfl_xor(s, 4); s += __shfl_xor(s, 8);
            if ((lane & 15) == 0) ss[(size_t)row * 16 + ng] = s;
        }
    }
};

__device__ __forceinline__ int unit_pm_of(const pg8::StaticOrder& S, int i) {
    const long L = (long)i * S.G + S.c; if (L >= S.nwg) return -1;
    int wgid = (int)L; { const int q = S.nwg / pg8::NXCD, r = S.nwg % pg8::NXCD, xcd = wgid % pg8::NXCD, off = wgid / pg8::NXCD; wgid = (xcd < r ? xcd * (q + 1) : r * (q + 1) + (xcd - r) * q) + off; }
    const int nig = pg8::WGM * S.nN, gid = wgid / nig, fm = gid * pg8::WGM, gsz = (S.nM - fm) < pg8::WGM ? (S.nM - fm) : pg8::WGM;
    return fm + ((wgid % nig) % gsz);
}
template <class Epi>
__device__ __forceinline__ void gemm_tail(const GAS bf16_t* A, const GAS bf16_t* Bt, int N, const Epi& E, int gw, int NGW, int lane, LAS unsigned char* lds) {
    const int r = lane & 15, g = lane >> 4, njobs = BATCH * (N / 64);
    const int G_ = NGW / NWAVES, wv_ = gw % NWAVES, bk_ = gw / NWAVES;
    LAS f32x4* RED = (LAS f32x4*)lds;
#pragma unroll 1
    for (int job = bk_; job < njobs; job += G_) {
        const int b = job & 3, ng = job >> 2;
        const GAS bf16_t* ap = A + ((size_t)b * TP + r) * 1024 + 8 * g + wv_ * 128; const GAS bf16_t* bp = Bt + ((size_t)ng * 64 + r) * 1024 + 8 * g + wv_ * 128;
        bf16x8 af[4], bf[4][4];
#pragma unroll
        for (int ks = 0; ks < 4; ++ks) { af[ks] = *(const GAS bf16x8*)(ap + ks * 32);
#pragma unroll
            for (int nt = 0; nt < 4; ++nt) bf[nt][ks] = *(const GAS bf16x8*)(bp + (size_t)nt * 16 * 1024 + ks * 32); }
        f32x4 acc[4];
#pragma unroll
        for (int nt = 0; nt < 4; ++nt) { acc[nt] = (f32x4){0.f, 0.f, 0.f, 0.f};
#pragma unroll
            for (int ks = 0; ks < 4; ++ks) acc[nt] = MFMA16(af[ks], bf[nt][ks], acc[nt]); }
#pragma unroll
        for (int nt = 0; nt < 4; ++nt) RED[(wv_ * 4 + nt) * 64 + lane] = acc[nt];
        __syncthreads();
        if (wv_ == 0) {
#pragma unroll
            for (int nt = 0; nt < 4; ++nt) {
#pragma unroll
                for (int w = 1; w < 8; ++w) acc[nt] += RED[(w * 4 + nt) * 64 + lane];
            }
            E.tail(acc, b, ng, lane);
        }
        __syncthreads();
    }
}

struct Args {
    const float* in[17]; float* out; unsigned char* ws;
    double inv32[16]; double inv16[8];
};
struct Frame {
    LAS unsigned char* lds; GAS unsigned char* ws; int tid, lane, wave, G, gw, NGW;
};

__device__ __forceinline__ void p0_transpose_item(const float* W, int N, const float* gain, GAS bf16_t* WT, LAS float* scr, int item, int lane, int nblk) {
    const int kb = item / nblk, nb = item - kb * nblk, k0 = 64 * kb, n0 = 32 * nb;
    const int n = n0 + (lane & 31);
#pragma unroll 8
    for (int i = 0; i < 32; ++i) { const int kk = 2 * i + (lane >> 5); float v = 0.f; if (n < N) { v = W[(size_t)(k0 + kk) * N + n]; if (gain) v *= gain[k0 + kk]; } scr[kk * 33 + (lane & 31)] = v; }
    asm volatile("s_waitcnt lgkmcnt(0)" ::: "memory");
    const int c = lane & 7;
#pragma unroll
    for (int j = 0; j < 4; ++j) { const int nn = (lane >> 3) + 8 * j; const LAS float* s = scr + (8 * c) * 33 + nn;
        u32x4 o; o.x = pk2(s[0 * 33], s[1 * 33]); o.y = pk2(s[2 * 33], s[3 * 33]); o.z = pk2(s[4 * 33], s[5 * 33]); o.w = pk2(s[6 * 33], s[7 * 33]);
        *(GAS u32x4*)(WT + (size_t)(n0 + nn) * 1024 + k0 + 8 * c) = o; }
    asm volatile("s_waitcnt lgkmcnt(0)" ::: "memory");
}
__device__ __forceinline__ void sincos_rev(double ang, float& c, float& s) {
    double rev = ang * 0.15915494309189533577; rev -= rint(rev);
    const double r = rev * 6.28318530717958647692, r2 = r * r;
    double ts = r, ss = r, tc = 1.0, cc = 1.0;
#pragma unroll
    for (int k = 1; k <= 13; ++k) { tc *= -r2 / (double)((2 * k - 1) * (2 * k)); cc += tc; ts *= -r2 / (double)((2 * k) * (2 * k + 1)); ss += ts; }
    c = (float)cc; s = (float)ss;
}
__device__ __forceinline__ void phase_prologue(const Frame& F, const Args& a) {
    GAS unsigned char* ws = F.ws;
    {
        LAS float* scr = (LAS float*)(F.lds + F.wave * 8704);
        const float* a_norm = a.in[2]; const float* a_w_in = a.in[3]; const float* a_w_o = a.in[6]; const float* kv_norm = a.in[7]; const float* kv_w = a.in[8];
        const float* b_norm = a.in[9]; const float* b_w_q = a.in[10]; const float* b_w_o = a.in[11]; const float* ffn_norm = a.in[12]; const float* peer_w_q = a.in[13];
        constexpr int I2048 = 16 * 64, I1024 = 16 * 32, I512 = 16 * 16;
        constexpr int NITEMS = 2 * I2048 + 2 * I1024 + I512 + I1024 + I1024 + 2 * I1024 + 4 * I2048;
        for (int it = F.gw; it < NITEMS; it += F.NGW) {
            int r = it;
            if (r < 2 * I2048) { const int l = r / I2048; r -= l * I2048; p0_transpose_item(a_w_in + (size_t)l * 1024 * ACOLS, ACOLS, a_norm + l * 1024, (GAS bf16_t*)(ws + WS_WIN) + (size_t)l * 2048 * 1024, scr, r, F.lane, 64); continue; } r -= 2 * I2048;
            if (r < 2 * I1024) { const int l = r / I1024; r -= l * I1024; p0_transpose_item(a_w_o + (size_t)l * 1024 * 1024, 1024, nullptr, (GAS bf16_t*)(ws + WS_WOA) + (size_t)l * 1024 * 1024, scr, r, F.lane, 32); continue; } r -= 2 * I1024;
            if (r < I512) { p0_transpose_item(kv_w, 512, kv_norm, (GAS bf16_t*)(ws + WS_WKVQ), scr, r, F.lane, 16); continue; } r -= I512;
            if (r < I1024) { p0_transpose_item(b_w_q, 1024, b_norm, (GAS bf16_t*)(ws + WS_WKVQ) + (size_t)512 * 1024, scr, r, F.lane, 32); continue; } r -= I1024;
            if (r < I1024) { p0_transpose_item(b_w_q + (size_t)1024 * 1024, 1024, b_norm + 1024, (GAS bf16_t*)(ws + WS_WBQ1), scr, r, F.lane, 32); continue; } r -= I1024;
            if (r < 2 * I1024) { const int l = r / I1024; r -= l * I1024; p0_transpose_item(b_w_o + (size_t)l * 1024 * 1024, 1024, nullptr, (GAS bf16_t*)(ws + WS_WOB) + (size_t)l * 1024 * 1024, scr, r, F.lane, 32); continue; } r -= 2 * I1024;
            { const int l = r / I2048; r -= l * I2048; p0_transpose_item(peer_w_q + (size_t)l * 1024 * 2048, 2048, ffn_norm + l * 1024, (GAS bf16_t*)(ws + WS_WPQ) + (size_t)l * 2048 * 1024, scr, r, F.lane, 64); }
        }
    }
    const size_t gtid = (size_t)blockIdx.x * NT + F.tid, gthreads = (size_t)F.G * NT;
    {
        const float* pu = a.in[15]; const float* pv = a.in[16]; const float* ffn_norm = a.in[12];
        GAS unsigned char* U = (GAS unsigned char*)(ws + WS_U); GAS unsigned char* V = (GAS unsigned char*)(ws + WS_V);
        const int lane = F.lane;
#pragma unroll 1
        for (int l = 0; l < 4; ++l) {
            f32x4 gq[4];
#pragma unroll
            for (int q = 0; q < 4; ++q) gq[q] = *(const f32x4*)(ffn_norm + l * 1024 + 256 * q + 4 * lane) * U_SCALE;
#pragma unroll 2
            for (int ex = F.gw; ex < NEXP; ex += F.NGW) {
                const size_t ro = ((size_t)l * NEXP + ex) * 1024 + 4 * lane;
                f32x4 u4[4], v4[4];
#pragma unroll
                for (int q = 0; q < 4; ++q) { u4[q] = __builtin_nontemporal_load((const f32x4*)(pu + ro + 256 * q)); v4[q] = __builtin_nontemporal_load((const f32x4*)(pv + ro + 256 * q)); }
#pragma unroll
                for (int q = 0; q < 4; ++q) {
                    f32x4 u0 = u4[q] * gq[q], v0 = v4[q] * V_SCALE;
#pragma unroll
                    for (int k = 0; k < 4; ++k) { u0[k] = fminf(fmaxf(u0[k], -416.f), 416.f); v0[k] = fminf(fmaxf(v0[k], -416.f), 416.f); }
                    int wu = __builtin_amdgcn_cvt_pk_fp8_f32(u0[0], u0[1], 0, false); wu = __builtin_amdgcn_cvt_pk_fp8_f32(u0[2], u0[3], wu, true);
                    int wv = __builtin_amdgcn_cvt_pk_fp8_f32(v0[0], v0[1], 0, false); wv = __builtin_amdgcn_cvt_pk_fp8_f32(v0[2], v0[3], wv, true);
                    const size_t so = (((size_t)l * 8 + 2 * q + (lane >> 5)) * NEXP + ex) * 128 + 4 * (lane & 31);
                    *(GAS unsigned*)(U + so) = (unsigned)wu; *(GAS unsigned*)(V + so) = (unsigned)wv;
                }
            }
        }
    }
    { const float* sk = a.in[14]; GAS bf16_t* o = (GAS bf16_t*)(ws + WS_SK); for (size_t i = gtid; i < (size_t)4 * 2 * 128 * 128; i += gthreads) o[i] = (bf16_t)f2bf(sk[i]); }
    {
        GAS f32x2* r32 = (GAS f32x2*)(ws + WS_ROPE32); GAS f32x2* r16 = (GAS f32x2*)(ws + WS_ROPE16);
        for (size_t i = gtid; i < (size_t)TP * 24; i += gthreads) {
            const int t = (int)(i / 24), j = (int)(i - (size_t)t * 24); float c, s;
            if (j < 16) { sincos_rev((double)t * a.inv32[j], c, s); r32[t * 16 + j] = (f32x2){c, s}; }
            else { sincos_rev((double)t * a.inv16[j - 16], c, s); r16[t * 8 + (j - 16)] = (f32x2){c, s}; }
        }
    }
    {
        const float* x = a.in[0]; const float* meta = a.in[1];
        GAS float* H = (GAS float*)(ws + WS_H); GAS bf16_t* HB = (GAS bf16_t*)(ws + WS_HB); GAS float* SS = (GAS float*)(ws + WS_SS); GAS bf16_t* O = (GAS bf16_t*)(ws + WS_O);
        for (int row = F.gw; row < NR; row += F.NGW) {
            const int b = row / TP, t = row - b * TP;
            f32x4 v[4]; float s = 0.f;
#pragma unroll
            for (int j = 0; j < 4; ++j) {
                if (t < NMETA) v[j] = *(const f32x4*)(meta + (size_t)t * 1024 + 256 * j + 4 * F.lane);
                else if (t < TT) v[j] = *(const f32x4*)(x + ((size_t)b * SEQ + (t - NMETA)) * 1024 + 256 * j + 4 * F.lane);
                else v[j] = (f32x4){0.f, 0.f, 0.f, 0.f};
                s += (v[j][0] * v[j][0] + v[j][1] * v[j][1]) + (v[j][2] * v[j][2] + v[j][3] * v[j][3]);
            }
            s = wave_sum(s);
#pragma unroll
            for (int j = 0; j < 4; ++j) {
                *(GAS f32x4*)(H + (size_t)row * 1024 + 256 * j + 4 * F.lane) = v[j];
                u32x2 w; w.x = pk2(v[j][0], v[j][1]); w.y = pk2(v[j][2], v[j][3]);
                *(GAS u32x2*)(HB + (size_t)row * 1024 + 256 * j + 4 * F.lane) = w;
                if (t >= TT) *(GAS u32x2*)(O + (size_t)row * 1024 + 256 * j + 4 * F.lane) = (u32x2){0u, 0u};
            }
            if (F.lane < 16) SS[(size_t)row * 16 + F.lane] = (F.lane == 0) ? s : 0.f;
        }
    }
}
#ifndef TRB8_HYP
#define TRB8_HYP 0
#endif
#if TRB8_HYP == 0
#define TRB8_ROW(r) ((r) >> 1)
#define TRB8_COL(r) ((r) & 1)
#else
#define TRB8_ROW(r) ((r) & 7)
#define TRB8_COL(r) ((r) >> 3)
#endif
__device__ __forceinline__ void unpack8(const u32x4& w, float (&x)[8]) {
#pragma unroll
    for (int k = 0; k < 4; ++k) { x[2 * k] = bflo(w[k]); x[2 * k + 1] = bfhi(w[k]); }
}
__device__ __forceinline__ u32x4 pack8(const float (&x)[8]) { u32x4 w; w.x = pk2(x[0], x[1]); w.y = pk2(x[2], x[3]); w.z = pk2(x[4], x[5]); w.w = pk2(x[6], x[7]); return w; }
__device__ __forceinline__ void phase_a_post(const Frame& F, const float* qgain, const float* kgain) {
    GAS unsigned char* ws = F.ws;
    const GAS bf16_t* PROJ = (const GAS bf16_t*)(ws + WS_PROJ);
    GAS unsigned char* Q8 = ws + WS_Q8; GAS unsigned char* K8 = ws + WS_K8; GAS unsigned char* V8 = ws + WS_V8; GAS bf16_t* QI = (GAS bf16_t*)(ws + WS_QI); GAS bf16_t* KI = (GAS bf16_t*)(ws + WS_KI); GAS float* WI = (GAS float*)(ws + WS_WI);
    const GAS f32x2* r32 = (const GAS f32x2*)(ws + WS_ROPE32); const GAS f32x2* r16 = (const GAS f32x2*)(ws + WS_ROPE16);
    const int lane = F.lane, l16 = lane & 15;
    float qg[8], kg[8];
#pragma unroll
    for (int j = 0; j < 8; ++j) { qg[j] = qgain[l16 * 8 + j]; kg[j] = kgain[l16 * 8 + j]; }
    for (int rown = F.gw; rown < BATCH * TT; rown += F.NGW) {
        const int b = rown / TT, t = rown - b * TT; const int row = b * TP + t;
        const GAS bf16_t* pr = PROJ + (size_t)row * 2048;
        const u32x4 wA = *(const GAS u32x4*)(pr + 8 * lane), wB = *(const GAS u32x4*)(pr + 512 + 8 * lane), wC = *(const GAS u32x4*)(pr + 1024 + 8 * lane), wD = *(const GAS u32x4*)(pr + 1536 + 8 * lane);
        f32x2 cs32[8], cs16[8];
#pragma unroll
        for (int j = 0; j < 8; ++j) { cs32[j] = r32[t * 16 + (lane & 1) * 8 + j]; cs16[j] = r16[t * 8 + j]; }
#pragma unroll
        for (int gp = 0; gp < 3; ++gp) {
            float x[8]; unpack8(gp == 0 ? wA : (gp == 1 ? wB : wC), x);
            float ssq = 0.f;
#pragma unroll
            for (int j = 0; j < 8; ++j) ssq += x[j] * x[j];
            ssq += __shfl_xor(ssq, 1); ssq += __shfl_xor(ssq, 2); ssq += __shfl_xor(ssq, 4); ssq += __shfl_xor(ssq, 8);
            const float ri = 1.0f / sqrtf(ssq * (1.0f / 128.0f) + RMS_EPS);
            const bool rot = l16 < 4, second = (lane & 2) != 0;
#pragma unroll
            for (int j = 0; j < 8; ++j) {
                float y = x[j] * ri * (gp < 2 ? qg[j] : kg[j]);
                const float p = __shfl_xor(y, 2);
                if (rot) y = second ? (y * cs32[j].x + p * cs32[j].y) : (y * cs32[j].x - p * cs32[j].y);
                x[j] = (gp < 2) ? y * 0.08838834764831845f : y;
            }
            {
                const float sc = (gp < 2) ? Q_SCALE : K_SCALE; float y8[8];
#pragma unroll
                for (int j = 0; j < 8; ++j) y8[j] = fminf(fmaxf(x[j] * sc, -416.f), 416.f);
                int w0 = __builtin_amdgcn_cvt_pk_fp8_f32(y8[0], y8[1], 0, false); w0 = __builtin_amdgcn_cvt_pk_fp8_f32(y8[2], y8[3], w0, true);
                int w1 = __builtin_amdgcn_cvt_pk_fp8_f32(y8[4], y8[5], 0, false); w1 = __builtin_amdgcn_cvt_pk_fp8_f32(y8[6], y8[7], w1, true);
                if (gp < 2) *(GAS u32x2*)(Q8 + (size_t)row * 1024 + gp * 512 + 8 * lane) = (u32x2){(unsigned)w0, (unsigned)w1};
                else if (lane < 32) *(GAS u32x2*)(K8 + (size_t)row * 256 + 8 * lane) = (u32x2){(unsigned)w0, (unsigned)w1};
            }
            if (gp == 2 && lane >= 32) {
                float xv[8]; unpack8(wC, xv);
#pragma unroll
                for (int j = 0; j < 8; ++j) xv[j] = fminf(fmaxf(xv[j] * V8_SCALE, -416.f), 416.f);
                int w0 = __builtin_amdgcn_cvt_pk_fp8_f32(xv[0], xv[1], 0, false); w0 = __builtin_amdgcn_cvt_pk_fp8_f32(xv[2], xv[3], w0, true);
                int w1 = __builtin_amdgcn_cvt_pk_fp8_f32(xv[4], xv[5], 0, false); w1 = __builtin_amdgcn_cvt_pk_fp8_f32(xv[6], xv[7], w1, true);
                *(GAS u32x2*)(V8 + (size_t)row * 256 + 8 * (lane - 32)) = (u32x2){(unsigned)w0, (unsigned)w1};
            }
        }
        {
            float x[8]; unpack8(wD, x);
            const bool rot = (lane & 7) < 2 && lane < 40, second = (lane & 1) != 0;
#pragma unroll
            for (int j = 0; j < 8; ++j) {
                float y = x[j]; const float p = __shfl_xor(y, 1);
                if (rot) y = second ? (y * cs16[j].x + p * cs16[j].y) : (y * cs16[j].x - p * cs16[j].y);
                x[j] = (lane < 32) ? y * 0.125f : y;
            }
            if (lane < 32) *(GAS u32x4*)(QI + (size_t)row * 256 + 8 * lane) = pack8(x);
            else if (lane < 40) *(GAS u32x4*)(KI + (size_t)row * 64 + 8 * (lane - 32)) = pack8(x);
            else if (lane == 40) *(GAS f32x4*)(WI + (size_t)row * 4) = (f32x4){x[0] * 0.5f, x[1] * 0.5f, x[2] * 0.5f, x[3] * 0.5f};
        }
    }
}

constexpr int SCS = 4232;
constexpr int DSA_SC = 0, DSA_HIST = 8 * SCS * 4, DSA_SEL = DSA_HIST + 8 * 256 * 4;
__device__ __forceinline__ int wave_incl_scan(int v, int lane) {
#pragma unroll
    for (int o = 1; o < 64; o <<= 1) { const int t = __shfl_up(v, o); if (lane >= o) v += t; }
    return v;
}
__device__ __forceinline__ void phase_dsa_sel(const Frame& F) {
    GAS unsigned char* ws = F.ws;
    GAS bf16_t* SELG = (GAS bf16_t*)(ws + WS_SELG); const GAS bf16_t* QI = (const GAS bf16_t*)(ws + WS_QI);
    const GAS bf16_t* KI = (const GAS bf16_t*)(ws + WS_KI); const GAS float* WI = (const GAS float*)(ws + WS_WI);
    LAS unsigned* SC = (LAS unsigned*)(F.lds + DSA_SC); LAS unsigned* HIST = (LAS unsigned*)(F.lds + DSA_HIST) + F.wave * 256; LAS unsigned* SEL = (LAS unsigned*)(F.lds + DSA_SEL) + F.wave * 256;
    const int lane = F.lane, wave = F.wave, r = lane & 15, g = lane >> 4;
    const unsigned long long ltmask = (1ull << lane) - 1ull;
    constexpr int NITEM = BATCH * (TT / 8), NFIRST = (NITEM / 256) * 256;
    for (int it = blockIdx.x; it < NITEM; it += F.G) {
        const int b = it & 3, qb = (it < NFIRST) ? (it >> 2) + (NITEM - NFIRST) / 4 : (it - NFIRST) >> 2, t0 = qb * 8, nkeys = t0 + 8;
        const size_t rb = (size_t)b * TP;
        {
            bf16x8 A[2][2]; f32x4 wv[2];
#pragma unroll
            for (int mt = 0; mt < 2; ++mt) {
                const GAS bf16_t* qp = QI + (rb + t0 + 4 * mt + (r >> 2)) * 256 + (r & 3) * 64 + 8 * g;
                A[mt][0] = *(const GAS bf16x8*)qp; A[mt][1] = *(const GAS bf16x8*)(qp + 32);
                wv[mt] = *(const GAS f32x4*)(WI + (rb + t0 + 4 * mt + g) * 4);
            }
            const int ntile = (nkeys + 15) >> 4;
            LAS unsigned char* KTL = F.lds + DSA_HIST + wave * 2048;
            const int kq8 = lane >> 3, c8 = lane & 7;
#pragma unroll 1
            for (int kt0 = wave; kt0 < ntile; kt0 += 32) {
                u32x4 kl[4][2];
#pragma unroll
                for (int u = 0; u < 4; ++u)
#pragma unroll
                    for (int h = 0; h < 2; ++h) kl[u][h] = *(const GAS u32x4*)(KI + (rb + (kt0 + 8 * u) * 16 + 8 * h + kq8) * 64 + 8 * c8);
#pragma unroll
                for (int u = 0; u < 4; ++u) {
                    const int kt = kt0 + 8 * u;
                    if (kt < ntile) {
#pragma unroll
                        for (int h = 0; h < 2; ++h) { const int rw = 8 * h + kq8; *(LAS u32x4*)(KTL + rw * 128 + ((c8 ^ (rw & 7)) << 4)) = kl[u][h]; }
                        const bf16x8 B0 = *(const LAS bf16x8*)(KTL + r * 128 + ((g ^ (r & 7)) << 4)), B1 = *(const LAS bf16x8*)(KTL + r * 128 + (((4 + g) ^ (r & 7)) << 4));
                        const int key = kt * 16 + r;
#pragma unroll
                        for (int mt = 0; mt < 2; ++mt) {
                            f32x4 d = (f32x4){0.f, 0.f, 0.f, 0.f};
                            d = MFMA16(A[mt][0], B0, d); d = MFMA16(A[mt][1], B1, d);
                            float s = fmaxf(d[0], 0.f) * wv[mt][0] + fmaxf(d[1], 0.f) * wv[mt][1] + fmaxf(d[2], 0.f) * wv[mt][2] + fmaxf(d[3], 0.f) * wv[mt][3];
                            if (s == 0.f) s = 0.f;
                            const int qpos = t0 + 4 * mt + g;
                            SC[(4 * mt + g) * SCS + key] = (key <= qpos) ? mono_key(s) : 0u;
                        }
                    }
                }
            }
        }
        __syncthreads();
        const int qpos = t0 + wave, n = qpos + 1;
        LAS unsigned* row = SC + wave * SCS;
        int cnt;
        if (n <= TOPK) { for (int i = lane; i < TOPK; i += 64) SEL[i] = (i < n) ? (unsigned)i : 0u; cnt = n; }
        else {
            unsigned kreg[65];
#pragma unroll
            for (int c = 0; c < 65; ++c) { const int i = 64 * c + lane; kreg[c] = (i < n) ? row[i] : 0u; }
            const int nch = (n + 63) >> 6;
            unsigned prefix = 0u, mask = 0u; int want = TOPK;
#pragma unroll 1
            for (int pass = 3; pass >= 0; --pass) {
                const int sh = pass * 8;
#pragma unroll
                for (int i = 0; i < 4; ++i) HIST[lane + 64 * i] = 0u;
#pragma unroll
                for (int cb = 0; cb < 65; cb += 13) {
                    if (cb < nch) {
#pragma unroll
                        for (int c = cb; c < cb + 13; ++c) { const unsigned k = kreg[c]; if ((64 * c + lane) < n && (k & mask) == prefix) __hip_atomic_fetch_add(&HIST[(k >> sh) & 255u], 1u, __ATOMIC_RELAXED, __HIP_MEMORY_SCOPE_WORKGROUP); }
                    }
                }
                asm volatile("s_waitcnt lgkmcnt(0)" ::: "memory");
                const int h0 = (int)HIST[255 - 4 * lane], h1 = (int)HIST[254 - 4 * lane], h2 = (int)HIST[253 - 4 * lane], h3 = (int)HIST[252 - 4 * lane];
                const int local = h0 + h1 + h2 + h3, incl = wave_incl_scan(local, lane), excl = incl - local;
                const bool here = (excl < want) && (want <= incl);
                int bin = 0, above = 0;
                if (here) { int c = excl;
                    if (c + h0 >= want) { bin = 255 - 4 * lane; above = c; } else { c += h0;
                    if (c + h1 >= want) { bin = 254 - 4 * lane; above = c; } else { c += h1;
                    if (c + h2 >= want) { bin = 253 - 4 * lane; above = c; } else { c += h2; bin = 252 - 4 * lane; above = c; } } } }
                const unsigned long long bm = __ballot(here);
                const int src = (int)__builtin_ctzll(bm);
                bin = __shfl(bin, src); above = __shfl(above, src);
                want -= above; prefix |= (unsigned)bin << sh; mask |= 0xFFu << sh;
            }
            const unsigned T = prefix; const int need = want;
            int outbase = 0, eqbase = 0;
#pragma unroll
            for (int cb = 0; cb < 65; cb += 13) {
                if (cb < nch) {
#pragma unroll
                    for (int c = cb; c < cb + 13; ++c) {
                        const int i = 64 * c + lane; const unsigned k = kreg[c];
                        const bool gt = k > T, eq = (k == T) && (i < n);
                        const unsigned long long beq = __ballot(eq);
                        const int eqrank = eqbase + __popcll(beq & ltmask);
                        const bool take = gt || (eq && eqrank < need);
                        const unsigned long long bt = __ballot(take);
                        const int pos = outbase + __popcll(bt & ltmask);
                        if (take && pos < TOPK) SEL[pos] = (unsigned)i;
                        outbase += __popcll(bt); eqbase += __popcll(beq);
                    }
                }
            }
            cnt = TOPK;
        }
        asm volatile("s_waitcnt lgkmcnt(0)" ::: "memory");
        { const unsigned s0 = SEL[4 * lane], s1 = SEL[4 * lane + 1], s2 = SEL[4 * lane + 2], s3 = SEL[4 * lane + 3];
          *(GAS u32x2*)(SELG + (rb + qpos) * 256 + 4 * lane) = (u32x2){s0 | (s1 << 16), s2 | (s3 << 16)}; }
        (void)cnt;
        __syncthreads();
    }
}

__device__ __forceinline__ void phase_dsa_attn(const Frame& F) {
    GAS unsigned char* ws = F.ws;
    const GAS unsigned char* Q8 = ws + WS_Q8; const GAS unsigned char* K8 = ws + WS_K8; const GAS unsigned char* V8 = ws + WS_V8; const GAS bf16_t* SELG = (const GAS bf16_t*)(ws + WS_SELG); GAS bf16_t* O = (GAS bf16_t*)(ws + WS_O);
    const int lane = F.lane, wave = F.wave, r = lane & 15, g = lane >> 4;
    volatile LAS unsigned* MISC = (volatile LAS unsigned*)(F.lds + MISC_OFF);
    const int xp = (int)MISC[4], nx = (int)MISC[5], xrank = (int)MISC[6], xn = (int)MISC[7];
    LAS unsigned* SEL = (LAS unsigned*)(F.lds) + wave * 256; LAS float* Pb = (LAS float*)(F.lds + 8192) + wave * 1024; LAS unsigned char* KT = F.lds + 40960 + wave * 8704; LAS unsigned char* PT8 = F.lds + 110592 + wave * 1024;
    const int wrank = xrank * NWAVES + wave, nw = xn * NWAVES;
#pragma unroll 1
    for (int P = xp; P < 2 * BATCH; P += nx) {
        const int b = P >> 1, kvh = P & 1;
        const size_t rb = (size_t)b * TP;
#pragma unroll 1
        for (int qpos = wrank; qpos < TT; qpos += nw) {
            const size_t qrow = rb + qpos;
            const int cnt = (qpos + 1 < TOPK) ? qpos + 1 : TOPK;
            { const u32x2 sw = *(const GAS u32x2*)(SELG + qrow * 256 + 4 * lane);
              SEL[4 * lane] = sw.x & 0xffffu; SEL[4 * lane + 1] = sw.x >> 16; SEL[4 * lane + 2] = sw.y & 0xffffu; SEL[4 * lane + 3] = sw.y >> 16; }
            asm volatile("s_waitcnt lgkmcnt(0)" ::: "memory");
            long Aq[4];
            {
                const GAS unsigned char* qp = Q8 + qrow * 1024 + (kvh * 4 + (r & 3)) * 128 + g * 32;
                u32x4 q0 = *(const GAS u32x4*)qp, q1 = *(const GAS u32x4*)(qp + 16);
                if (r >= 4) { q0 = (u32x4){0u, 0u, 0u, 0u}; q1 = q0; }
                Aq[0] = (long)(((unsigned long long)q0.y << 32) | q0.x); Aq[1] = (long)(((unsigned long long)q0.w << 32) | q0.z);
                Aq[2] = (long)(((unsigned long long)q1.y << 32) | q1.x); Aq[3] = (long)(((unsigned long long)q1.w << 32) | q1.z);
            }
#ifndef NO_QK
            {
                const int kq8 = lane >> 3, c8 = lane & 7;
                const GAS unsigned char* kbase = K8 + rb * 256 + kvh * 128 + 16 * c8;
                u32x4 ka[4], kb2[4];
#define DSA_LOADK(buf, st) do { _Pragma("unroll") for (int u_ = 0; u_ < 4; ++u_) { const int key_ = (int)SEL[(st) * 32 + 8 * u_ + kq8]; buf[u_] = *(const GAS u32x4*)(kbase + (size_t)key_ * 256); } } while (0)
#define DSA_QKSTEP(buf, st) do { _Pragma("unroll") for (int u_ = 0; u_ < 4; ++u_) *(LAS u32x4*)(KT + (8 * u_ + kq8) * 144 + 16 * c8) = buf[u_]; \
                    _Pragma("unroll") for (int h_ = 0; h_ < 2; ++h_) { f32x4 d_ = (f32x4){0.f, 0.f, 0.f, 0.f}; \
                        const u32x4 k0_ = *(const LAS u32x4*)(KT + (16 * h_ + r) * 144 + g * 32), k1_ = *(const LAS u32x4*)(KT + (16 * h_ + r) * 144 + g * 32 + 16); \
                        d_ = __builtin_amdgcn_mfma_f32_16x16x32_fp8_fp8(Aq[0], (long)(((unsigned long long)k0_.y << 32) | k0_.x), d_, 0, 0, 0); \
                        d_ = __builtin_amdgcn_mfma_f32_16x16x32_fp8_fp8(Aq[1], (long)(((unsigned long long)k0_.w << 32) | k0_.z), d_, 0, 0, 0); \
                        d_ = __builtin_amdgcn_mfma_f32_16x16x32_fp8_fp8(Aq[2], (long)(((unsigned long long)k1_.y << 32) | k1_.x), d_, 0, 0, 0); \
                        d_ = __builtin_amdgcn_mfma_f32_16x16x32_fp8_fp8(Aq[3], (long)(((unsigned long long)k1_.w << 32) | k1_.z), d_, 0, 0, 0); \
                        d_ *= (1.0f / (Q_SCALE * K_SCALE)); \
                        const int kk_ = (st) * 32 + 16 * h_ + r; if (kk_ >= cnt) d_ = (f32x4){-INFINITY, -INFINITY, -INFINITY, -INFINITY}; \
                        if (g == 0) *(LAS f32x4*)(Pb + kk_ * 4) = d_; } } while (0)
                DSA_LOADK(ka, 0);
#pragma unroll 1
                for (int st = 0; st < 8; st += 2) {
                    DSA_LOADK(kb2, st + 1);
                    DSA_QKSTEP(ka, st);
                    if (st + 2 < 8) DSA_LOADK(ka, st + 2);
                    DSA_QKSTEP(kb2, st + 1);
                }
            }
#endif
            asm volatile("s_waitcnt lgkmcnt(0)" ::: "memory");
            {
                f32x4 sv[4];
#pragma unroll
                for (int j = 0; j < 4; ++j) sv[j] = *(const LAS f32x4*)(Pb + (lane + 64 * j) * 4);
                float mx[4], sm[4];
#pragma unroll
                for (int i = 0; i < 4; ++i) { float m = fmaxf(fmaxf(sv[0][i], sv[1][i]), fmaxf(sv[2][i], sv[3][i]));
#pragma unroll
                    for (int o = 1; o < 64; o <<= 1) m = fmaxf(m, __shfl_xor(m, o));
                    mx[i] = m; }
#pragma unroll
                for (int i = 0; i < 4; ++i) { float t = 0.f;
#pragma unroll
                    for (int j = 0; j < 4; ++j) { const float e = __expf(sv[j][i] - mx[i]); sv[j][i] = e; t += e; }
                    sm[i] = 1.0f / wave_sum(t); }
#pragma unroll
                for (int j = 0; j < 4; ++j)
#pragma unroll
                    for (int i = 0; i < 4; ++i) { const int w8 = __builtin_amdgcn_cvt_pk_fp8_f32(sv[j][i] * sm[i] * P8_SCALE, 0.f, 0, false); PT8[i * 256 + lane + 64 * j] = (unsigned char)(w8 & 0xff); }
            }
            asm volatile("s_waitcnt lgkmcnt(0)" ::: "memory");
#ifndef NO_PV
            {
                const int kq8 = lane >> 3, c8 = lane & 7;
                const GAS unsigned char* vbase = V8 + rb * 256 + kvh * 128 + 16 * c8;
                f32x4 Od[8];
#pragma unroll
                for (int c = 0; c < 8; ++c) Od[c] = (f32x4){0.f, 0.f, 0.f, 0.f};
                const unsigned vt_lane = (unsigned)(size_t)KT + (unsigned)((8 * g + TRB8_ROW(r)) * 144 + 8 * TRB8_COL(r));
                u32x4 va[4], vb[4];
#define DSA_LOADV(buf, ks) do { _Pragma("unroll") for (int u_ = 0; u_ < 4; ++u_) { const int key_ = (int)SEL[(ks) * 32 + 8 * u_ + kq8]; buf[u_] = *(const GAS u32x4*)(vbase + (size_t)key_ * 256); } } while (0)
#define DSA_PVSTEP(buf, ks) do { _Pragma("unroll") for (int u_ = 0; u_ < 4; ++u_) *(LAS u32x4*)(KT + (8 * u_ + kq8) * 144 + 16 * c8) = buf[u_]; \
                    const u32x2 pw_ = *(const LAS u32x2*)(PT8 + (r & 3) * 256 + (ks) * 32 + 8 * g); const long pa_ = (long)(((unsigned long long)pw_.y << 32) | pw_.x); \
                    long t0_, t1_, t2_, t3_, t4_, t5_, t6_, t7_; \
                    asm volatile("ds_read_b64_tr_b8 %0, %8\n\tds_read_b64_tr_b8 %1, %8 offset:16\n\tds_read_b64_tr_b8 %2, %8 offset:32\n\tds_read_b64_tr_b8 %3, %8 offset:48\n\t" \
                                 "ds_read_b64_tr_b8 %4, %8 offset:64\n\tds_read_b64_tr_b8 %5, %8 offset:80\n\tds_read_b64_tr_b8 %6, %8 offset:96\n\tds_read_b64_tr_b8 %7, %8 offset:112\n\t" \
                                 "s_waitcnt lgkmcnt(0)" \
                                 : "=&v"(t0_), "=&v"(t1_), "=&v"(t2_), "=&v"(t3_), "=&v"(t4_), "=&v"(t5_), "=&v"(t6_), "=&v"(t7_) : "v"(vt_lane) : "memory"); \
                    __builtin_amdgcn_sched_barrier(0); \
                    Od[0] = __builtin_amdgcn_mfma_f32_16x16x32_fp8_fp8(pa_, t0_, Od[0], 0, 0, 0); Od[1] = __builtin_amdgcn_mfma_f32_16x16x32_fp8_fp8(pa_, t1_, Od[1], 0, 0, 0); \
                    Od[2] = __builtin_amdgcn_mfma_f32_16x16x32_fp8_fp8(pa_, t2_, Od[2], 0, 0, 0); Od[3] = __builtin_amdgcn_mfma_f32_16x16x32_fp8_fp8(pa_, t3_, Od[3], 0, 0, 0); \
                    Od[4] = __builtin_amdgcn_mfma_f32_16x16x32_fp8_fp8(pa_, t4_, Od[4], 0, 0, 0); Od[5] = __builtin_amdgcn_mfma_f32_16x16x32_fp8_fp8(pa_, t5_, Od[5], 0, 0, 0); \
                    Od[6] = __builtin_amdgcn_mfma_f32_16x16x32_fp8_fp8(pa_, t6_, Od[6], 0, 0, 0); Od[7] = __builtin_amdgcn_mfma_f32_16x16x32_fp8_fp8(pa_, t7_, Od[7], 0, 0, 0); } while (0)
                DSA_LOADV(va, 0);
#pragma unroll 1
                for (int ks = 0; ks < 8; ks += 2) {
                    DSA_LOADV(vb, ks + 1);
                    DSA_PVSTEP(va, ks);
                    if (ks + 2 < 8) DSA_LOADV(va, ks + 2);
                    DSA_PVSTEP(vb, ks + 1);
                }
                if (g == 0) {
#pragma unroll
                    for (int c = 0; c < 8; ++c)
#pragma unroll
                        for (int i = 0; i < 4; ++i) Pb[i * 128 + c * 16 + r] = Od[c][i] * (1.0f / (P8_SCALE * V8_SCALE));
                }
                asm volatile("s_waitcnt lgkmcnt(0)" ::: "memory");
                { const int kq = lane >> 4, c16 = lane & 15;
                  const f32x4 o0 = *(const LAS f32x4*)(Pb + kq * 128 + 8 * c16), o1 = *(const LAS f32x4*)(Pb + kq * 128 + 8 * c16 + 4);
                  u32x4 w; w.x = pk2(o0[0], o0[1]); w.y = pk2(o0[2], o0[3]); w.z = pk2(o1[0], o1[1]); w.w = pk2(o1[2], o1[3]);
                  *(GAS u32x4*)(O + qrow * 1024 + (kvh * 4 + kq) * 128 + 8 * c16) = w; }
            }
#endif
            asm volatile("s_waitcnt lgkmcnt(0)" ::: "memory");
            asm volatile("s_waitcnt lgkmcnt(0)" ::: "memory");
        }
    }
}

__device__ __forceinline__ float softplus_f(float z) { return fmaxf(z, 0.f) + __logf(1.0f + __expf(-fabsf(z))); }
__device__ __forceinline__ void phase_stick(const Frame& F) {
    GAS unsigned char* ws = F.ws;
    const GAS bf16_t* BQ = (const GAS bf16_t*)(ws + WS_Q); const GAS bf16_t* SKV = (const GAS bf16_t*)(ws + WS_SKV); const GAS bf16_t* VT = (const GAS bf16_t*)(ws + WS_VT); GAS bf16_t* O = (GAS bf16_t*)(ws + WS_O);
    const int lane = F.lane, r = lane & 15, g = lane >> 4;
    constexpr int NQT = TT / 16;
    constexpr int NH = 2;
    for (int it = F.gw; it < BATCH * (8 / NH) * NQT; it += F.NGW) {
        constexpr int NMAIN = BATCH * (8 / NH) * (NQT - 1);
        const int qt = (it < NMAIN) ? (it % (NQT - 1)) + 1 : 0, hb = (it < NMAIN) ? it / (NQT - 1) : it - NMAIN, head0 = (hb % (8 / NH)) * NH, b = hb / (8 / NH), kvh = head0 >> 2, t0 = qt * 16;
        const size_t rb = (size_t)b * TP;
        bf16x8 Bq[NH][4];
#pragma unroll
        for (int hh = 0; hh < NH; ++hh) { const GAS bf16_t* qp = BQ + (rb + t0 + r) * 1024 + (head0 + hh) * 128 + 8 * g;
#pragma unroll
          for (int ks = 0; ks < 4; ++ks) Bq[hh][ks] = *(const GAS bf16x8*)(qp + ks * 32); }
        f32x4 Oa[NH][8];
#pragma unroll
        for (int hh = 0; hh < NH; ++hh)
#pragma unroll
            for (int dt = 0; dt < 8; ++dt) Oa[hh][dt] = (f32x4){0.f, 0.f, 0.f, 0.f};
        float carry[NH];
#pragma unroll
        for (int hh = 0; hh < NH; ++hh) carry[hh] = 0.f;
        const int qpos = t0 + r;
        const GAS bf16_t* vtb = VT + ((size_t)(b * 2 + kvh) * 128) * TP;
        for (int kb = t0; kb >= 0; kb -= 32) {
            bf16x8 Kf[2][4];
#pragma unroll
            for (int tl = 0; tl < 2; ++tl) { int krow = kb - 16 * tl + r; krow = krow < 0 ? 0 : krow; const GAS bf16_t* kp = SKV + (rb + krow) * 512 + kvh * 128 + 8 * g;
#pragma unroll
                for (int ks = 0; ks < 4; ++ks) Kf[tl][ks] = *(const GAS bf16x8*)(kp + ks * 32); }
            bool done = true;
            bf16x8 Pbh[NH];
#pragma unroll
            for (int hh = 0; hh < NH; ++hh) {
                float a_hi[4], a_lo[4];
                float zz[2][4], sp[2][4], tot[2];
#pragma unroll
                for (int tl = 0; tl < 2; ++tl) {
                    const int kbase = kb - 16 * tl;
                    f32x4 z = (f32x4){0.f, 0.f, 0.f, 0.f};
#pragma unroll
                    for (int ks = 0; ks < 4; ++ks) z = MFMA16(Kf[tl][ks], Bq[hh][ks], z);
                    float gsum = 0.f;
#pragma unroll
                    for (int i = 0; i < 4; ++i) { const int key = kbase + 4 * g + i; const bool valid = (key >= 0) && (key < qpos);
                        const float zv = z[i] * 0.08838834764831845f; zz[tl][i] = zv; const float s_ = valid ? softplus_f(zv) : 0.f; sp[tl][i] = s_; gsum += s_; }
                    const float g0 = __shfl(gsum, r), g1 = __shfl(gsum, r + 16), g2 = __shfl(gsum, r + 32), g3 = __shfl(gsum, r + 48);
                    tot[tl] = (g0 + g1) + (g2 + g3);
                    float above = (g < 3 ? g3 : 0.f) + (g < 2 ? g2 : 0.f) + (g < 1 ? g1 : 0.f);
                    float c3 = above + sp[tl][3], c2 = c3 + sp[tl][2], c1 = c2 + sp[tl][1], c0 = c1 + sp[tl][0];
                    sp[tl][3] = c3; sp[tl][2] = c2; sp[tl][1] = c1; sp[tl][0] = c0;
                }
#pragma unroll
                for (int i = 0; i < 4; ++i) {
                    const int khi = kb + 4 * g + i, klo = kb - 16 + 4 * g + i;
                    a_hi[i] = (khi < qpos) ? __expf(zz[0][i] - (carry[hh] + sp[0][i])) : 0.f;
                    a_lo[i] = (klo >= 0 && klo < qpos) ? __expf(zz[1][i] - (carry[hh] + tot[0] + sp[1][i])) : 0.f;
                }
                carry[hh] += tot[0] + tot[1];
                { const unsigned w0 = pk2(a_hi[0], a_hi[1]), w1 = pk2(a_hi[2], a_hi[3]), w2 = pk2(a_lo[0], a_lo[1]), w3 = pk2(a_lo[2], a_lo[3]);
                  const u32x4 w = (u32x4){w0, w1, w2, w3}; Pbh[hh] = __builtin_bit_cast(bf16x8, w); }
                done = done && (carry[hh] > 104.0f);
            }
            const int tlo = (kb - 16) < 0 ? kb : (kb - 16);
#pragma unroll
            for (int dh = 0; dh < 8; dh += 4) {
                bf16x8 Vf[4];
#pragma unroll
                for (int d4 = 0; d4 < 4; ++d4) { const GAS bf16_t* vp = vtb + (size_t)((dh + d4) * 16 + r) * TP;
                    const u32x2 vh = *(const GAS u32x2*)(vp + kb + 4 * g), vl = *(const GAS u32x2*)(vp + tlo + 4 * g);
                    const u32x4 w = (u32x4){vh.x, vh.y, vl.x, vl.y}; Vf[d4] = __builtin_bit_cast(bf16x8, w); }
#pragma unroll
                for (int hh = 0; hh < NH; ++hh)
#pragma unroll
                    for (int d4 = 0; d4 < 4; ++d4) Oa[hh][dh + d4] = MFMA16(Vf[d4], Pbh[hh], Oa[hh][dh + d4]);
            }
            if (__all(done)) break;
        }
#pragma unroll
        for (int hh = 0; hh < NH; ++hh) {
            GAS bf16_t* op = O + (rb + t0 + r) * 1024 + (head0 + hh) * 128 + 4 * g;
#pragma unroll
            for (int dt = 0; dt < 8; ++dt) { u32x2 w; w.x = pk2(Oa[hh][dt][0], Oa[hh][dt][1]); w.y = pk2(Oa[hh][dt][2], Oa[hh][dt][3]); *(GAS u32x2*)(op + dt * 16) = w; }
        }
    }
}
constexpr int SCPH = 130;
constexpr int SKP = 272;
constexpr int PE_SC = 0, PE_TOP = 256 * SCPH * 2  , PE_SK = PE_TOP + 16384, PE_END = PE_SK + 2 * 128 * SKP;
__device__ __forceinline__ float gelu_erf(float v) { return 0.5f * v * (1.0f + erff(v * 0.70710678118654752f)); }
__device__ __forceinline__ void phase_peer_route(const Frame& F, int layer) {
    GAS unsigned char* ws = F.ws;
    const GAS bf16_t* PQ = (const GAS bf16_t*)(ws + WS_PROJ); const GAS bf16_t* SK = (const GAS bf16_t*)(ws + WS_SK) + (size_t)layer * 2 * 128 * 128;
    LAS _Float16* SCP = (LAS _Float16*)(F.lds + PE_SC); LAS unsigned* TOPL = (LAS unsigned*)(F.lds + PE_TOP); LAS unsigned char* SKL = F.lds + PE_SK;
    static_assert(PE_END <= MISC_OFF, "PEER routing LDS");
    for (int i = F.tid; i < 2 * 128 * 16; i += NT) { const int rw = i >> 4, ch = i & 15; *(LAS u32x4*)(SKL + rw * SKP + ch * 16) = *(const GAS u32x4*)(SK + (size_t)rw * 128 + ch * 8); }
    __syncthreads();
    GAS bf16_t* RIDG = (GAS bf16_t*)(ws + WS_RID); GAS bf16_t* RIDT = (GAS bf16_t*)(ws + WS_RIDT); GAS float* RGG = (GAS float*)(ws + WS_RG);
    const int lane = F.lane, wave = F.wave, tid = F.tid, r = lane & 15, g = lane >> 4;
    constexpr int NIT = BATCH * (TT / 16);
    for (int it = blockIdx.x; it < NIT; it += F.G) {
        const int b = it / (TT / 16), tb = it - b * (TT / 16);
        const size_t row0 = (size_t)b * TP + tb * 16;
#ifndef PROBE_ROUTE
#define PROBE_ROUTE 0
#endif
        for (int rp = 0; rp < ((PROBE_ROUTE & 1) ? 2 : 1); ++rp) {
            const int h = wave;
#pragma unroll 1
            for (int c = 0; c < 2; ++c) {
                bf16x8 A[4];
                const GAS bf16_t* ap = PQ + (row0 + r) * 2048 + h * 256 + c * 128 + 8 * g;
#pragma unroll
                for (int ks = 0; ks < 4; ++ks) A[ks] = *(const GAS bf16x8*)(ap + ks * 32);
#pragma unroll
                for (int kt = 0; kt < 8; ++kt) {
                    const LAS unsigned char* bp = SKL + (c * 128 + kt * 16 + r) * SKP + 16 * g;
                    f32x4 d = (f32x4){0.f, 0.f, 0.f, 0.f};
#pragma unroll
                    for (int ks = 0; ks < 4; ++ks) d = MFMA16(A[ks], *(const LAS bf16x8*)(bp + ks * 64), d);
#pragma unroll
                    for (int i = 0; i < 4; ++i) SCP[((4 * g + i) * 16 + h * 2 + c) * SCPH + kt * 16 + r] = (_Float16)d[i];
                }
            }
        }
        __syncthreads();
        for (int rp = 0; rp < ((PROBE_ROUTE & 2) ? 2 : 1); ++rp) {
            if (rp) __syncthreads();
            const int list = tid >> 1, half = tid & 1;
            const LAS _Float16* lp = SCP + list * SCPH + 64 * half;
            unsigned a[16];
#pragma unroll
            for (int i = 0; i < 16; ++i) a[i] = 0u;
#pragma unroll 4
            for (int k = 0; k < 64; ++k) {
                const unsigned x = (mono_key((float)lp[k]) & ~127u) | (unsigned)(127 - (64 * half + k));
#pragma unroll
                for (int i = 15; i >= 1; --i) a[i] = med3u(a[i - 1], a[i], x);
                a[0] = a[0] > x ? a[0] : x;
            }
            if (half) {
#pragma unroll
                for (int i = 0; i < 16; ++i) TOPL[list * 16 + i] = a[i];
            }
            __syncthreads();
            if (!half) {
#pragma unroll 4
                for (int k = 0; k < 16; ++k) {
                    const unsigned x = TOPL[list * 16 + k];
#pragma unroll
                    for (int i = 15; i >= 1; --i) a[i] = med3u(a[i - 1], a[i], x);
                    a[0] = a[0] > x ? a[0] : x;
                }
            }
            __syncthreads();
            if (!half) {
#pragma unroll
                for (int i = 0; i < 16; ++i) TOPL[list * 16 + i] = a[i];
            }
        }
        __syncthreads();
        for (int rp = 0; rp < ((PROBE_ROUTE & 4) ? 2 : 1); ++rp)
        if (tid < 128) {
            const int token = tid >> 3, h = tid & 7;
            const LAS unsigned* L1 = TOPL + (token * 16 + h * 2) * 16; const LAS unsigned* L2 = L1 + 16;
            float v1[16], v2[16];
#pragma unroll
            for (int i = 0; i < 16; ++i) { v1[i] = unmono_key(L1[i] & ~127u); v2[i] = unmono_key(L2[i] & ~127u); }
            unsigned cc[16];
#pragma unroll
            for (int i = 0; i < 16; ++i) cc[i] = 0u;
#pragma unroll
            for (int ia = 0; ia < 16; ++ia)
#pragma unroll
                for (int ib = 0; ib < 16; ++ib) if ((ia + 1) * (ib + 1) <= 16) {
                    const unsigned x = (mono_key(v1[ia] + v2[ib]) & ~255u) | (unsigned)(255 - (ia * 16 + ib));
#pragma unroll
                    for (int i = 15; i >= 1; --i) cc[i] = med3u(cc[i - 1], cc[i], x);
                    cc[0] = cc[0] > x ? cc[0] : x;
                }
            const float bmax = unmono_key(cc[0] & ~255u);
            float e[16], esum = 0.f;
#pragma unroll
            for (int i = 0; i < 16; ++i) { e[i] = __expf(unmono_key(cc[i] & ~255u) - bmax); esum += e[i]; }
            const float inv = 1.0f / esum;
#pragma unroll
            for (int i = 0; i < 16; ++i) {
                const int flat = 255 - (int)(cc[i] & 255u), ia = flat >> 4, ib = flat & 15;
                const int i1 = 127 - (int)(L1[ia] & 127u), i2 = 127 - (int)(L2[ib] & 127u);
                RIDG[(row0 + token) * 128 + h * 16 + i] = (bf16_t)(i1 * 128 + i2); RIDT[(row0 + token) * 128 + i * 8 + h] = (bf16_t)(i1 * 128 + i2); RGG[(row0 + token) * 128 + h * 16 + i] = e[i] * inv;
            }
        }
        __syncthreads();
    }
}

constexpr int NTOK = BATCH * TT;
#define XCC_FRAME() volatile LAS unsigned* MISC_ = (volatile LAS unsigned*)(F.lds + MISC_OFF); \
    const int xp = (int)MISC_[4], nx = (int)MISC_[5], wrank = (int)MISC_[6] * NWAVES + F.wave, nw = (int)MISC_[7] * NWAVES
__device__ __forceinline__ unsigned id_of(const u32x4& a, const u32x4& b, int k) {
    const unsigned w = (k < 8) ? a[(k >> 1) & 3] : b[(k >> 1) & 3]; return (k & 1) ? (w >> 16) : (w & 0xffffu);
}
#define FP8X2(w, hi) __builtin_amdgcn_cvt_pk_f32_fp8((int)(w), hi)
__device__ __forceinline__ size_t tok_row(int tokn) { const int bsel = tokn / TT; return (size_t)bsel * TP + (tokn - bsel * TT); }
#define LDG16(base, off) (*(const GAS u32x4*)((const GAS unsigned char*)(base) + (unsigned)(off)))
__device__ __forceinline__ void phase_peer_u(const Frame& F, int layer) {
    GAS unsigned char* ws = F.ws;
    const GAS unsigned char* HBb = ws + WS_HB; const GAS unsigned char* RIDb = ws + WS_RID;
    const int lane = F.lane, j = lane >> 3, c = lane & 7;
    LAS unsigned char* MET = F.lds + 16384 + F.wave * 1024;
    XCC_FRAME();
#pragma unroll 1
    for (int s = xp; s < 8; s += nx) {
        const GAS unsigned char* Us = ws + WS_U + ((size_t)layer * 8 + s) * NEXP * 128;
        GAS unsigned char* Ps = ws + WS_PART + (size_t)s * NR * 128 * 4;
        const unsigned uo = 16u * c;
#define PU_FETCH(tk) do { const int tk_ = (tk) < NTOK ? (tk) : NTOK - 1; const unsigned r_ = (unsigned)tok_row(tk_); \
        pid = *(const GAS unsigned*)(RIDb + (r_ * 256u + 4u * lane)); px = *(const GAS unsigned*)(HBb + (r_ * 2048u + 256u * s + 4u * lane)); } while (0)
#define PU_STAGE(slot) do { *(LAS unsigned*)(MET + (slot) * 512 + 4 * lane) = pid; *(LAS unsigned*)(MET + (slot) * 512 + 256 + 4 * lane) = px; } while (0)
        unsigned pid, px; int it = 0;
        PU_FETCH(wrank); PU_STAGE(0); PU_FETCH(wrank + nw);
#pragma unroll 1
        for (int tokn = wrank; tokn < NTOK; tokn += nw, ++it) {
            const unsigned row = (unsigned)tok_row(tokn);
            const int sl = it & 1;
            PU_STAGE(sl ^ 1);
            const u32x4 ia = *(const LAS u32x4*)(MET + sl * 512 + 32 * j), ib = *(const LAS u32x4*)(MET + sl * 512 + 32 * j + 16);
            u32x4 u[16];
#pragma unroll
            for (int b = 0; b < 16; ++b) u[b] = LDG16(Us, id_of(ia, ib, b) * 128u + uo);
            PU_FETCH(tokn + 2 * nw);
            const u32x4 xa = *(const LAS u32x4*)(MET + sl * 512 + 256 + 32 * c), xb = *(const LAS u32x4*)(MET + sl * 512 + 256 + 32 * c + 16);
            __builtin_amdgcn_sched_barrier(0);
            f32x2 xf[8];
#pragma unroll
            for (int k = 0; k < 4; ++k) { xf[k] = (f32x2){bflo(xa[k]), bfhi(xa[k])}; xf[4 + k] = (f32x2){bflo(xb[k]), bfhi(xb[k])}; }
            float p[16];
#pragma unroll
            for (int b = 0; b < 16; ++b) {
                unsigned w0 = u[b].x, w1 = u[b].y, w2 = u[b].z, w3 = u[b].w;
                f32x2 t2 = FP8X2(w0, false) * xf[0], t3 = FP8X2(w0, true) * xf[1];
                t2 += FP8X2(w1, false) * xf[2]; t3 += FP8X2(w1, true) * xf[3];
                t2 += FP8X2(w2, false) * xf[4]; t3 += FP8X2(w2, true) * xf[5]; t2 += FP8X2(w3, false) * xf[6]; t3 += FP8X2(w3, true) * xf[7];
                t2 += t3;
                float t = t2.x + t2.y;
                if (b < 14 && (b & 1)) asm volatile("" : "+v"(u[b + 1].x), "+v"(u[b + 1].y), "+v"(u[b + 1].z), "+v"(u[b + 1].w), "+v"(u[b + 2].x), "+v"(u[b + 2].y), "+v"(u[b + 2].z), "+v"(u[b + 2].w) : "v"(t));
                p[b] = t; }
            float q[8], r4[4], t2[2];
            { const bool hi = (c & 4) != 0;
#pragma unroll
              for (int i = 0; i < 8; ++i) q[i] = (hi ? p[8 + i] : p[i]) + __shfl_xor(hi ? p[i] : p[8 + i], 4); }
            { const bool hi = (c & 2) != 0;
#pragma unroll
              for (int i = 0; i < 4; ++i) r4[i] = (hi ? q[4 + i] : q[i]) + __shfl_xor(hi ? q[i] : q[4 + i], 2); }
            { const bool hi = (c & 1) != 0;
#pragma unroll
              for (int i = 0; i < 2; ++i) t2[i] = (hi ? r4[2 + i] : r4[i]) + __shfl_xor(hi ? r4[i] : r4[2 + i], 1); }
            *(GAS f32x2*)(Ps + (row * 512u + 64u * j + 8u * c)) = (f32x2){t2[0], t2[1]};
        }
    }
}
__device__ __forceinline__ void phase_peer_act(const Frame& F) {
    GAS unsigned char* ws = F.ws;
    const GAS float* PART = (const GAS float*)(ws + WS_PART); const GAS float* RGG = (const GAS float*)(ws + WS_RG); const GAS float* SS = (const GAS float*)(ws + WS_SS); GAS bf16_t* ACT = (GAS bf16_t*)(ws + WS_ACT);
    const size_t n4 = (size_t)NTOK * 32;
    for (size_t i = (size_t)blockIdx.x * NT + F.tid; i < n4; i += (size_t)F.G * NT) {
        const int tokn = (int)(i >> 5), q4 = (int)(i & 31); const int bsel = tokn / TT; const size_t row = (size_t)bsel * TP + (tokn - bsel * TT);
        const size_t o = row * 128 + 4 * q4;
        f32x4 acc = *(const GAS f32x4*)(PART + o);
#pragma unroll
        for (int s = 1; s < 8; ++s) acc += *(const GAS f32x4*)(PART + (size_t)s * NR * 128 + o);
        const float ri = row_rinv(SS, (int)row) * (1.0f / U_SCALE); const f32x4 gt = *(const GAS f32x4*)(RGG + o) * (1.0f / V_SCALE);
        *(GAS u32x2*)(ACT + o) = (u32x2){pk2(gelu_erf(acc[0] * ri) * gt[0], gelu_erf(acc[1] * ri) * gt[1]), pk2(gelu_erf(acc[2] * ri) * gt[2], gelu_erf(acc[3] * ri) * gt[3])};
    }
}
__device__ __forceinline__ void phase_peer_v(const Frame& F, int layer, float* dout, size_t dry_off = 0) {
    GAS unsigned char* ws = F.ws;
    const GAS unsigned char* RIDb = ws + WS_RID; const GAS unsigned char* ACTb = ws + WS_ACT;
    GAS unsigned char* Hb = ws + WS_H + dry_off; GAS unsigned char* HBb = ws + WS_HB + dry_off; GAS float* SS = (GAS float*)(ws + WS_SS + dry_off);
    const int lane = F.lane, j = lane >> 3, c = lane & 7;
    LAS unsigned char* MET = F.lds + F.wave * 1024;
    XCC_FRAME();
#pragma unroll 1
    for (int s = xp; s < 8; s += nx) {
        const GAS unsigned char* Vs = ws + WS_V + ((size_t)layer * 8 + s) * NEXP * 128;
        const unsigned vo = 16u * c;
#define PV_FETCH(tk) do { const int tk_ = (tk) < NTOK ? (tk) : NTOK - 1; const unsigned r_ = (unsigned)tok_row(tk_); \
        pid = *(const GAS unsigned*)(RIDb + (r_ * 256u + 4u * lane)); pact = *(const GAS unsigned*)(ACTb + (r_ * 256u + 4u * lane)); } while (0)
#define PV_STAGE(slot) do { *(LAS unsigned*)(MET + (slot) * 512 + 4 * lane) = pid; *(LAS unsigned*)(MET + (slot) * 512 + 256 + 4 * lane) = pact; } while (0)
        unsigned pid, pact; int it = 0;
        PV_FETCH(wrank); PV_STAGE(0); PV_FETCH(wrank + nw);
#pragma unroll 1
        for (int tokn = wrank; tokn < NTOK; tokn += nw, ++it) {
            const int bsel = tokn / TT, tsel = tokn - bsel * TT; const unsigned row = (unsigned)(bsel * TP + tsel);
            const int sl = it & 1;
            PV_STAGE(sl ^ 1);
            const u32x4 ia = *(const LAS u32x4*)(MET + sl * 512 + 32 * j), ib = *(const LAS u32x4*)(MET + sl * 512 + 32 * j + 16);
            u32x4 v[16];
#pragma unroll
            for (int b = 0; b < 16; ++b) v[b] = LDG16(Vs, id_of(ia, ib, b) * 128u + vo);
            PV_FETCH(tokn + 2 * nw);
            const unsigned col = 128u * s + 16u * c + 2u * j;
            const f32x2 hold = *(const GAS f32x2*)(Hb + (row * 4096u + col * 4u));
            __builtin_amdgcn_sched_barrier(0);
            const u32x4 av0 = *(const LAS u32x4*)(MET + sl * 512 + 256 + 32 * j), av1 = *(const LAS u32x4*)(MET + sl * 512 + 256 + 32 * j + 16);
            float acc[16];
#pragma unroll
            for (int i = 0; i < 16; ++i) acc[i] = 0.f;
#pragma unroll
            for (int b = 0; b < 16; ++b) { const unsigned aw_ = (b < 8) ? av0[(b >> 1) & 3] : av1[(b >> 1) & 3]; const float a_ = (b & 1) ? bfhi(aw_) : bflo(aw_);
#pragma unroll
                for (int k = 0; k < 4; ++k) { const f32x2 lo = FP8X2(v[b][k], false), hi = FP8X2(v[b][k], true);
                    acc[4 * k] += a_ * lo.x; acc[4 * k + 1] += a_ * lo.y; acc[4 * k + 2] += a_ * hi.x; acc[4 * k + 3] += a_ * hi.y; }
                if (b < 14 && (b & 1)) asm volatile("" : "+v"(v[b + 1].x), "+v"(v[b + 1].y), "+v"(v[b + 1].z), "+v"(v[b + 1].w), "+v"(v[b + 2].x), "+v"(v[b + 2].y), "+v"(v[b + 2].z), "+v"(v[b + 2].w) : "v"(acc[0])); }
            float q[8], r4[4], o2[2];
            { const bool hi = (lane & 32) != 0;
#pragma unroll
              for (int i = 0; i < 8; ++i) q[i] = (hi ? acc[8 + i] : acc[i]) + __shfl_xor(hi ? acc[i] : acc[8 + i], 32); }
            { const bool hi = (lane & 16) != 0;
#pragma unroll
              for (int i = 0; i < 4; ++i) r4[i] = (hi ? q[4 + i] : q[i]) + __shfl_xor(hi ? q[i] : q[4 + i], 16); }
            { const bool hi = (lane & 8) != 0;
#pragma unroll
              for (int i = 0; i < 2; ++i) o2[i] = (hi ? r4[2 + i] : r4[i]) + __shfl_xor(hi ? r4[i] : r4[2 + i], 8); }
            f32x2 hv = hold; hv.x += o2[0]; hv.y += o2[1];
            *(GAS f32x2*)(Hb + (row * 4096u + col * 4u)) = hv; *(GAS unsigned*)(HBb + (row * 2048u + col * 2u)) = pk2(hv.x, hv.y);
            const float sq = wave_sum(hv.x * hv.x + hv.y * hv.y);
            if (lane == 0) { SS[(size_t)row * 16 + s] = sq; SS[(size_t)row * 16 + 8 + s] = 0.f; }
            if (dout && tsel >= NMETA) *(f32x2*)(dout + ((size_t)bsel * SEQ + (tsel - NMETA)) * 1024 + col) = hv;
        }
    }
}

#define PHASE_FRAME() Frame F; { unsigned long long ws_ = wsu; asm volatile("" : "+s"(ws_)); int tid_ = threadIdx.x; asm volatile("" : "+v"(tid_)); \
    F.lds = (LAS unsigned char*)lds; F.ws = (GAS unsigned char*)ws_; F.tid = tid_; F.lane = tid_ & 63; F.wave = __builtin_amdgcn_readfirstlane(tid_ >> 6); F.G = gridDim.x; F.gw = blockIdx.x * NWAVES + F.wave; F.NGW = F.G * NWAVES; } \
    GAS unsigned char* ws = F.ws; (void)ws
__global__ void __launch_bounds__(NT, 2) mk_fwd(Args a) {
    extern __shared__ __attribute__((aligned(16))) unsigned char lds[];
    unsigned long long wsu = (unsigned long long)a.ws; asm volatile("" : "+s"(wsu));
    unsigned long long outu = (unsigned long long)a.out; asm volatile("" : "+s"(outu));
    volatile LAS unsigned* MISC = (volatile LAS unsigned*)((LAS unsigned char*)lds + MISC_OFF);
    if (threadIdx.x < 16) MISC[threadIdx.x] = 0u;
    __syncthreads();
    XcdBarrier bar = xcd_barrier_post((unsigned*)((unsigned char*)wsu + WS_CTL), MISC);
    if (threadIdx.x == 0) MISC[6] = xb_add((unsigned*)((unsigned char*)wsu + WS_CTL + CTL_XRANK) + 64 * bar.x, 1u);
    PG8_LAS unsigned char* glds = (PG8_LAS unsigned char*)lds;

#ifndef PROBE_DUP
#define PROBE_DUP 0
#endif
    constexpr size_t DRY_OFF = WS_END - WS_H;
    { PHASE_FRAME(); phase_prologue(F, a); }
    xcd_barrier(bar);
    if (threadIdx.x == 0) {
        unsigned nx = 0, xp = 0, xn = 1;
        for (unsigned j = 0; j < 16; ++j) { const unsigned c = xb_ld((unsigned*)((unsigned char*)wsu + WS_CTL + CTL_XRANK) + 64 * j); if (j == bar.x) { xp = nx; xn = c ? c : 1u; } nx += (c > 0u) ? 1u : 0u; }
        MISC[4] = xp; MISC[5] = nx ? nx : 1u; MISC[7] = xn;
    }
    __syncthreads();
    if (PROBE_DUP & 1) { { PHASE_FRAME(); phase_prologue(F, a); } xcd_barrier(bar); }
#pragma unroll 1
    for (int layer = 0; layer < 4; ++layer) {
        for (int rep = 0; rep < ((PROBE_DUP & 2) ? 2 : 1); ++rep) {
            PHASE_FRAME();
            const GAS bf16_t* Bt; int N; EpiScale E;
            E.ss = (const GAS float*)(ws + WS_SS); E.vT = nullptr;
            if (layer < 2) { Bt = (const GAS bf16_t*)(ws + WS_WIN) + (size_t)layer * 2048 * 1024; N = 2048; E.O0 = (GAS bf16_t*)(ws + WS_PROJ); E.ld0 = 2048; E.split = 2048; E.O1 = E.O0; E.ld1 = 2048; }
            else if (layer == 2) { Bt = (const GAS bf16_t*)(ws + WS_WKVQ); N = 1536; E.O0 = (GAS bf16_t*)(ws + WS_SKV); E.ld0 = 512; E.split = 512; E.O1 = (GAS bf16_t*)(ws + WS_Q); E.ld1 = 1024; E.vT = (GAS bf16_t*)(ws + WS_VT); }
            else { Bt = (const GAS bf16_t*)(ws + WS_WBQ1); N = 1024; E.O0 = (GAS bf16_t*)(ws + WS_Q); E.ld0 = 1024; E.split = 1024; E.O1 = E.O0; E.ld1 = 1024; }
            pg8::Gemm gm{(const bf16_t*)(ws + WS_HB), (const bf16_t*)Bt, BATCH * SEQ, N, 1024}; pg8::StaticOrder S; S.init(BATCH * SEQ, N, F.G, (int)blockIdx.x);
            { LAS float* RINV = (LAS float*)(F.lds + 131072); LAS int* PML = (LAS int*)(F.lds + 131072 + 4096);
              _Pragma("unroll") for (int q = 0; q < 4; ++q) { const int pmq = unit_pm_of(S, q); if (F.tid == 0) PML[q] = pmq;
                  if (pmq >= 0 && F.tid < 256) RINV[q * 256 + F.tid] = row_rinv((const GAS float*)(ws + WS_SS), pg8::tile_row(pmq) + F.tid); }
              __syncthreads(); E.rinv_lds = RINV; E.pm_lds = PML; }
            pg8::gemm_phase<EpiScale, pg8::StaticOrder>(glds, gm, S, E);
            gemm_tail<EpiScale>((const GAS bf16_t*)(ws + WS_HB), Bt, N, E, F.gw, F.NGW, F.lane, F.lds);
            if (rep == 0 && (PROBE_DUP & 2)) xcd_barrier(bar);
        }
        xcd_barrier(bar);
        if (layer < 2) {
            for (int rep = 0; rep < ((PROBE_DUP & 4) ? 2 : 1); ++rep) {
            { PHASE_FRAME(); phase_a_post(F, a.in[4] + layer * 128, a.in[5] + layer * 128); }
            xcd_barrier(bar);
            for (int rep2 = 0; rep2 < ((PROBE_DUP & 512) ? 2 : 1); ++rep2) { { PHASE_FRAME(); phase_dsa_sel(F); } xcd_barrier(bar); }
            for (int rep2 = 0; rep2 < ((PROBE_DUP & 1024) ? 2 : 1); ++rep2) { { PHASE_FRAME(); phase_dsa_attn(F); } if (rep2 == 0 && (PROBE_DUP & 1024)) xcd_barrier(bar); }
            if (rep == 0 && (PROBE_DUP & 4)) xcd_barrier(bar);
            }
        } else {
            for (int rep = 0; rep < ((PROBE_DUP & 8) ? 2 : 1); ++rep) {
            PHASE_FRAME(); phase_stick(F);
            if (rep == 0 && (PROBE_DUP & 8)) xcd_barrier(bar);
            }
        }
        xcd_barrier(bar);
        for (int rep = ((PROBE_DUP & 16) ? 1 : 0); rep >= 0; --rep) {
            PHASE_FRAME();
            const GAS bf16_t* Bt = (layer < 2) ? (const GAS bf16_t*)(ws + WS_WOA) + (size_t)layer * 1024 * 1024 : (const GAS bf16_t*)(ws + WS_WOB) + (size_t)(layer - 2) * 1024 * 1024;
            EpiResid E; E.H = (GAS float*)(ws + WS_H + (rep ? DRY_OFF : 0)); E.HB = (GAS bf16_t*)(ws + WS_HB + (rep ? DRY_OFF : 0)); E.ss = (GAS float*)(ws + WS_SS + (rep ? DRY_OFF : 0)); E.HB8 = ws + WS_HB8;
            pg8::Gemm gm{(const bf16_t*)(ws + WS_O), (const bf16_t*)Bt, BATCH * SEQ, 1024, 1024}; pg8::StaticOrder S; S.init(BATCH * SEQ, 1024, F.G, (int)blockIdx.x);
            pg8::gemm_phase<EpiResid, pg8::StaticOrder>(glds, gm, S, E);
            gemm_tail<EpiResid>((const GAS bf16_t*)(ws + WS_O), Bt, 1024, E, F.gw, F.NGW, F.lane, F.lds);
            if (rep) xcd_barrier(bar);
        }
        xcd_barrier(bar);
        for (int rep = 0; rep < ((PROBE_DUP & 32) ? 2 : 1); ++rep) {
            PHASE_FRAME();
            EpiScale E; E.ss = (const GAS float*)(ws + WS_SS); E.vT = nullptr; E.O0 = (GAS bf16_t*)(ws + WS_PROJ); E.ld0 = 2048; E.split = 2048; E.O1 = E.O0; E.ld1 = 2048;
            pg8::Gemm gm{(const bf16_t*)(ws + WS_HB), (const bf16_t*)((const GAS bf16_t*)(ws + WS_WPQ) + (size_t)layer * 2048 * 1024), BATCH * SEQ, 2048, 1024}; pg8::StaticOrder S; S.init(BATCH * SEQ, 2048, F.G, (int)blockIdx.x);
            { LAS float* RINV = (LAS float*)(F.lds + 131072); LAS int* PML = (LAS int*)(F.lds + 131072 + 4096);
              _Pragma("unroll") for (int q = 0; q < 4; ++q) { const int pmq = unit_pm_of(S, q); if (F.tid == 0) PML[q] = pmq;
                  if (pmq >= 0 && F.tid < 256) RINV[q * 256 + F.tid] = row_rinv((const GAS float*)(ws + WS_SS), pg8::tile_row(pmq) + F.tid); }
              __syncthreads(); E.rinv_lds = RINV; E.pm_lds = PML; }
            pg8::gemm_phase<EpiScale, pg8::StaticOrder>(glds, gm, S, E);
            gemm_tail<EpiScale>((const GAS bf16_t*)(ws + WS_HB), (const GAS bf16_t*)(ws + WS_WPQ) + (size_t)layer * 2048 * 1024, 2048, E, F.gw, F.NGW, F.lane, F.lds);
            if (rep == 0 && (PROBE_DUP & 32)) xcd_barrier(bar);
        }
        xcd_barrier(bar);
        for (int rep = 0; rep < ((PROBE_DUP & 64) ? 2 : 1); ++rep) { { PHASE_FRAME(); phase_peer_route(F, layer); } xcd_barrier(bar); }
        for (int rep = 0; rep < ((PROBE_DUP & 128) ? 2 : 1); ++rep) { { PHASE_FRAME(); phase_peer_u(F, layer); } xcd_barrier(bar); }
        for (int rep = 0; rep < ((PROBE_DUP & 2048) ? 2 : 1); ++rep) { { PHASE_FRAME(); phase_peer_act(F); } xcd_barrier(bar); }
        if (PROBE_DUP & 4096) { { PHASE_FRAME(); phase_peer_v(F, layer, nullptr, DRY_OFF); } xcd_barrier(bar); }
        { PHASE_FRAME(); unsigned long long o_ = outu; asm volatile("" : "+s"(o_));
          phase_peer_v(F, layer, layer == 3 ? (float*)o_ : nullptr); }
        xcd_barrier(bar);
        if (PROBE_DUP & 256) { for (int rep = 0; rep < 8; ++rep) xcd_barrier(bar); }
    }
}

extern "C" void kernel_launch(void* const* d_in, const int* in_sizes, int n_in, void* d_out, int out_size, void* d_ws, size_t ws_size, hipStream_t stream) {
    static int grid = 0;
    if (grid == 0) {
        if (n_in != 17 || out_size != BATCH * SEQ * DM || ws_size < WS_END + (WS_PROJ - WS_H)) { fprintf(stderr, "kernel_launch: unexpected shapes (n_in %d out %d ws %zu need %zu)\n", n_in, out_size, ws_size, (size_t)WS_END); grid = -1; return; }
        int dev = 0, cus = 0, per_cu = 0;
        if (hipGetDevice(&dev) != hipSuccess || hipDeviceGetAttribute(&cus, hipDeviceAttributeMultiprocessorCount, dev) != hipSuccess) { grid = -1; return; }
        if (hipFuncSetAttribute((const void*)mk_fwd, hipFuncAttributeMaxDynamicSharedMemorySize, LDS_BYTES) != hipSuccess) { fprintf(stderr, "kernel_launch: hipFuncSetAttribute failed\n"); grid = -1; return; }
        if (hipOccupancyMaxActiveBlocksPerMultiprocessor(&per_cu, (const void*)mk_fwd, NT, LDS_BYTES) != hipSuccess || per_cu < 1) fprintf(stderr, "kernel_launch: occupancy query says %d blocks/CU\n", per_cu);
        (void)hipGetLastError();
        grid = cus;
    }
    if (grid < 0) return;
    if (hipMemsetAsync((char*)d_ws + WS_CTL, 0, 65536, stream) != hipSuccess) return;
    Args a{};
    for (int i = 0; i < 17; ++i) a.in[i] = (const float*)d_in[i];
    a.out = (float*)d_out; a.ws = (unsigned char*)d_ws;
    for (int i = 0; i < 16; ++i) a.inv32[i] = pow(500000.0, -(double)(2 * i) / 32.0);
    for (int i = 0; i < 8; ++i) a.inv16[i] = pow(500000.0, -(double)(2 * i) / 16.0);
    hipLaunchKernelGGL(mk_fwd, dim3(grid), dim3(NT), LDS_BYTES, stream, a);
}
```

```cpp
#include <hip/hip_runtime.h>
#include <cstdio>
#include <cmath>
#define LAS __attribute__((address_space(3)))
#define GAS __attribute__((address_space(1)))
typedef unsigned short bf16_t;
typedef short bf16x8 __attribute__((ext_vector_type(8)));
typedef short s16x4 __attribute__((ext_vector_type(4)));
typedef float f32x4 __attribute__((ext_vector_type(4)));
typedef float f32x2 __attribute__((ext_vector_type(2)));
typedef unsigned u32x4 __attribute__((ext_vector_type(4)));
typedef unsigned u32x2 __attribute__((ext_vector_type(2)));
typedef __bf16 bf16x2_t __attribute__((ext_vector_type(2)));
constexpr float U_SCALE = 1024.0f, V_SCALE = 256.0f, X_SCALE = 16.0f, Q_SCALE = 128.0f, K_SCALE = 16.0f, V8_SCALE = 16.0f, P8_SCALE = 256.0f;

constexpr int BATCH = 4, SEQ = 4096, DM = 1024, NMETA = 16, TT = SEQ + NMETA  , TP = 4224, NR = BATCH * TP  ;
constexpr int HD = 128, TOPK = 256;
constexpr int ACOLS = 1860, ACOLS_P = 2048;
constexpr int NEXP = 16384;
constexpr float RMS_EPS = 1e-6f;
constexpr int NT = 512, NWAVES = 8;
constexpr int LDS_BYTES = 160 * 1024;
constexpr int MISC_OFF = LDS_BYTES - 64;
constexpr size_t CTL_XRANK = 16384;

constexpr size_t al256(size_t x) { return (x + 255) & ~(size_t)255; }
constexpr size_t WS_CTL   = 0;
constexpr size_t WS_WIN   = 65536;
constexpr size_t WS_WOA   = WS_WIN  + (size_t)2 * 2048 * 1024 * 2;
constexpr size_t WS_WKVQ  = WS_WOA  + (size_t)2 * 1024 * 1024 * 2;
constexpr size_t WS_WBQ1  = WS_WKVQ + (size_t)1536 * 1024 * 2;
constexpr size_t WS_WOB   = WS_WBQ1 + (size_t)1024 * 1024 * 2;
constexpr size_t WS_WPQ   = WS_WOB  + (size_t)2 * 1024 * 1024 * 2;
constexpr size_t WS_SK    = WS_WPQ  + (size_t)4 * 2048 * 1024 * 2;
constexpr size_t WS_ROPE32= WS_SK   + (size_t)4 * 2 * 128 * 128 * 2;
constexpr size_t WS_ROPE16= WS_ROPE32 + (size_t)TP * 16 * 8;
constexpr size_t WS_U     = al256(WS_ROPE16 + (size_t)TP * 8 * 8);
constexpr size_t WS_V     = WS_U    + (size_t)4 * NEXP * 1024 * 2;
constexpr size_t WS_H     = WS_V    + (size_t)4 * NEXP * 1024 * 2;
constexpr size_t WS_HB    = WS_H    + (size_t)NR * 1024 * 4;
constexpr size_t WS_SS    = WS_HB   + (size_t)NR * 1024 * 2;
constexpr size_t WS_PROJ  = WS_SS   + (size_t)NR * 16 * 4;
constexpr size_t WS_Q     = WS_PROJ + (size_t)NR * 2048 * 2;
constexpr size_t WS_KVA   = WS_Q    + (size_t)NR * 1024 * 2;
constexpr size_t WS_QI    = WS_KVA  + (size_t)NR * 512 * 2;
constexpr size_t WS_KI    = WS_QI   + (size_t)NR * 256 * 2;
constexpr size_t WS_WI    = WS_KI   + (size_t)NR * 64 * 2;
constexpr size_t WS_O     = WS_WI   + (size_t)NR * 4 * 4;
constexpr size_t WS_SKV   = WS_O    + (size_t)NR * 1024 * 2;
constexpr size_t WS_VT    = WS_SKV  + (size_t)NR * 512 * 2;
constexpr size_t WS_RID   = WS_VT   + (size_t)BATCH * 2 * 128 * TP * 2;
constexpr size_t WS_RG    = WS_RID  + (size_t)NR * 128 * 4;
constexpr size_t WS_SELG  = WS_RG   + (size_t)NR * 128 * 4;
constexpr size_t WS_ACT   = WS_SELG + (size_t)NR * 256 * 2;
constexpr size_t WS_PART  = WS_ACT  + (size_t)NR * 128 * 4;
constexpr size_t WS_HB8   = WS_PART + (size_t)16 * NR * 128 * 4;
constexpr size_t WS_RIDT  = WS_HB8  + (size_t)NR * 1024;
constexpr size_t WS_Q8    = WS_RIDT + (size_t)NR * 128 * 2;
constexpr size_t WS_K8    = WS_Q8   + (size_t)NR * 1024;
constexpr size_t WS_V8    = WS_K8   + (size_t)NR * 256;
constexpr size_t WS_END   = WS_V8   + (size_t)NR * 256;

__device__ __forceinline__ float bf2f(unsigned b) { return __uint_as_float(b << 16); }
__device__ __forceinline__ float bflo(unsigned w) { return __uint_as_float(w << 16); }
__device__ __forceinline__ float bfhi(unsigned w) { return __uint_as_float(w & 0xffff0000u); }
__device__ __forceinline__ unsigned f2bf(float f) { unsigned u = __float_as_uint(f); return (u + 0x7fffu + ((u >> 16) & 1u)) >> 16; }
__device__ __forceinline__ unsigned pk2(float lo, float hi) { return f2bf(lo) | (f2bf(hi) << 16); }
__device__ __forceinline__ int lane_id_() { return (int)__builtin_amdgcn_mbcnt_hi(~0u, __builtin_amdgcn_mbcnt_lo(~0u, 0u)); }
__device__ __forceinline__ float wave_sum(float v) {
#pragma unroll
    for (int o = 1; o < 64; o <<= 1) v += __shfl_xor(v, o);
    return v;
}
__device__ __forceinline__ int wave_sum_dpp_i(int x) {
    x += __builtin_amdgcn_update_dpp(0, x, 0xB1, 0xf, 0xf, false);
    x += __builtin_amdgcn_update_dpp(0, x, 0x4E, 0xf, 0xf, false);
    x += __builtin_amdgcn_update_dpp(0, x, 0x141, 0xf, 0xf, false);
    x += __builtin_amdgcn_update_dpp(0, x, 0x140, 0xf, 0xf, false);
    return __builtin_amdgcn_readlane(x, 0) + __builtin_amdgcn_readlane(x, 16) + __builtin_amdgcn_readlane(x, 32) + __builtin_amdgcn_readlane(x, 48);
}
__device__ __forceinline__ unsigned mono_key(float s) { const unsigned u = __float_as_uint(s); return u ^ ((u >> 31) ? 0xFFFFFFFFu : 0x80000000u); }
__device__ __forceinline__ float unmono_key(unsigned k) { const unsigned u = (k >> 31) ? (k ^ 0x80000000u) : ~k; return __uint_as_float(u); }
__device__ __forceinline__ unsigned med3u(unsigned a, unsigned b, unsigned c) { unsigned r; asm("v_med3_u32 %0, %1, %2, %3" : "=v"(r) : "v"(a), "v"(b), "v"(c)); return r; }
__device__ __forceinline__ float dot2bf(unsigned a, unsigned b, float c) { return __builtin_amdgcn_fdot2_f32_bf16(__builtin_bit_cast(bf16x2_t, a), __builtin_bit_cast(bf16x2_t, b), c, false); }
#define MFMA16(a, b, c) __builtin_amdgcn_mfma_f32_16x16x32_bf16((a), (b), (c), 0, 0, 0)

#define XB_TMO      128
#define XB_XCNT(j)  (256  + 64 * (j))
#define XB_XSUB(j)  (1280 + 64 * (j))
#define XB_XGEN(j)  (2304 + 64 * (j))
#define XB_TOP      3328
#define XB_TOPGEN   3392
#define XCD_BAR_WORDS 3456
#define XB_SPIN_CAP (1u << 22)
__device__ __forceinline__ unsigned xb_ld(unsigned* p)              { return __hip_atomic_load((GAS unsigned*)p, __ATOMIC_RELAXED, __HIP_MEMORY_SCOPE_AGENT); }
__device__ __forceinline__ unsigned xb_add(unsigned* p, unsigned v) { return __hip_atomic_fetch_add((GAS unsigned*)p, v, __ATOMIC_RELAXED, __HIP_MEMORY_SCOPE_AGENT); }
__device__ __forceinline__ unsigned xb_xcc_id() { return (unsigned)__builtin_amdgcn_s_getreg((3 << 11) | 20) & 0xFu; }
#define XB_SPIN(cond, bar) do { unsigned _sp = 0; while (cond) { __builtin_amdgcn_s_sleep(1); \
    if ((++_sp & 255u) == 0u) { if (xb_ld(&(bar)[XB_TMO])) break; if (_sp > XB_SPIN_CAP) { xb_add(&(bar)[XB_TMO], 1u); break; } } } } while (0)
struct XcdBarrier { unsigned* bar; unsigned x; volatile LAS unsigned* st; };
__device__ __forceinline__ XcdBarrier xcd_barrier_post(unsigned* bar, volatile LAS unsigned* st) {
    XcdBarrier b; b.bar = bar; b.x = xb_xcc_id(); b.st = st;
    if (threadIdx.x == 0) (void)xb_add(&bar[XB_XCNT(b.x)], 1u);
    return b;
}
__device__ __forceinline__ void xcd_barrier_complete(unsigned* bar, unsigned x, unsigned& nloc, unsigned& nx) {
    const unsigned G = gridDim.x * gridDim.y * gridDim.z;
    unsigned sum, cnt, mine, sp = 0u;
    for (;;) {
        sum = 0u; cnt = 0u; mine = 0u;
#pragma unroll
        for (unsigned j = 0; j < 16; ++j) { const unsigned c = xb_ld(&bar[XB_XCNT(j)]); sum += c; cnt += (c > 0u) ? 1u : 0u; mine = (j == x) ? c : mine; }
        if (sum == G) break;
        __builtin_amdgcn_s_sleep(1);
        if ((++sp & 255u) == 0u) { if (xb_ld(&bar[XB_TMO])) break; if (sp > XB_SPIN_CAP) { xb_add(&bar[XB_TMO], 1u); break; } }
    }
    nloc = mine > 0u ? mine : 1u; nx = cnt > 0u ? cnt : 1u;
}
__device__ __forceinline__ void xcd_barrier(const XcdBarrier& b) {
    asm volatile("s_waitcnt vmcnt(0)" ::: "memory");
    __syncthreads();
    if (threadIdx.x == 0) {
        unsigned* bar = b.bar;
        __builtin_amdgcn_s_waitcnt(0);
        unsigned nloc = b.st[0], nx = b.st[1];
        if (nloc == 0u) { xcd_barrier_complete(bar, b.x, nloc, nx); b.st[0] = nloc; b.st[1] = nx; }
        const unsigned old = xb_add(&bar[XB_XSUB(b.x)], 1u);
        const unsigned gen = old / nloc;
        if (old + 1u == (gen + 1u) * nloc) {
            __builtin_amdgcn_fence(__ATOMIC_RELEASE, "agent");
            asm volatile("s_waitcnt vmcnt(0)" ::: "memory");
            const unsigned og = xb_add(&bar[XB_TOP], 1u);
            const unsigned tg = og / nx;
            if (og + 1u == (tg + 1u) * nx) xb_add(&bar[XB_TOPGEN], 1u);
            else XB_SPIN(xb_ld(&bar[XB_TOPGEN]) == tg, bar);
            __builtin_amdgcn_fence(__ATOMIC_ACQUIRE, "agent");
            xb_add(&bar[XB_XGEN(b.x)], 1u);
            asm volatile("s_waitcnt vmcnt(0)" ::: "memory");
        } else {
            XB_SPIN(xb_ld(&bar[XB_XGEN(b.x)]) == gen, bar);
            __builtin_amdgcn_fence(__ATOMIC_ACQUIRE, "agent");
            asm volatile("s_waitcnt vmcnt(0)" ::: "memory");
        }
    }
    __syncthreads();
}
namespace pg8 {
#define PG8_LAS __attribute__((address_space(3)))
typedef unsigned short bf16_t;
typedef short bf16x8 __attribute__((ext_vector_type(8)));
typedef float f32x4 __attribute__((ext_vector_type(4)));
typedef unsigned u32x4 __attribute__((ext_vector_type(4)));
constexpr int BM = 256, BK = 64, HALF = 128, HTB = HALF * BK * 2  , STAGE_BYTES = 8 * HTB, NXCD = 8, WGM = 8;

__host__ __device__ __forceinline__ int lds_byte(int r, int c) { const int st = (r >> 4) * 2 + (c >> 5), rr = r & 15, cc = c & 31, ob = rr * 64 + cc * 2; return st * 1024 + (ob ^ (((ob >> 9) & 1) << 5)); }
__host__ __device__ __forceinline__ void stage_rc(int b, int& R, int& C) { const int st = b / 1024, sb = b % 1024, swz = sb ^ (((sb >> 9) & 1) << 5); R = (st >> 1) * 16 + swz / 64; C = (st & 1) * 32 + (swz % 64) / 2; }
__host__ __device__ __forceinline__ int perm32(int rho) { const int n = rho >> 4, i = rho & 15; return 8 * (i >> 2) + 4 * n + (i & 3); }

__host__ __device__ __forceinline__ int tile_row(int pm) { return (pm >> 4) * 4224 + 16 + (pm & 15) * 256; }
struct Unit { int pm, pn; };
struct Gemm { const bf16_t* A; const bf16_t* Bt; int M, N, K; };

struct StaticOrder {
    int nM, nN, nwg, G, c;
    __host__ __device__ void init(int M, int N, int G_, int c_) { nM = M / BM; nN = N / BM; nwg = nM * nN; G = G_; c = c_; }
    __host__ __device__ bool next(int i, Unit& u) const {
        const long L = (long)i * G + c; if (L >= nwg) return false;
        int wgid = (int)L; { const int q = nwg / NXCD, r = nwg % NXCD, xcd = wgid % NXCD, off = wgid / NXCD; wgid = (xcd < r ? xcd * (q + 1) : r * (q + 1) + (xcd - r) * q) + off; }
        const int nig = WGM * nN, gid = wgid / nig, fm = gid * WGM, gsz = (nM - fm) < WGM ? (nM - fm) : WGM;
        u.pm = fm + ((wgid % nig) % gsz); u.pn = (wgid % nig) / gsz; return true;
    }
    __device__ __forceinline__ void a_ready(const Unit&) const {}
    __device__ __forceinline__ void done(const Unit&) const {}
};
__device__ __forceinline__ unsigned cvt_pk_bf16(float lo, float hi) { unsigned r; asm volatile("v_cvt_pk_bf16_f32 %0, %1, %2" : "=v"(r) : "v"(lo), "v"(hi)); return r; }
template <class Epi, class Sched>
__device__ __forceinline__ void gemm_phase(PG8_LAS unsigned char* lds, const Gemm g, const Sched& S, const Epi& E) {
    int tid_l = threadIdx.x; asm volatile("" : "+v"(tid_l));
    const int tid = tid_l, wid = __builtin_amdgcn_readfirstlane(tid >> 6), lane = tid & 63, wr = wid >> 2, wc = wid & 3, fr = lane & 15, fq = lane >> 4;
    const int K = g.K, nt = K / BK;
    unsigned voffA[2], voffB[2];
#pragma unroll
    for (int i = 0; i < 2; ++i) { int R, C; stage_rc(tid * 16 + i * 8192, R, C); const int Rb = Epi::PERM ? ((R & ~31) + perm32(R & 31)) : R;
        voffA[i] = (unsigned)(R * K + C) * 2u; voffB[i] = (unsigned)(Rb * K + C) * 2u; }
    const size_t kstep = (size_t)(BK * 2);
    const size_t hstep = (size_t)HALF * K * 2;
    const size_t tstep = 2 * hstep;
    const unsigned ldsw = (unsigned)wid * 1024u;
    const int aoff = lds_byte(wr * 64 + fr, fq * 8), boff = lds_byte(wc * 32 + fr, fq * 8);
#define PG8_SA(b, h) (((b) * 2 + (h)) * HTB)
#define PG8_SB(b, h) ((4 + (b) * 2 + (h)) * HTB)
#define PG8_STAGE(bufoff, gbase, voff) do { _Pragma("unroll") for (int _i = 0; _i < 2; ++_i) \
        __builtin_amdgcn_global_load_lds((const unsigned*)((const char*)(gbase) + (voff)[_i]), (PG8_LAS unsigned*)(lds + (bufoff) + ldsw + _i * 8192), 16, 0, 0); } while (0)
#define PG8_LDA(dst, b, h) do { _Pragma("unroll") for (int m = 0; m < 4; ++m) _Pragma("unroll") for (int k = 0; k < 2; ++k) dst[m][k] = *(const PG8_LAS bf16x8*)(lds + PG8_SA(b, h) + aoff + m * 2048 + k * 1024); } while (0)
#define PG8_LDB(dst, b, h) do { _Pragma("unroll") for (int n = 0; n < 2; ++n) _Pragma("unroll") for (int k = 0; k < 2; ++k) dst[n][k] = *(const PG8_LAS bf16x8*)(lds + PG8_SB(b, h) + boff + n * 2048 + k * 1024); } while (0)
#define PG8_MMA(ai, bj, At, Bt) do { __builtin_amdgcn_s_setprio(1); _Pragma("unroll") for (int m = 0; m < 4; ++m) _Pragma("unroll") for (int n = 0; n < 2; ++n) _Pragma("unroll") for (int k = 0; k < 2; ++k) \
        acc[ai][bj][m][n] = __builtin_amdgcn_mfma_f32_16x16x32_bf16(Bt[n][k], At[m][k], acc[ai][bj][m][n], 0, 0, 0); __builtin_amdgcn_s_setprio(0); } while (0)
#define PG8_WAIT_V(n) asm volatile("s_waitcnt vmcnt(" #n ")" ::: "memory")
#define PG8_WAIT_L(n) asm volatile("s_waitcnt lgkmcnt(" #n ")" ::: "memory")
#define PG8_BAR __builtin_amdgcn_s_barrier()
#define PG8_SCHED __builtin_amdgcn_sched_barrier(0)
    Unit cur, nxt; int ui = 0;
    if (!S.next(0, cur)) return;
    f32x4 acc[2][2][4][2];
#pragma unroll
    for (int a = 0; a < 2; ++a)
#pragma unroll
        for (int b = 0; b < 2; ++b)
#pragma unroll
            for (int m = 0; m < 4; ++m)
#pragma unroll
                for (int n = 0; n < 2; ++n) acc[a][b][m][n] = (f32x4){0.f, 0.f, 0.f, 0.f};
    bf16x8 At[4][2], B0[2][2], B1[2][2];
    const char* cA = (const char*)g.A + (size_t)tile_row(cur.pm) * K * 2; const char* cB = (const char*)g.Bt + (size_t)cur.pn * tstep;
    S.a_ready(cur);
    PG8_STAGE(PG8_SB(0, 0), cB, voffB); PG8_STAGE(PG8_SA(0, 0), cA, voffA); PG8_STAGE(PG8_SB(0, 1), cB + hstep, voffB); PG8_STAGE(PG8_SA(0, 1), cA + hstep, voffA);
    if (wr == 1) PG8_BAR;
    PG8_WAIT_V(4); PG8_BAR;
    PG8_STAGE(PG8_SB(1, 0), cB + kstep, voffB); PG8_STAGE(PG8_SA(1, 0), cA + kstep, voffA); PG8_STAGE(PG8_SB(1, 1), cB + hstep + kstep, voffB);
    PG8_WAIT_V(6); PG8_BAR;
    for (;;) {
        const bool has_next = S.next(ui + 1, nxt);
        const char* nA = has_next ? (const char*)g.A + (size_t)tile_row(nxt.pm) * K * 2 : cA; const char* nB = has_next ? (const char*)g.Bt + (size_t)nxt.pn * tstep : cB;
        for (int t = 0; t < nt; t += 2) {
            const bool last = (t == nt - 2);
            const char* a1 = cA + (size_t)(t + 1) * kstep;
            const char* a2 = last ? nA : cA + (size_t)(t + 2) * kstep; const char* b2 = last ? nB : cB + (size_t)(t + 2) * kstep;
            const char* a3 = a2 + kstep; const char* b3 = b2 + kstep;
            if (last && has_next) S.a_ready(nxt);
            PG8_LDB(B0, 0, 0); PG8_SCHED; PG8_LDA(At, 0, 0); PG8_STAGE(PG8_SA(1, 1), a1 + hstep, voffA);
            PG8_WAIT_L(8); PG8_BAR; PG8_WAIT_L(0); PG8_MMA(0, 0, At, B0); PG8_BAR; PG8_SCHED;
            PG8_LDB(B1, 0, 1); PG8_STAGE(PG8_SB(0, 0), b2, voffB);
            PG8_BAR; PG8_WAIT_L(0); PG8_MMA(0, 1, At, B1); PG8_BAR;
            PG8_LDA(At, 0, 1); PG8_STAGE(PG8_SA(0, 0), a2, voffA);
            PG8_BAR; PG8_WAIT_L(0); PG8_MMA(1, 0, At, B0); PG8_BAR; PG8_SCHED;
            PG8_STAGE(PG8_SB(0, 1), b2 + hstep, voffB);
            PG8_WAIT_V(6); PG8_BAR; PG8_MMA(1, 1, At, B1); PG8_BAR;
            PG8_LDB(B0, 1, 0); PG8_SCHED; PG8_LDA(At, 1, 0); PG8_STAGE(PG8_SA(0, 1), a2 + hstep, voffA);
            PG8_WAIT_L(8); PG8_BAR; PG8_WAIT_L(0); PG8_MMA(0, 0, At, B0); PG8_BAR; PG8_SCHED;
            PG8_LDB(B1, 1, 1); PG8_STAGE(PG8_SB(1, 0), b3, voffB);
            PG8_BAR; PG8_WAIT_L(0); PG8_MMA(0, 1, At, B1); PG8_BAR;
            PG8_LDA(At, 1, 1); PG8_STAGE(PG8_SA(1, 0), a3, voffA);
            PG8_BAR; PG8_WAIT_L(0); PG8_MMA(1, 0, At, B0); PG8_BAR; PG8_SCHED;
            PG8_STAGE(PG8_SB(1, 1), b3 + hstep, voffB);
            PG8_WAIT_V(6); PG8_BAR; PG8_MMA(1, 1, At, B1); PG8_BAR;
        }
        if constexpr (!Epi::AFTER_DRAIN) { E(acc, cur, wr, wc, fr, fq); S.done(cur); }
        if (!has_next) break;
#pragma unroll
        for (int a = 0; a < 2; ++a)
#pragma unroll
            for (int b = 0; b < 2; ++b)
#pragma unroll
                for (int m = 0; m < 4; ++m)
#pragma unroll
                    for (int n = 0; n < 2; ++n) acc[a][b][m][n] = (f32x4){0.f, 0.f, 0.f, 0.f};
        cur = nxt; cA = nA; cB = nB; ++ui;
    }
    PG8_WAIT_V(0);
    if (wr == 0) PG8_BAR;
    PG8_BAR;
    if constexpr (Epi::AFTER_DRAIN) { E.fused(acc, cur, wr, wc, fr, fq, lds, wid, lane); S.done(cur); }
#undef PG8_SA
#undef PG8_SB
#undef PG8_STAGE
#undef PG8_LDA
#undef PG8_LDB
#undef PG8_MMA
#undef PG8_WAIT_V
#undef PG8_WAIT_L
#undef PG8_BAR
#undef PG8_SCHED
}
}
__device__ __forceinline__ float row_rinv(const GAS float* ss, int row) {
    const GAS f32x4* p = (const GAS f32x4*)(ss + (size_t)row * 16);
    const f32x4 a = p[0], b = p[1], c = p[2], d = p[3];
    const float s = ((a[0] + a[1]) + (a[2] + a[3])) + ((b[0] + b[1]) + (b[2] + b[3])) + ((c[0] + c[1]) + (c[2] + c[3])) + ((d[0] + d[1]) + (d[2] + d[3]));
    return 1.0f / sqrtf(s * (1.0f / 1024.0f) + RMS_EPS);
}
struct EpiScale {
    static constexpr bool PERM = true, AFTER_DRAIN = false;
    GAS bf16_t* O0; int ld0; int split; GAS bf16_t* O1; int ld1; const GAS float* ss; GAS bf16_t* vT;
    const LAS float* rinv_lds; const LAS int* pm_lds;
    __device__ __forceinline__ void operator()(const f32x4 (&acc)[2][2][4][2], const pg8::Unit& u, int wr, int wc, int fr, int fq) const {
        asm volatile("" : "+v"(fr), "+v"(fq));
        const int row0 = pg8::tile_row(u.pm) + wr * 64 + fr; const int colt = u.pn * 256;
        GAS bf16_t* base; int ldc, c0;
        if (colt < split) { base = O0; ldc = ld0; c0 = colt; } else { base = O1; ldc = ld1; c0 = colt - split; }
        const int col0 = c0 + wc * 32 + 8 * fq;
        const bool dovt = (vT != nullptr) && (colt == 256);
        int uslot = 0;
#pragma unroll
        for (int q = 1; q < 4; ++q) if (pm_lds[q] == u.pm && pm_lds[0] != u.pm) uslot = (uslot == 0) ? q : uslot;
#pragma unroll
        for (int ai = 0; ai < 2; ++ai)
#pragma unroll
            for (int m = 0; m < 4; ++m) {
                const int row = row0 + ai * 128 + m * 16;
                const float ri = rinv_lds[uslot * 256 + wr * 64 + fr + ai * 128 + m * 16];
                GAS bf16_t* rowp = base + (size_t)row * ldc + col0;
#pragma unroll
                for (int bj = 0; bj < 2; ++bj) {
                    const f32x4 v0 = acc[ai][bj][m][0] * ri, v1 = acc[ai][bj][m][1] * ri;
                    u32x4 w; w.x = pk2(v0[0], v0[1]); w.y = pk2(v0[2], v0[3]); w.z = pk2(v1[0], v1[1]); w.w = pk2(v1[2], v1[3]);
                    *(GAS u32x4*)(rowp + bj * 128) = w;
                    if (dovt) {
                        const int b = row / TP, t = row - b * TP;
                        GAS bf16_t* vp = vT + ((size_t)(b * 2 + bj) * 128 + wc * 32 + 8 * fq) * TP + t;
                        vp[0 * TP] = (bf16_t)(w.x & 0xffff); vp[1 * TP] = (bf16_t)(w.x >> 16); vp[2 * TP] = (bf16_t)(w.y & 0xffff); vp[3 * TP] = (bf16_t)(w.y >> 16);
                        vp[4 * TP] = (bf16_t)(w.z & 0xffff); vp[5 * TP] = (bf16_t)(w.z >> 16); vp[6 * TP] = (bf16_t)(w.w & 0xffff); vp[7 * TP] = (bf16_t)(w.w >> 16);
                    }
                }
            }
    }
    __device__ __forceinline__ void tail(const f32x4 (&acc)[4], int b, int ng, int lane) const {
        const int colt = (ng * 64) & ~255; GAS bf16_t* base; int ldc, c0;
        if (colt < split) { base = O0; ldc = ld0; c0 = ng * 64; } else { base = O1; ldc = ld1; c0 = ng * 64 - split; }
        const bool dovt = (vT != nullptr) && (colt == 256);
#pragma unroll
        for (int i = 0; i < 4; ++i) {
            const int t = 4 * (lane >> 4) + i, row = b * TP + t; const float ri = row_rinv(ss, row);
#pragma unroll
            for (int nt = 0; nt < 4; ++nt) {
                const int col = c0 + nt * 16 + (lane & 15); const bf16_t w = (bf16_t)f2bf(acc[nt][i] * ri);
                base[(size_t)row * ldc + col] = w;
                if (dovt) { const int vc = ng * 64 - 256 + nt * 16 + (lane & 15); vT[((size_t)(b * 2 + (vc >> 7)) * 128 + (vc & 127)) * TP + t] = w; }
            }
        }
    }
};
struct EpiResid {
    static constexpr bool PERM = false, AFTER_DRAIN = false;
    GAS float* H; GAS bf16_t* HB; GAS float* ss; GAS unsigned char* HB8;
    __device__ __forceinline__ void operator()(const f32x4 (&acc)[2][2][4][2], const pg8::Unit& u, int wr, int wc, int fr, int fq) const {
        asm volatile("" : "+v"(fr), "+v"(fq));
        const int row0 = pg8::tile_row(u.pm) + wr * 64 + fr, col0 = u.pn * 256 + wc * 32 + 4 * fq;
        f32x4 hn[4];
#pragma unroll
        for (int q = 0; q < 4; ++q) hn[q] = *(const GAS f32x4*)(H + (size_t)row0 * 1024 + col0 + (q >> 1) * 128 + (q & 1) * 16);
#pragma unroll
        for (int gi = 0; gi < 8; ++gi) {
            const int ai = gi >> 2, m = gi & 3;
            const int row = row0 + ai * 128 + m * 16; float s = 0.f;
            GAS float* hp = H + (size_t)row * 1024 + col0; GAS bf16_t* bp = HB + (size_t)row * 1024 + col0;
            f32x4 hc[4];
#pragma unroll
            for (int q = 0; q < 4; ++q) hc[q] = hn[q];
            if (gi < 7) { const int rown = row0 + ((gi + 1) >> 2) * 128 + ((gi + 1) & 3) * 16;
#pragma unroll
                for (int q = 0; q < 4; ++q) hn[q] = *(const GAS f32x4*)(H + (size_t)rown * 1024 + col0 + (q >> 1) * 128 + (q & 1) * 16); }
#pragma unroll
            for (int bj = 0; bj < 2; ++bj)
#pragma unroll
                for (int n = 0; n < 2; ++n) {
                    const f32x4 hv = hc[bj * 2 + n] + acc[ai][bj][m][n];
                    *(GAS f32x4*)(hp + bj * 128 + n * 16) = hv;
                    s += (hv[0] * hv[0] + hv[1] * hv[1]) + (hv[2] * hv[2] + hv[3] * hv[3]);
                    u32x2 w; w.x = pk2(hv[0], hv[1]); w.y = pk2(hv[2], hv[3]);
                    *(GAS u32x2*)(bp + bj * 128 + n * 16) = w;
                }
            s += __shfl_xor(s, 16); s += __shfl_xor(s, 32);
            if (fq == 0) ss[(size_t)row * 16 + u.pn * 4 + wc] = s;
        }
    }
    __device__ __forceinline__ void tail(const f32x4 (&acc)[4], int b, int ng, int lane) const {
#pragma unroll
        for (int i = 0; i < 4; ++i) {
            const int t = 4 * (lane >> 4) + i, row = b * TP + t; float s = 0.f;
#pragma unroll
            for (int nt = 0; nt < 4; ++nt) {
                const int col = ng * 64 + nt * 16 + (lane & 15); const size_t o = (size_t)row * 1024 + col;
                const float hv = H[o] + acc[nt][i]; H[o] = hv; HB[o] = (bf16_t)f2bf(hv); s += hv * hv;
            }
            s += __shfl_xor(s, 1); s += __shfl_xor(s, 2); s += __shfl_xor(s, 4); s += __shfl_xor(s, 8);
            if ((lane & 15) == 0) ss[(size_t)row * 16 + ng] = s;
        }
    }
};

__device__ __forceinline__ int unit_pm_of(const pg8::StaticOrder& S, int i) {
    const long L = (long)i * S.G + S.c; if (L >= S.nwg) return -1;
    int wgid = (int)L; { const int q = S.nwg / pg8::NXCD, r = S.nwg % pg8::NXCD, xcd = wgid % pg8::NXCD, off = wgid / pg8::NXCD; wgid = (xcd < r ? xcd * (q + 1) : r * (q + 1) + (xcd - r) * q) + off; }
    const int nig = pg8::WGM * S.nN, gid = wgid / nig, fm = gid * pg8::WGM, gsz = (S.nM - fm) < pg8::WGM ? (S.nM - fm) : pg8::WGM;
    return fm + ((wgid % nig) % gsz);
}
template <class Epi>
__device__ __forceinline__ void gemm_tail(const GAS bf16_t* A, const GAS bf16_t* Bt, int N, const Epi& E, int gw, int NGW, int lane, LAS unsigned char* lds) {
    const int r = lane & 15, g = lane >> 4, njobs = BATCH * (N / 64);
    const int G_ = NGW / NWAVES, wv_ = gw % NWAVES, bk_ = gw / NWAVES;
    LAS f32x4* RED = (LAS f32x4*)lds;
#pragma unroll 1
    for (int job = bk_; job < njobs; job += G_) {
        const int b = job & 3, ng = job >> 2;
        const GAS bf16_t* ap = A + ((size_t)b * TP + r) * 1024 + 8 * g + wv_ * 128; const GAS bf16_t* bp = Bt + ((size_t)ng * 64 + r) * 1024 + 8 * g + wv_ * 128;
        bf16x8 af[4], bf[4][4];
#pragma unroll
        for (int ks = 0; ks < 4; ++ks) { af[ks] = *(const GAS bf16x8*)(ap + ks * 32);
#pragma unroll
            for (int nt = 0; nt < 4; ++nt) bf[nt][ks] = *(const GAS bf16x8*)(bp + (size_t)nt * 16 * 1024 + ks * 32); }
        f32x4 acc[4];
#pragma unroll
        for (int nt = 0; nt < 4; ++nt) { acc[nt] = (f32x4){0.f, 0.f, 0.f, 0.f};
#pragma unroll
            for (int ks = 0; ks < 4; ++ks) acc[nt] = MFMA16(af[ks], bf[nt][ks], acc[nt]); }
#pragma unroll
        for (int nt = 0; nt < 4; ++nt) RED[(wv_ * 4 + nt) * 64 + lane] = acc[nt];
        __syncthreads();
        if (wv_ == 0) {
#pragma unroll
            for (int nt = 0; nt < 4; ++nt) {
#pragma unroll
                for (int w = 1; w < 8; ++w) acc[nt] += RED[(w * 4 + nt) * 64 + lane];
            }
            E.tail(acc, b, ng, lane);
        }
        __syncthreads();
    }
}

struct Args {
    const float* in[17]; float* out; unsigned char* ws;
    double inv32[16]; double inv16[8];
};
struct Frame {
    LAS unsigned char* lds; GAS unsigned char* ws; int tid, lane, wave, G, gw, NGW;
};

__device__ __forceinline__ void p0_transpose_item(const float* W, int N, const float* gain, GAS bf16_t* WT, LAS float* scr, int item, int lane, int nblk) {
    const int kb = item / nblk, nb = item - kb * nblk, k0 = 64 * kb, n0 = 32 * nb;
    const int n = n0 + (lane & 31);
#pragma unroll 8
    for (int i = 0; i < 32; ++i) { const int kk = 2 * i + (lane >> 5); float v = 0.f; if (n < N) { v = W[(size_t)(k0 + kk) * N + n]; if (gain) v *= gain[k0 + kk]; } scr[kk * 33 + (lane & 31)] = v; }
    asm volatile("s_waitcnt lgkmcnt(0)" ::: "memory");
    const int c = lane & 7;
#pragma unroll
    for (int j = 0; j < 4; ++j) { const int nn = (lane >> 3) + 8 * j; const LAS float* s = scr + (8 * c) * 33 + nn;
        u32x4 o; o.x = pk2(s[0 * 33], s[1 * 33]); o.y = pk2(s[2 * 33], s[3 * 33]); o.z = pk2(s[4 * 33], s[5 * 33]); o.w = pk2(s[6 * 33], s[7 * 33]);
        *(GAS u32x4*)(WT + (size_t)(n0 + nn) * 1024 + k0 + 8 * c) = o; }
    asm volatile("s_waitcnt lgkmcnt(0)" ::: "memory");
}
__device__ __forceinline__ void sincos_rev(double ang, float& c, float& s) {
    double rev = ang * 0.15915494309189533577; rev -= rint(rev);
    const double r = rev * 6.28318530717958647692, r2 = r * r;
    double ts = r, ss = r, tc = 1.0, cc = 1.0;
#pragma unroll
    for (int k = 1; k <= 13; ++k) { tc *= -r2 / (double)((2 * k - 1) * (2 * k)); cc += tc; ts *= -r2 / (double)((2 * k) * (2 * k + 1)); ss += ts; }
    c = (float)cc; s = (float)ss;
}
__device__ __forceinline__ void phase_prologue(const Frame& F, const Args& a) {
    GAS unsigned char* ws = F.ws;
    {
        LAS float* scr = (LAS float*)(F.lds + F.wave * 8704);
        const float* a_norm = a.in[2]; const float* a_w_in = a.in[3]; const float* a_w_o = a.in[6]; const float* kv_norm = a.in[7]; const float* kv_w = a.in[8];
        const float* b_norm = a.in[9]; const float* b_w_q = a.in[10]; const float* b_w_o = a.in[11]; const float* ffn_norm = a.in[12]; const float* peer_w_q = a.in[13];
        constexpr int I2048 = 16 * 64, I1024 = 16 * 32, I512 = 16 * 16;
        constexpr int NITEMS = 2 * I2048 + 2 * I1024 + I512 + I1024 + I1024 + 2 * I1024 + 4 * I2048;
        for (int it = F.gw; it < NITEMS; it += F.NGW) {
            int r = it;
            if (r < 2 * I2048) { const int l = r / I2048; r -= l * I2048; p0_transpose_item(a_w_in + (size_t)l * 1024 * ACOLS, ACOLS, a_norm + l * 1024, (GAS bf16_t*)(ws + WS_WIN) + (size_t)l * 2048 * 1024, scr, r, F.lane, 64); continue; } r -= 2 * I2048;
            if (r < 2 * I1024) { const int l = r / I1024; r -= l * I1024; p0_transpose_item(a_w_o + (size_t)l * 1024 * 1024, 1024, nullptr, (GAS bf16_t*)(ws + WS_WOA) + (size_t)l * 1024 * 1024, scr, r, F.lane, 32); continue; } r -= 2 * I1024;
            if (r < I512) { p0_transpose_item(kv_w, 512, kv_norm, (GAS bf16_t*)(ws + WS_WKVQ), scr, r, F.lane, 16); continue; } r -= I512;
            if (r < I1024) { p0_transpose_item(b_w_q, 1024, b_norm, (GAS bf16_t*)(ws + WS_WKVQ) + (size_t)512 * 1024, scr, r, F.lane, 32); continue; } r -= I1024;
            if (r < I1024) { p0_transpose_item(b_w_q + (size_t)1024 * 1024, 1024, b_norm + 1024, (GAS bf16_t*)(ws + WS_WBQ1), scr, r, F.lane, 32); continue; } r -= I1024;
            if (r < 2 * I1024) { const int l = r / I1024; r -= l * I1024; p0_transpose_item(b_w_o + (size_t)l * 1024 * 1024, 1024, nullptr, (GAS bf16_t*)(ws + WS_WOB) + (size_t)l * 1024 * 1024, scr, r, F.lane, 32); continue; } r -= 2 * I1024;
            { const int l = r / I2048; r -= l * I2048; p0_transpose_item(peer_w_q + (size_t)l * 1024 * 2048, 2048, ffn_norm + l * 1024, (GAS bf16_t*)(ws + WS_WPQ) + (size_t)l * 2048 * 1024, scr, r, F.lane, 64); }
        }
    }
    const size_t gtid = (size_t)blockIdx.x * NT + F.tid, gthreads = (size_t)F.G * NT;
    {
        const float* pu = a.in[15]; const float* pv = a.in[16]; const float* ffn_norm = a.in[12];
        GAS unsigned char* U = (GAS unsigned char*)(ws + WS_U); GAS unsigned char* V = (GAS unsigned char*)(ws + WS_V);
        const int lane = F.lane;
#pragma unroll 1
        for (int l = 0; l < 4; ++l) {
            f32x4 gq[4];
#pragma unroll
            for (int q = 0; q < 4; ++q) gq[q] = *(const f32x4*)(ffn_norm + l * 1024 + 256 * q + 4 * lane) * U_SCALE;
#pragma unroll 2
            for (int ex = F.gw; ex < NEXP; ex += F.NGW) {
                const size_t ro = ((size_t)l * NEXP + ex) * 1024 + 4 * lane;
                f32x4 u4[4], v4[4];
#pragma unroll
                for (int q = 0; q < 4; ++q) { u4[q] = __builtin_nontemporal_load((const f32x4*)(pu + ro + 256 * q)); v4[q] = __builtin_nontemporal_load((const f32x4*)(pv + ro + 256 * q)); }
#pragma unroll
                for (int q = 0; q < 4; ++q) {
                    f32x4 u0 = u4[q] * gq[q], v0 = v4[q] * V_SCALE;
#pragma unroll
                    for (int k = 0; k < 4; ++k) { u0[k] = fminf(fmaxf(u0[k], -416.f), 416.f); v0[k] = fminf(fmaxf(v0[k], -416.f), 416.f); }
                    int wu = __builtin_amdgcn_cvt_pk_fp8_f32(u0[0], u0[1], 0, false); wu = __builtin_amdgcn_cvt_pk_fp8_f32(u0[2], u0[3], wu, true);
                    int wv = __builtin_amdgcn_cvt_pk_fp8_f32(v0[0], v0[1], 0, false); wv = __builtin_amdgcn_cvt_pk_fp8_f32(v0[2], v0[3], wv, true);
                    const size_t so = (((size_t)l * 8 + 2 * q + (lane >> 5)) * NEXP + ex) * 128 + 4 * (lane & 31);
                    *(GAS unsigned*)(U + so) = (unsigned)wu; *(GAS unsigned*)(V + so) = (unsigned)wv;
                }
            }
        }
    }
    { const float* sk = a.in[14]; GAS bf16_t* o = (GAS bf16_t*)(ws + WS_SK); for (size_t i = gtid; i < (size_t)4 * 2 * 128 * 128; i += gthreads) o[i] = (bf16_t)f2bf(sk[i]); }
    {
        GAS f32x2* r32 = (GAS f32x2*)(ws + WS_ROPE32); GAS f32x2* r16 = (GAS f32x2*)(ws + WS_ROPE16);
        for (size_t i = gtid; i < (size_t)TP * 24; i += gthreads) {
            const int t = (int)(i / 24), j = (int)(i - (size_t)t * 24); float c, s;
            if (j < 16) { sincos_rev((double)t * a.inv32[j], c, s); r32[t * 16 + j] = (f32x2){c, s}; }
            else { sincos_rev((double)t * a.inv16[j - 16], c, s); r16[t * 8 + (j - 16)] = (f32x2){c, s}; }
        }
    }
    {
        const float* x = a.in[0]; const float* meta = a.in[1];
        GAS float* H = (GAS float*)(ws + WS_H); GAS bf16_t* HB = (GAS bf16_t*)(ws + WS_HB); GAS float* SS = (GAS float*)(ws + WS_SS); GAS bf16_t* O = (GAS bf16_t*)(ws + WS_O);
        for (int row = F.gw; row < NR; row += F.NGW) {
            const int b = row / TP, t = row - b * TP;
            f32x4 v[4]; float s = 0.f;
#pragma unroll
            for (int j = 0; j < 4; ++j) {
                if (t < NMETA) v[j] = *(const f32x4*)(meta + (size_t)t * 1024 + 256 * j + 4 * F.lane);
                else if (t < TT) v[j] = *(const f32x4*)(x + ((size_t)b * SEQ + (t - NMETA)) * 1024 + 256 * j + 4 * F.lane);
                else v[j] = (f32x4){0.f, 0.f, 0.f, 0.f};
                s += (v[j][0] * v[j][0] + v[j][1] * v[j][1]) + (v[j][2] * v[j][2] + v[j][3] * v[j][3]);
            }
            s = wave_sum(s);
#pragma unroll
            for (int j = 0; j < 4; ++j) {
                *(GAS f32x4*)(H + (size_t)row * 1024 + 256 * j + 4 * F.lane) = v[j];
                u32x2 w; w.x = pk2(v[j][0], v[j][1]); w.y = pk2(v[j][2], v[j][3]);
                *(GAS u32x2*)(HB + (size_t)row * 1024 + 256 * j + 4 * F.lane) = w;
                if (t >= TT) *(GAS u32x2*)(O + (size_t)row * 1024 + 256 * j + 4 * F.lane) = (u32x2){0u, 0u};
            }
            if (F.lane < 16) SS[(size_t)row * 16 + F.lane] = (F.lane == 0) ? s : 0.f;
        }
    }
}
#ifndef TRB8_HYP
#define TRB8_HYP 0
#endif
#if TRB8_HYP == 0
#define TRB8_ROW(r) ((r) >> 1)
#define TRB8_COL(r) ((r) & 1)
#else
#define TRB8_ROW(r) ((r) & 7)
#define TRB8_COL(r) ((r) >> 3)
#endif
__device__ __forceinline__ void unpack8(const u32x4& w, float (&x)[8]) {
#pragma unroll
    for (int k = 0; k < 4; ++k) { x[2 * k] = bflo(w[k]); x[2 * k + 1] = bfhi(w[k]); }
}
__device__ __forceinline__ u32x4 pack8(const float (&x)[8]) { u32x4 w; w.x = pk2(x[0], x[1]); w.y = pk2(x[2], x[3]); w.z = pk2(x[4], x[5]); w.w = pk2(x[6], x[7]); return w; }
__device__ __forceinline__ void phase_a_post(const Frame& F, const float* qgain, const float* kgain) {
    GAS unsigned char* ws = F.ws;
    const GAS bf16_t* PROJ = (const GAS bf16_t*)(ws + WS_PROJ);
    GAS unsigned char* Q8 = ws + WS_Q8; GAS unsigned char* K8 = ws + WS_K8; GAS unsigned char* V8 = ws + WS_V8; GAS bf16_t* QI = (GAS bf16_t*)(ws + WS_QI); GAS bf16_t* KI = (GAS bf16_t*)(ws + WS_KI); GAS float* WI = (GAS float*)(ws + WS_WI);
    const GAS f32x2* r32 = (const GAS f32x2*)(ws + WS_ROPE32); const GAS f32x2* r16 = (const GAS f32x2*)(ws + WS_ROPE16);
    const int lane = F.lane, l16 = lane & 15;
    float qg[8], kg[8];
#pragma unroll
    for (int j = 0; j < 8; ++j) { qg[j] = qgain[l16 * 8 + j]; kg[j] = kgain[l16 * 8 + j]; }
    for (int rown = F.gw; rown < BATCH * TT; rown += F.NGW) {
        const int b = rown / TT, t = rown - b * TT; const int row = b * TP + t;
        const GAS bf16_t* pr = PROJ + (size_t)row * 2048;
        const u32x4 wA = *(const GAS u32x4*)(pr + 8 * lane), wB = *(const GAS u32x4*)(pr + 512 + 8 * lane), wC = *(const GAS u32x4*)(pr + 1024 + 8 * lane), wD = *(const GAS u32x4*)(pr + 1536 + 8 * lane);
        f32x2 cs32[8], cs16[8];
#pragma unroll
        for (int j = 0; j < 8; ++j) { cs32[j] = r32[t * 16 + (lane & 1) * 8 + j]; cs16[j] = r16[t * 8 + j]; }
#pragma unroll
        for (int gp = 0; gp < 3; ++gp) {
            float x[8]; unpack8(gp == 0 ? wA : (gp == 1 ? wB : wC), x);
            float ssq = 0.f;
#pragma unroll
            for (int j = 0; j < 8; ++j) ssq += x[j] * x[j];
            ssq += __shfl_xor(ssq, 1); ssq += __shfl_xor(ssq, 2); ssq += __shfl_xor(ssq, 4); ssq += __shfl_xor(ssq, 8);
            const float ri = 1.0f / sqrtf(ssq * (1.0f / 128.0f) + RMS_EPS);
            const bool rot = l16 < 4, second = (lane & 2) != 0;
#pragma unroll
            for (int j = 0; j < 8; ++j) {
                float y = x[j] * ri * (gp < 2 ? qg[j] : kg[j]);
                const float p = __shfl_xor(y, 2);
                if (rot) y = second ? (y * cs32[j].x + p * cs32[j].y) : (y * cs32[j].x - p * cs32[j].y);
                x[j] = (gp < 2) ? y * 0.08838834764831845f : y;
            }
            {
                const float sc = (gp < 2) ? Q_SCALE : K_SCALE; float y8[8];
#pragma unroll
                for (int j = 0; j < 8; ++j) y8[j] = fminf(fmaxf(x[j] * sc, -416.f), 416.f);
                int w0 = __builtin_amdgcn_cvt_pk_fp8_f32(y8[0], y8[1], 0, false); w0 = __builtin_amdgcn_cvt_pk_fp8_f32(y8[2], y8[3], w0, true);
                int w1 = __builtin_amdgcn_cvt_pk_fp8_f32(y8[4], y8[5], 0, false); w1 = __builtin_amdgcn_cvt_pk_fp8_f32(y8[6], y8[7], w1, true);
                if (gp < 2) *(GAS u32x2*)(Q8 + (size_t)row * 1024 + gp * 512 + 8 * lane) = (u32x2){(unsigned)w0, (unsigned)w1};
                else if (lane < 32) *(GAS u32x2*)(K8 + (size_t)row * 256 + 8 * lane) = (u32x2){(unsigned)w0, (unsigned)w1};
            }
            if (gp == 2 && lane >= 32) {
                float xv[8]; unpack8(wC, xv);
#pragma unroll
                for (int j = 0; j < 8; ++j) xv[j] = fminf(fmaxf(xv[j] * V8_SCALE, -416.f), 416.f);
                int w0 = __builtin_amdgcn_cvt_pk_fp8_f32(xv[0], xv[1], 0, false); w0 = __builtin_amdgcn_cvt_pk_fp8_f32(xv[2], xv[3], w0, true);
                int w1 = __builtin_amdgcn_cvt_pk_fp8_f32(xv[4], xv[5], 0, false); w1 = __builtin_amdgcn_cvt_pk_fp8_f32(xv[6], xv[7], w1, true);
                *(GAS u32x2*)(V8 + (size_t)row * 256 + 8 * (lane - 32)) = (u32x2){(unsigned)w0, (unsigned)w1};
            }
        }
        {
            float x[8]; unpack8(wD, x);
            const bool rot = (lane & 7) < 2 && lane < 40, second = (lane & 1) != 0;
#pragma unroll
            for (int j = 0; j < 8; ++j) {
                float y = x[j]; const float p = __shfl_xor(y, 1);
                if (rot) y = second ? (y * cs16[j].x + p * cs16[j].y) : (y * cs16[j].x - p * cs16[j].y);
                x[j] = (lane < 32) ? y * 0.125f : y;
            }
            if (lane < 32) *(GAS u32x4*)(QI + (size_t)row * 256 + 8 * lane) = pack8(x);
            else if (lane < 40) *(GAS u32x4*)(KI + (size_t)row * 64 + 8 * (lane - 32)) = pack8(x);
            else if (lane == 40) *(GAS f32x4*)(WI + (size_t)row * 4) = (f32x4){x[0] * 0.5f, x[1] * 0.5f, x[2] * 0.5f, x[3] * 0.5f};
        }
    }
}

constexpr int SCS = 4232;
constexpr int DSA_SC = 0, DSA_HIST = 8 * SCS * 4, DSA_SEL = DSA_HIST + 8 * 256 * 4;
__device__ __forceinline__ int wave_incl_scan(int v, int lane) {
#pragma unroll
    for (int o = 1; o < 64; o <<= 1) { const int t = __shfl_up(v, o); if (lane >= o) v += t; }
    return v;
}
__device__ __forceinline__ void phase_dsa_sel(const Frame& F) {
    GAS unsigned char* ws = F.ws;
    GAS bf16_t* SELG = (GAS bf16_t*)(ws + WS_SELG); const GAS bf16_t* QI = (const GAS bf16_t*)(ws + WS_QI);
    const GAS bf16_t* KI = (const GAS bf16_t*)(ws + WS_KI); const GAS float* WI = (const GAS float*)(ws + WS_WI);
    LAS unsigned* SC = (LAS unsigned*)(F.lds + DSA_SC); LAS unsigned* HIST = (LAS unsigned*)(F.lds + DSA_HIST) + F.wave * 256; LAS unsigned* SEL = (LAS unsigned*)(F.lds + DSA_SEL) + F.wave * 256;
    const int lane = F.lane, wave = F.wave, r = lane & 15, g = lane >> 4;
    const unsigned long long ltmask = (1ull << lane) - 1ull;
    constexpr int NITEM = BATCH * (TT / 8), NFIRST = (NITEM / 256) * 256;
    for (int it = blockIdx.x; it < NITEM; it += F.G) {
        const int b = it & 3, qb = (it < NFIRST) ? (it >> 2) + (NITEM - NFIRST) / 4 : (it - NFIRST) >> 2, t0 = qb * 8, nkeys = t0 + 8;
        const size_t rb = (size_t)b * TP;
        {
            bf16x8 A[2][2]; f32x4 wv[2];
#pragma unroll
            for (int mt = 0; mt < 2; ++mt) {
                const GAS bf16_t* qp = QI + (rb + t0 + 4 * mt + (r >> 2)) * 256 + (r & 3) * 64 + 8 * g;
                A[mt][0] = *(const GAS bf16x8*)qp; A[mt][1] = *(const GAS bf16x8*)(qp + 32);
                wv[mt] = *(const GAS f32x4*)(WI + (rb + t0 + 4 * mt + g) * 4);
            }
            const int ntile = (nkeys + 15) >> 4;
            LAS unsigned char* KTL = F.lds + DSA_HIST + wave * 2048;
            const int kq8 = lane >> 3, c8 = lane & 7;
#pragma unroll 1
            for (int kt0 = wave; kt0 < ntile; kt0 += 32) {
                u32x4 kl[4][2];
#pragma unroll
                for (int u = 0; u < 4; ++u)
#pragma unroll
                    for (int h = 0; h < 2; ++h) kl[u][h] = *(const GAS u32x4*)(KI + (rb + (kt0 + 8 * u) * 16 + 8 * h + kq8) * 64 + 8 * c8);
#pragma unroll
                for (int u = 0; u < 4; ++u) {
                    const int kt = kt0 + 8 * u;
                    if (kt < ntile) {
#pragma unroll
                        for (int h = 0; h < 2; ++h) { const int rw = 8 * h + kq8; *(LAS u32x4*)(KTL + rw * 128 + ((c8 ^ (rw & 7)) << 4)) = kl[u][h]; }
                        const bf16x8 B0 = *(const LAS bf16x8*)(KTL + r * 128 + ((g ^ (r & 7)) << 4)), B1 = *(const LAS bf16x8*)(KTL + r * 128 + (((4 + g) ^ (r & 7)) << 4));
                        const int key = kt * 16 + r;
#pragma unroll
                        for (int mt = 0; mt < 2; ++mt) {
                            f32x4 d = (f32x4){0.f, 0.f, 0.f, 0.f};
                            d = MFMA16(A[mt][0], B0, d); d = MFMA16(A[mt][1], B1, d);
                            float s = fmaxf(d[0], 0.f) * wv[mt][0] + fmaxf(d[1], 0.f) * wv[mt][1] + fmaxf(d[2], 0.f) * wv[mt][2] + fmaxf(d[3], 0.f) * wv[mt][3];
                            if (s == 0.f) s = 0.f;
                            const int qpos = t0 + 4 * mt + g;
                            SC[(4 * mt + g) * SCS + key] = (key <= qpos) ? mono_key(s) : 0u;
                        }
                    }
                }
            }
        }
        __syncthreads();
        const int qpos = t0 + wave, n = qpos + 1;
        LAS unsigned* row = SC + wave * SCS;
        int cnt;
        if (n <= TOPK) { for (int i = lane; i < TOPK; i += 64) SEL[i] = (i < n) ? (unsigned)i : 0u; cnt = n; }
        else {
            unsigned kreg[65];
#pragma unroll
            for (int c = 0; c < 65; ++c) { const int i = 64 * c + lane; kreg[c] = (i < n) ? row[i] : 0u; }
            const int nch = (n + 63) >> 6;
            unsigned prefix = 0u, mask = 0u; int want = TOPK;
#pragma unroll 1
            for (int pass = 3; pass >= 0; --pass) {
                const int sh = pass * 8;
#pragma unroll
                for (int i = 0; i < 4; ++i) HIST[lane + 64 * i] = 0u;
#pragma unroll
                for (int cb = 0; cb < 65; cb += 13) {
                    if (cb < nch) {
#pragma unroll
                        for (int c = cb; c < cb + 13; ++c) { const unsigned k = kreg[c]; if ((64 * c + lane) < n && (k & mask) == prefix) __hip_atomic_fetch_add(&HIST[(k >> sh) & 255u], 1u, __ATOMIC_RELAXED, __HIP_MEMORY_SCOPE_WORKGROUP); }
                    }
                }
                asm volatile("s_waitcnt lgkmcnt(0)" ::: "memory");
                const int h0 = (int)HIST[255 - 4 * lane], h1 = (int)HIST[254 - 4 * lane], h2 = (int)HIST[253 - 4 * lane], h3 = (int)HIST[252 - 4 * lane];
                const int local = h0 + h1 + h2 + h3, incl = wave_incl_scan(local, lane), excl = incl - local;
                const bool here = (excl < want) && (want <= incl);
                int bin = 0, above = 0;
                if (here) { int c = excl;
                    if (c + h0 >= want) { bin = 255 - 4 * lane; above = c; } else { c += h0;
                    if (c + h1 >= want) { bin = 254 - 4 * lane; above = c; } else { c += h1;
                    if (c + h2 >= want) { bin = 253 - 4 * lane; above = c; } else { c += h2; bin = 252 - 4 * lane; above = c; } } } }
                const unsigned long long bm = __ballot(here);
                const int src = (int)__builtin_ctzll(bm);
                bin = __shfl(bin, src); above = __shfl(above, src);
                want -= above; prefix |= (unsigned)bin << sh; mask |= 0xFFu << sh;
            }
            const unsigned T = prefix; const int need = want;
            int outbase = 0, eqbase = 0;
#pragma unroll
            for (int cb = 0; cb < 65; cb += 13) {
                if (cb < nch) {
#pragma unroll
                    for (int c = cb; c < cb + 13; ++c) {
                        const int i = 64 * c + lane; const unsigned k = kreg[c];
                        const bool gt = k > T, eq = (k == T) && (i < n);
                        const unsigned long long beq = __ballot(eq);
                        const int eqrank = eqbase + __popcll(beq & ltmask);
                        const bool take = gt || (eq && eqrank < need);
                        const unsigned long long bt = __ballot(take);
                        const int pos = outbase + __popcll(bt & ltmask);
                        if (take && pos < TOPK) SEL[pos] = (unsigned)i;
                        outbase += __popcll(bt); eqbase += __popcll(beq);
                    }
                }
            }
            cnt = TOPK;
        }
        asm volatile("s_waitcnt lgkmcnt(0)" ::: "memory");
        { const unsigned s0 = SEL[4 * lane], s1 = SEL[4 * lane + 1], s2 = SEL[4 * lane + 2], s3 = SEL[4 * lane + 3];
          *(GAS u32x2*)(SELG + (rb + qpos) * 256 + 4 * lane) = (u32x2){s0 | (s1 << 16), s2 | (s3 << 16)}; }
        (void)cnt;
        __syncthreads();
    }
}

__device__ __forceinline__ void phase_dsa_attn(const Frame& F) {
    GAS unsigned char* ws = F.ws;
    const GAS unsigned char* Q8 = ws + WS_Q8; const GAS unsigned char* K8 = ws + WS_K8; const GAS unsigned char* V8 = ws + WS_V8; const GAS bf16_t* SELG = (const GAS bf16_t*)(ws + WS_SELG); GAS bf16_t* O = (GAS bf16_t*)(ws + WS_O);
    const int lane = F.lane, wave = F.wave, r = lane & 15, g = lane >> 4;
    volatile LAS unsigned* MISC = (volatile LAS unsigned*)(F.lds + MISC_OFF);
    const int xp = (int)MISC[4], nx = (int)MISC[5], xrank = (int)MISC[6], xn = (int)MISC[7];
    LAS unsigned* SEL = (LAS unsigned*)(F.lds) + wave * 256; LAS float* Pb = (LAS float*)(F.lds + 8192) + wave * 1024; LAS unsigned char* KT = F.lds + 40960 + wave * 8704; LAS unsigned char* PT8 = F.lds + 110592 + wave * 1024;
    const int wrank = xrank * NWAVES + wave, nw = xn * NWAVES;
#pragma unroll 1
    for (int P = xp; P < 2 * BATCH; P += nx) {
        const int b = P >> 1, kvh = P & 1;
        const size_t rb = (size_t)b * TP;
#pragma unroll 1
        for (int qpos = wrank; qpos < TT; qpos += nw) {
            const size_t qrow = rb + qpos;
            const int cnt = (qpos + 1 < TOPK) ? qpos + 1 : TOPK;
            { const u32x2 sw = *(const GAS u32x2*)(SELG + qrow * 256 + 4 * lane);
              SEL[4 * lane] = sw.x & 0xffffu; SEL[4 * lane + 1] = sw.x >> 16; SEL[4 * lane + 2] = sw.y & 0xffffu; SEL[4 * lane + 3] = sw.y >> 16; }
            asm volatile("s_waitcnt lgkmcnt(0)" ::: "memory");
            long Aq[4];
            {
                const GAS unsigned char* qp = Q8 + qrow * 1024 + (kvh * 4 + (r & 3)) * 128 + g * 32;
                u32x4 q0 = *(const GAS u32x4*)qp, q1 = *(const GAS u32x4*)(qp + 16);
                if (r >= 4) { q0 = (u32x4){0u, 0u, 0u, 0u}; q1 = q0; }
                Aq[0] = (long)(((unsigned long long)q0.y << 32) | q0.x); Aq[1] = (long)(((unsigned long long)q0.w << 32) | q0.z);
                Aq[2] = (long)(((unsigned long long)q1.y << 32) | q1.x); Aq[3] = (long)(((unsigned long long)q1.w << 32) | q1.z);
            }
#ifndef NO_QK
            {
                const int kq8 = lane >> 3, c8 = lane & 7;
                const GAS unsigned char* kbase = K8 + rb * 256 + kvh * 128 + 16 * c8;
                u32x4 ka[4], kb2[4];
#define DSA_LOADK(buf, st) do { _Pragma("unroll") for (int u_ = 0; u_ < 4; ++u_) { const int key_ = (int)SEL[(st) * 32 + 8 * u_ + kq8]; buf[u_] = *(const GAS u32x4*)(kbase + (size_t)key_ * 256); } } while (0)
#define DSA_QKSTEP(buf, st) do { _Pragma("unroll") for (int u_ = 0; u_ < 4; ++u_) *(LAS u32x4*)(KT + (8 * u_ + kq8) * 144 + 16 * c8) = buf[u_]; \
                    _Pragma("unroll") for (int h_ = 0; h_ < 2; ++h_) { f32x4 d_ = (f32x4){0.f, 0.f, 0.f, 0.f}; \
                        const u32x4 k0_ = *(const LAS u32x4*)(KT + (16 * h_ + r) * 144 + g * 32), k1_ = *(const LAS u32x4*)(KT + (16 * h_ + r) * 144 + g * 32 + 16); \
                        d_ = __builtin_amdgcn_mfma_f32_16x16x32_fp8_fp8(Aq[0], (long)(((unsigned long long)k0_.y << 32) | k0_.x), d_, 0, 0, 0); \
                        d_ = __builtin_amdgcn_mfma_f32_16x16x32_fp8_fp8(Aq[1], (long)(((unsigned long long)k0_.w << 32) | k0_.z), d_, 0, 0, 0); \
                        d_ = __builtin_amdgcn_mfma_f32_16x16x32_fp8_fp8(Aq[2], (long)(((unsigned long long)k1_.y << 32) | k1_.x), d_, 0, 0, 0); \
                        d_ = __builtin_amdgcn_mfma_f32_16x16x32_fp8_fp8(Aq[3], (long)(((unsigned long long)k1_.w << 32) | k1_.z), d_, 0, 0, 0); \
                        d_ *= (1.0f / (Q_SCALE * K_SCALE)); \
                        const int kk_ = (st) * 32 + 16 * h_ + r; if (kk_ >= cnt) d_ = (f32x4){-INFINITY, -INFINITY, -INFINITY, -INFINITY}; \
                        if (g == 0) *(LAS f32x4*)(Pb + kk_ * 4) = d_; } } while (0)
                DSA_LOADK(ka, 0);
#pragma unroll 1
                for (int st = 0; st < 8; st += 2) {
                    DSA_LOADK(kb2, st + 1);
                    DSA_QKSTEP(ka, st);
                    if (st + 2 < 8) DSA_LOADK(ka, st + 2);
                    DSA_QKSTEP(kb2, st + 1);
                }
            }
#endif
            asm volatile("s_waitcnt lgkmcnt(0)" ::: "memory");
            {
                f32x4 sv[4];
#pragma unroll
                for (int j = 0; j < 4; ++j) sv[j] = *(const LAS f32x4*)(Pb + (lane + 64 * j) * 4);
                float mx[4], sm[4];
#pragma unroll
                for (int i = 0; i < 4; ++i) { float m = fmaxf(fmaxf(sv[0][i], sv[1][i]), fmaxf(sv[2][i], sv[3][i]));
#pragma unroll
                    for (int o = 1; o < 64; o <<= 1) m = fmaxf(m, __shfl_xor(m, o));
                    mx[i] = m; }
#pragma unroll
                for (int i = 0; i < 4; ++i) { float t = 0.f;
#pragma unroll
                    for (int j = 0; j < 4; ++j) { const float e = __expf(sv[j][i] - mx[i]); sv[j][i] = e; t += e; }
                    sm[i] = 1.0f / wave_sum(t); }
#pragma unroll
                for (int j = 0; j < 4; ++j)
#pragma unroll
                    for (int i = 0; i < 4; ++i) { const int w8 = __builtin_amdgcn_cvt_pk_fp8_f32(sv[j][i] * sm[i] * P8_SCALE, 0.f, 0, false); PT8[i * 256 + lane + 64 * j] = (unsigned char)(w8 & 0xff); }
            }
            asm volatile("s_waitcnt lgkmcnt(0)" ::: "memory");
#ifndef NO_PV
            {
                const int kq8 = lane >> 3, c8 = lane & 7;
                const GAS unsigned char* vbase = V8 + rb * 256 + kvh * 128 + 16 * c8;
                f32x4 Od[8];
#pragma unroll
                for (int c = 0; c < 8; ++c) Od[c] = (f32x4){0.f, 0.f, 0.f, 0.f};
                const unsigned vt_lane = (unsigned)(size_t)KT + (unsigned)((8 * g + TRB8_ROW(r)) * 144 + 8 * TRB8_COL(r));
                u32x4 va[4], vb[4];
#define DSA_LOADV(buf, ks) do { _Pragma("unroll") for (int u_ = 0; u_ < 4; ++u_) { const int key_ = (int)SEL[(ks) * 32 + 8 * u_ + kq8]; buf[u_] = *(const GAS u32x4*)(vbase + (size_t)key_ * 256); } } while (0)
#define DSA_PVSTEP(buf, ks) do { _Pragma("unroll") for (int u_ = 0; u_ < 4; ++u_) *(LAS u32x4*)(KT + (8 * u_ + kq8) * 144 + 16 * c8) = buf[u_]; \
                    const u32x2 pw_ = *(const LAS u32x2*)(PT8 + (r & 3) * 256 + (ks) * 32 + 8 * g); const long pa_ = (long)(((unsigned long long)pw_.y << 32) | pw_.x); \
                    long t0_, t1_, t2_, t3_, t4_, t5_, t6_, t7_; \
                    asm volatile("ds_read_b64_tr_b8 %0, %8\n\tds_read_b64_tr_b8 %1, %8 offset:16\n\tds_read_b64_tr_b8 %2, %8 offset:32\n\tds_read_b64_tr_b8 %3, %8 offset:48\n\t" \
                                 "ds_read_b64_tr_b8 %4, %8 offset:64\n\tds_read_b64_tr_b8 %5, %8 offset:80\n\tds_read_b64_tr_b8 %6, %8 offset:96\n\tds_read_b64_tr_b8 %7, %8 offset:112\n\t" \
                                 "s_waitcnt lgkmcnt(0)" \
                                 : "=&v"(t0_), "=&v"(t1_), "=&v"(t2_), "=&v"(t3_), "=&v"(t4_), "=&v"(t5_), "=&v"(t6_), "=&v"(t7_) : "v"(vt_lane) : "memory"); \
                    __builtin_amdgcn_sched_barrier(0); \
                    Od[0] = __builtin_amdgcn_mfma_f32_16x16x32_fp8_fp8(pa_, t0_, Od[0], 0, 0, 0); Od[1] = __builtin_amdgcn_mfma_f32_16x16x32_fp8_fp8(pa_, t1_, Od[1], 0, 0, 0); \
                    Od[2] = __builtin_amdgcn_mfma_f32_16x16x32_fp8_fp8(pa_, t2_, Od[2], 0, 0, 0); Od[3] = __builtin_amdgcn_mfma_f32_16x16x32_fp8_fp8(pa_, t3_, Od[3], 0, 0, 0); \
                    Od[4] = __builtin_amdgcn_mfma_f32_16x16x32_fp8_fp8(pa_, t4_, Od[4], 0, 0, 0); Od[5] = __builtin_amdgcn_mfma_f32_16x16x32_fp8_fp8(pa_, t5_, Od[5], 0, 0, 0); \
                    Od[6] = __builtin_amdgcn_mfma_f32_16x16x32_fp8_fp8(pa_, t6_, Od[6], 0, 0, 0); Od[7] = __builtin_amdgcn_mfma_f32_16x16x32_fp8_fp8(pa_, t7_, Od[7], 0, 0, 0); } while (0)
                DSA_LOADV(va, 0);
#pragma unroll 1
                for (int ks = 0; ks < 8; ks += 2) {
                    DSA_LOADV(vb, ks + 1);
                    DSA_PVSTEP(va, ks);
                    if (ks + 2 < 8) DSA_LOADV(va, ks + 2);
                    DSA_PVSTEP(vb, ks + 1);
                }
                if (g == 0) {
#pragma unroll
                    for (int c = 0; c < 8; ++c)
#pragma unroll
                        for (int i = 0; i < 4; ++i) Pb[i * 128 + c * 16 + r] = Od[c][i] * (1.0f / (P8_SCALE * V8_SCALE));
                }
                asm volatile("s_waitcnt lgkmcnt(0)" ::: "memory");
                { const int kq = lane >> 4, c16 = lane & 15;
                  const f32x4 o0 = *(const LAS f32x4*)(Pb + kq * 128 + 8 * c16), o1 = *(const LAS f32x4*)(Pb + kq * 128 + 8 * c16 + 4);
                  u32x4 w; w.x = pk2(o0[0], o0[1]); w.y = pk2(o0[2], o0[3]); w.z = pk2(o1[0], o1[1]); w.w = pk2(o1[2], o1[3]);
                  *(GAS u32x4*)(O + qrow * 1024 + (kvh * 4 + kq) * 128 + 8 * c16) = w; }
            }
#endif
            asm volatile("s_waitcnt lgkmcnt(0)" ::: "memory");
            asm volatile("s_waitcnt lgkmcnt(0)" ::: "memory");
        }
    }
}

__device__ __forceinline__ float softplus_f(float z) { return fmaxf(z, 0.f) + __logf(1.0f + __expf(-fabsf(z))); }
__device__ __forceinline__ void phase_stick(const Frame& F) {
    GAS unsigned char* ws = F.ws;
    const GAS bf16_t* BQ = (const GAS bf16_t*)(ws + WS_Q); const GAS bf16_t* SKV = (const GAS bf16_t*)(ws + WS_SKV); const GAS bf16_t* VT = (const GAS bf16_t*)(ws + WS_VT); GAS bf16_t* O = (GAS bf16_t*)(ws + WS_O);
    const int lane = F.lane, r = lane & 15, g = lane >> 4;
    constexpr int NQT = TT / 16;
    constexpr int NH = 2;
    for (int it = F.gw; it < BATCH * (8 / NH) * NQT; it += F.NGW) {
        constexpr int NMAIN = BATCH * (8 / NH) * (NQT - 1);
        const int qt = (it < NMAIN) ? (it % (NQT - 1)) + 1 : 0, hb = (it < NMAIN) ? it / (NQT - 1) : it - NMAIN, head0 = (hb % (8 / NH)) * NH, b = hb / (8 / NH), kvh = head0 >> 2, t0 = qt * 16;
        const size_t rb = (size_t)b * TP;
        bf16x8 Bq[NH][4];
#pragma unroll
        for (int hh = 0; hh < NH; ++hh) { const GAS bf16_t* qp = BQ + (rb + t0 + r) * 1024 + (head0 + hh) * 128 + 8 * g;
#pragma unroll
          for (int ks = 0; ks < 4; ++ks) Bq[hh][ks] = *(const GAS bf16x8*)(qp + ks * 32); }
        f32x4 Oa[NH][8];
#pragma unroll
        for (int hh = 0; hh < NH; ++hh)
#pragma unroll
            for (int dt = 0; dt < 8; ++dt) Oa[hh][dt] = (f32x4){0.f, 0.f, 0.f, 0.f};
        float carry[NH];
#pragma unroll
        for (int hh = 0; hh < NH; ++hh) carry[hh] = 0.f;
        const int qpos = t0 + r;
        const GAS bf16_t* vtb = VT + ((size_t)(b * 2 + kvh) * 128) * TP;
        for (int kb = t0; kb >= 0; kb -= 32) {
            bf16x8 Kf[2][4];
#pragma unroll
            for (int tl = 0; tl < 2; ++tl) { int krow = kb - 16 * tl + r; krow = krow < 0 ? 0 : krow; const GAS bf16_t* kp = SKV + (rb + krow) * 512 + kvh * 128 + 8 * g;
#pragma unroll
                for (int ks = 0; ks < 4; ++ks) Kf[tl][ks] = *(const GAS bf16x8*)(kp + ks * 32); }
            bool done = true;
            bf16x8 Pbh[NH];
#pragma unroll
            for (int hh = 0; hh < NH; ++hh) {
                float a_hi[4], a_lo[4];
                float zz[2][4], sp[2][4], tot[2];
#pragma unroll
                for (int tl = 0; tl < 2; ++tl) {
                    const int kbase = kb - 16 * tl;
                    f32x4 z = (f32x4){0.f, 0.f, 0.f, 0.f};
#pragma unroll
                    for (int ks = 0; ks < 4; ++ks) z = MFMA16(Kf[tl][ks], Bq[hh][ks], z);
                    float gsum = 0.f;
#pragma unroll
                    for (int i = 0; i < 4; ++i) { const int key = kbase + 4 * g + i; const bool valid = (key >= 0) && (key < qpos);
                        const float zv = z[i] * 0.08838834764831845f; zz[tl][i] = zv; const float s_ = valid ? softplus_f(zv) : 0.f; sp[tl][i] = s_; gsum += s_; }
                    const float g0 = __shfl(gsum, r), g1 = __shfl(gsum, r + 16), g2 = __shfl(gsum, r + 32), g3 = __shfl(gsum, r + 48);
                    tot[tl] = (g0 + g1) + (g2 + g3);
                    float above = (g < 3 ? g3 : 0.f) + (g < 2 ? g2 : 0.f) + (g < 1 ? g1 : 0.f);
                    float c3 = above + sp[tl][3], c2 = c3 + sp[tl][2], c1 = c2 + sp[tl][1], c0 = c1 + sp[tl][0];
                    sp[tl][3] = c3; sp[tl][2] = c2; sp[tl][1] = c1; sp[tl][0] = c0;
                }
#pragma unroll
                for (int i = 0; i < 4; ++i) {
                    const int khi = kb + 4 * g + i, klo = kb - 16 + 4 * g + i;
                    a_hi[i] = (khi < qpos) ? __expf(zz[0][i] - (carry[hh] + sp[0][i])) : 0.f;
                    a_lo[i] = (klo >= 0 && klo < qpos) ? __expf(zz[1][i] - (carry[hh] + tot[0] + sp[1][i])) : 0.f;
                }
                carry[hh] += tot[0] + tot[1];
                { const unsigned w0 = pk2(a_hi[0], a_hi[1]), w1 = pk2(a_hi[2], a_hi[3]), w2 = pk2(a_lo[0], a_lo[1]), w3 = pk2(a_lo[2], a_lo[3]);
                  const u32x4 w = (u32x4){w0, w1, w2, w3}; Pbh[hh] = __builtin_bit_cast(bf16x8, w); }
                done = done && (carry[hh] > 104.0f);
            }
            const int tlo = (kb - 16) < 0 ? kb : (kb - 16);
#pragma unroll
            for (int dh = 0; dh < 8; dh += 4) {
                bf16x8 Vf[4];
#pragma unroll
                for (int d4 = 0; d4 < 4; ++d4) { const GAS bf16_t* vp = vtb + (size_t)((dh + d4) * 16 + r) * TP;
                    const u32x2 vh = *(const GAS u32x2*)(vp + kb + 4 * g), vl = *(const GAS u32x2*)(vp + tlo + 4 * g);
                    const u32x4 w = (u32x4){vh.x, vh.y, vl.x, vl.y}; Vf[d4] = __builtin_bit_cast(bf16x8, w); }
#pragma unroll
                for (int hh = 0; hh < NH; ++hh)
#pragma unroll
                    for (int d4 = 0; d4 < 4; ++d4) Oa[hh][dh + d4] = MFMA16(Vf[d4], Pbh[hh], Oa[hh][dh + d4]);
            }
            if (__all(done)) break;
        }
#pragma unroll
        for (int hh = 0; hh < NH; ++hh) {
            GAS bf16_t* op = O + (rb + t0 + r) * 1024 + (head0 + hh) * 128 + 4 * g;
#pragma unroll
            for (int dt = 0; dt < 8; ++dt) { u32x2 w; w.x = pk2(Oa[hh][dt][0], Oa[hh][dt][1]); w.y = pk2(Oa[hh][dt][2], Oa[hh][dt][3]); *(GAS u32x2*)(op + dt * 16) = w; }
        }
    }
}
constexpr int SCPH = 130;
constexpr int SKP = 272;
constexpr int PE_SC = 0, PE_TOP = 256 * SCPH * 2  , PE_SK = PE_TOP + 16384, PE_END = PE_SK + 2 * 128 * SKP;
__device__ __forceinline__ float gelu_erf(float v) { return 0.5f * v * (1.0f + erff(v * 0.70710678118654752f)); }
__device__ __forceinline__ void phase_peer_route(const Frame& F, int layer) {
    GAS unsigned char* ws = F.ws;
    const GAS bf16_t* PQ = (const GAS bf16_t*)(ws + WS_PROJ); const GAS bf16_t* SK = (const GAS bf16_t*)(ws + WS_SK) + (size_t)layer * 2 * 128 * 128;
    LAS _Float16* SCP = (LAS _Float16*)(F.lds + PE_SC); LAS unsigned* TOPL = (LAS unsigned*)(F.lds + PE_TOP); LAS unsigned char* SKL = F.lds + PE_SK;
    static_assert(PE_END <= MISC_OFF, "PEER routing LDS");
    for (int i = F.tid; i < 2 * 128 * 16; i += NT) { const int rw = i >> 4, ch = i & 15; *(LAS u32x4*)(SKL + rw * SKP + ch * 16) = *(const GAS u32x4*)(SK + (size_t)rw * 128 + ch * 8); }
    __syncthreads();
    GAS bf16_t* RIDG = (GAS bf16_t*)(ws + WS_RID); GAS bf16_t* RIDT = (GAS bf16_t*)(ws + WS_RIDT); GAS float* RGG = (GAS float*)(ws + WS_RG);
    const int lane = F.lane, wave = F.wave, tid = F.tid, r = lane & 15, g = lane >> 4;
    constexpr int NIT = BATCH * (TT / 16);
    for (int it = blockIdx.x; it < NIT; it += F.G) {
        const int b = it / (TT / 16), tb = it - b * (TT / 16);
        const size_t row0 = (size_t)b * TP + tb * 16;
#ifndef PROBE_ROUTE
#define PROBE_ROUTE 0
#endif
        for (int rp = 0; rp < ((PROBE_ROUTE & 1) ? 2 : 1); ++rp) {
            const int h = wave;
#pragma unroll 1
            for (int c = 0; c < 2; ++c) {
                bf16x8 A[4];
                const GAS bf16_t* ap = PQ + (row0 + r) * 2048 + h * 256 + c * 128 + 8 * g;
#pragma unroll
                for (int ks = 0; ks < 4; ++ks) A[ks] = *(const GAS bf16x8*)(ap + ks * 32);
#pragma unroll
                for (int kt = 0; kt < 8; ++kt) {
                    const LAS unsigned char* bp = SKL + (c * 128 + kt * 16 + r) * SKP + 16 * g;
                    f32x4 d = (f32x4){0.f, 0.f, 0.f, 0.f};
#pragma unroll
                    for (int ks = 0; ks < 4; ++ks) d = MFMA16(A[ks], *(const LAS bf16x8*)(bp + ks * 64), d);
#pragma unroll
                    for (int i = 0; i < 4; ++i) SCP[((4 * g + i) * 16 + h * 2 + c) * SCPH + kt * 16 + r] = (_Float16)d[i];
                }
            }
        }
        __syncthreads();
        for (int rp = 0; rp < ((PROBE_ROUTE & 2) ? 2 : 1); ++rp) {
            if (rp) __syncthreads();
            const int list = tid >> 1, half = tid & 1;
            const LAS _Float16* lp = SCP + list * SCPH + 64 * half;
            unsigned a[16];
#pragma unroll
            for (int i = 0; i < 16; ++i) a[i] = 0u;
#pragma unroll 4
            for (int k = 0; k < 64; ++k) {
                const unsigned x = (mono_key((float)lp[k]) & ~127u) | (unsigned)(127 - (64 * half + k));
#pragma unroll
                for (int i = 15; i >= 1; --i) a[i] = med3u(a[i - 1], a[i], x);
                a[0] = a[0] > x ? a[0] : x;
            }
            if (half) {
#pragma unroll
                for (int i = 0; i < 16; ++i) TOPL[list * 16 + i] = a[i];
            }
            __syncthreads();
            if (!half) {
#pragma unroll 4
                for (int k = 0; k < 16; ++k) {
                    const unsigned x = TOPL[list * 16 + k];
#pragma unroll
                    for (int i = 15; i >= 1; --i) a[i] = med3u(a[i - 1], a[i], x);
                    a[0] = a[0] > x ? a[0] : x;
                }
            }
            __syncthreads();
            if (!half) {
#pragma unroll
                for (int i = 0; i < 16; ++i) TOPL[list * 16 + i] = a[i];
            }
        }
        __syncthreads();
        for (int rp = 0; rp < ((PROBE_ROUTE & 4) ? 2 : 1); ++rp)
        if (tid < 128) {
            const int token = tid >> 3, h = tid & 7;
            const LAS unsigned* L1 = TOPL + (token * 16 + h * 2) * 16; const LAS unsigned* L2 = L1 + 16;
            float v1[16], v2[16];
#pragma unroll
            for (int i = 0; i < 16; ++i) { v1[i] = unmono_key(L1[i] & ~127u); v2[i] = unmono_key(L2[i] & ~127u); }
            unsigned cc[16];
#pragma unroll
            for (int i = 0; i < 16; ++i) cc[i] = 0u;
#pragma unroll
            for (int ia = 0; ia < 16; ++ia)
#pragma unroll
                for (int ib = 0; ib < 16; ++ib) if ((ia + 1) * (ib + 1) <= 16) {
                    const unsigned x = (mono_key(v1[ia] + v2[ib]) & ~255u) | (unsigned)(255 - (ia * 16 + ib));
#pragma unroll
                    for (int i = 15; i >= 1; --i) cc[i] = med3u(cc[i - 1], cc[i], x);
                    cc[0] = cc[0] > x ? cc[0] : x;
                }
            const float bmax = unmono_key(cc[0] & ~255u);
            float e[16], esum = 0.f;
#pragma unroll
            for (int i = 0; i < 16; ++i) { e[i] = __expf(unmono_key(cc[i] & ~255u) - bmax); esum += e[i]; }
            const float inv = 1.0f / esum;
#pragma unroll
            for (int i = 0; i < 16; ++i) {
                const int flat = 255 - (int)(cc[i] & 255u), ia = flat >> 4, ib = flat & 15;
                const int i1 = 127 - (int)(L1[ia] & 127u), i2 = 127 - (int)(L2[ib] & 127u);
                RIDG[(row0 + token) * 128 + h * 16 + i] = (bf16_t)(i1 * 128 + i2); RIDT[(row0 + token) * 128 + i * 8 + h] = (bf16_t)(i1 * 128 + i2); RGG[(row0 + token) * 128 + h * 16 + i] = e[i] * inv;
            }
        }
        __syncthreads();
    }
}

constexpr int NTOK = BATCH * TT;
#define XCC_FRAME() volatile LAS unsigned* MISC_ = (volatile LAS unsigned*)(F.lds + MISC_OFF); \
    const int xp = (int)MISC_[4], nx = (int)MISC_[5], wrank = (int)MISC_[6] * NWAVES + F.wave, nw = (int)MISC_[7] * NWAVES
__device__ __forceinline__ unsigned id_of(const u32x4& a, const u32x4& b, int k) {
    const unsigned w = (k < 8) ? a[(k >> 1) & 3] : b[(k >> 1) & 3]; return (k & 1) ? (w >> 16) : (w & 0xffffu);
}
#define FP8X2(w, hi) __builtin_amdgcn_cvt_pk_f32_fp8((int)(w), hi)
__device__ __forceinline__ size_t tok_row(int tokn) { const int bsel = tokn / TT; return (size_t)bsel * TP + (tokn - bsel * TT); }
#define LDG16(base, off) (*(const GAS u32x4*)((const GAS unsigned char*)(base) + (unsigned)(off)))
__device__ __forceinline__ void phase_peer_u(const Frame& F, int layer) {
    GAS unsigned char* ws = F.ws;
    const GAS unsigned char* HBb = ws + WS_HB; const GAS unsigned char* RIDb = ws + WS_RID;
    const int lane = F.lane, j = lane >> 3, c = lane & 7;
    LAS unsigned char* MET = F.lds + 16384 + F.wave * 1024;
    XCC_FRAME();
#pragma unroll 1
    for (int s = xp; s < 8; s += nx) {
        const GAS unsigned char* Us = ws + WS_U + ((size_t)layer * 8 + s) * NEXP * 128;
        GAS unsigned char* Ps = ws + WS_PART + (size_t)s * NR * 128 * 4;
        const unsigned uo = 16u * c;
#define PU_FETCH(tk) do { const int tk_ = (tk) < NTOK ? (tk) : NTOK - 1; const unsigned r_ = (unsigned)tok_row(tk_); \
        pid = *(const GAS unsigned*)(RIDb + (r_ * 256u + 4u * lane)); px = *(const GAS unsigned*)(HBb + (r_ * 2048u + 256u * s + 4u * lane)); } while (0)
#define PU_STAGE(slot) do { *(LAS unsigned*)(MET + (slot) * 512 + 4 * lane) = pid; *(LAS unsigned*)(MET + (slot) * 512 + 256 + 4 * lane) = px; } while (0)
#define PU_GATHER(buf, slot) do { const u32x4 ia_ = *(const LAS u32x4*)(MET + (slot) * 512 + 32 * j), ib_ = *(const LAS u32x4*)(MET + (slot) * 512 + 32 * j + 16); \
        _Pragma("unroll") for (int b_ = 0; b_ < 16; ++b_) buf[b_] = LDG16(Us, id_of(ia_, ib_, b_) * 128u + uo); } while (0)
#define PU_STEP(cur, nxt) do { const unsigned row = (unsigned)tok_row(tokn); const int sl = it & 1; \
        PU_STAGE(sl ^ 1); PU_GATHER(nxt, sl ^ 1); PU_FETCH(tokn + 2 * nw); \
        const u32x4 xa = *(const LAS u32x4*)(MET + sl * 512 + 256 + 32 * c), xb = *(const LAS u32x4*)(MET + sl * 512 + 256 + 32 * c + 16); \
        __builtin_amdgcn_sched_barrier(0); \
        f32x2 xf[8]; \
        _Pragma("unroll") for (int k = 0; k < 4; ++k) { xf[k] = (f32x2){bflo(xa[k]), bfhi(xa[k])}; xf[4 + k] = (f32x2){bflo(xb[k]), bfhi(xb[k])}; } \
        float p[16]; \
        _Pragma("unroll") for (int b = 0; b < 16; ++b) { \
            unsigned w0 = cur[b].x, w1 = cur[b].y, w2 = cur[b].z, w3 = cur[b].w; \
            f32x2 t2 = FP8X2(w0, false) * xf[0], t3 = FP8X2(w0, true) * xf[1]; \
            t2 += FP8X2(w1, false) * xf[2]; t3 += FP8X2(w1, true) * xf[3]; \
            t2 += FP8X2(w2, false) * xf[4]; t3 += FP8X2(w2, true) * xf[5]; t2 += FP8X2(w3, false) * xf[6]; t3 += FP8X2(w3, true) * xf[7]; \
            t2 += t3; \
            float t = t2.x + t2.y; \
            if (b < 14 && (b & 1)) asm volatile("" : "+v"(cur[b + 1].x), "+v"(cur[b + 1].y), "+v"(cur[b + 1].z), "+v"(cur[b + 1].w), "+v"(cur[b + 2].x), "+v"(cur[b + 2].y), "+v"(cur[b + 2].z), "+v"(cur[b + 2].w) : "v"(t)); \
            p[b] = t; } \
        float q[8], r4[4], t2[2]; \
        { const bool hi = (c & 4) != 0; \
          _Pragma("unroll") for (int i = 0; i < 8; ++i) q[i] = (hi ? p[8 + i] : p[i]) + __shfl_xor(hi ? p[i] : p[8 + i], 4); } \
        { const bool hi = (c & 2) != 0; \
          _Pragma("unroll") for (int i = 0; i < 4; ++i) r4[i] = (hi ? q[4 + i] : q[i]) + __shfl_xor(hi ? q[i] : q[4 + i], 2); } \
        { const bool hi = (c & 1) != 0; \
          _Pragma("unroll") for (int i = 0; i < 2; ++i) t2[i] = (hi ? r4[2 + i] : r4[i]) + __shfl_xor(hi ? r4[i] : r4[2 + i], 1); } \
        *(GAS f32x2*)(Ps + (row * 512u + 64u * j + 8u * c)) = (f32x2){t2[0], t2[1]}; \
        tokn += nw; ++it; } while (0)
        unsigned pid, px; int it = 0, tokn = wrank;
        u32x4 uA[16], uB[16];
        PU_FETCH(wrank); PU_STAGE(0); PU_GATHER(uA, 0); PU_FETCH(wrank + nw);
#pragma unroll 1
        while (tokn < NTOK) {
            PU_STEP(uA, uB);
            if (tokn >= NTOK) break;
            PU_STEP(uB, uA);
        }
    }
}
__device__ __forceinline__ void phase_peer_act(const Frame& F) {
    GAS unsigned char* ws = F.ws;
    const GAS float* PART = (const GAS float*)(ws + WS_PART); const GAS float* RGG = (const GAS float*)(ws + WS_RG); const GAS float* SS = (const GAS float*)(ws + WS_SS); GAS bf16_t* ACT = (GAS bf16_t*)(ws + WS_ACT);
    const size_t n4 = (size_t)NTOK * 32;
    for (size_t i = (size_t)blockIdx.x * NT + F.tid; i < n4; i += (size_t)F.G * NT) {
        const int tokn = (int)(i >> 5), q4 = (int)(i & 31); const int bsel = tokn / TT; const size_t row = (size_t)bsel * TP + (tokn - bsel * TT);
        const size_t o = row * 128 + 4 * q4;
        f32x4 acc = *(const GAS f32x4*)(PART + o);
#pragma unroll
        for (int s = 1; s < 8; ++s) acc += *(const GAS f32x4*)(PART + (size_t)s * NR * 128 + o);
        const float ri = row_rinv(SS, (int)row) * (1.0f / U_SCALE); const f32x4 gt = *(const GAS f32x4*)(RGG + o) * (1.0f / V_SCALE);
        *(GAS u32x2*)(ACT + o) = (u32x2){pk2(gelu_erf(acc[0] * ri) * gt[0], gelu_erf(acc[1] * ri) * gt[1]), pk2(gelu_erf(acc[2] * ri) * gt[2], gelu_erf(acc[3] * ri) * gt[3])};
    }
}
__device__ __forceinline__ void phase_peer_v(const Frame& F, int layer, float* dout, size_t dry_off = 0) {
    GAS unsigned char* ws = F.ws;
    const GAS unsigned char* RIDb = ws + WS_RID; const GAS unsigned char* ACTb = ws + WS_ACT;
    GAS unsigned char* Hb = ws + WS_H + dry_off; GAS unsigned char* HBb = ws + WS_HB + dry_off; GAS float* SS = (GAS float*)(ws + WS_SS + dry_off);
    const int lane = F.lane, j = lane >> 3, c = lane & 7;
    LAS unsigned char* MET = F.lds + F.wave * 1024;
    XCC_FRAME();
#pragma unroll 1
    for (int s = xp; s < 8; s += nx) {
        const GAS unsigned char* Vs = ws + WS_V + ((size_t)layer * 8 + s) * NEXP * 128;
        const unsigned vo = 16u * c;
#define PV_FETCH(tk) do { const int tk_ = (tk) < NTOK ? (tk) : NTOK - 1; const unsigned r_ = (unsigned)tok_row(tk_); \
        pid = *(const GAS unsigned*)(RIDb + (r_ * 256u + 4u * lane)); pact = *(const GAS unsigned*)(ACTb + (r_ * 256u + 4u * lane)); } while (0)
#define PV_STAGE(slot) do { *(LAS unsigned*)(MET + (slot) * 512 + 4 * lane) = pid; *(LAS unsigned*)(MET + (slot) * 512 + 256 + 4 * lane) = pact; } while (0)
        unsigned pid, pact; int it = 0;
        PV_FETCH(wrank); PV_STAGE(0); PV_FETCH(wrank + nw);
#pragma unroll 1
        for (int tokn = wrank; tokn < NTOK; tokn += nw, ++it) {
            const int bsel = tokn / TT, tsel = tokn - bsel * TT; const unsigned row = (unsigned)(bsel * TP + tsel);
            const int sl = it & 1;
            PV_STAGE(sl ^ 1);
            const u32x4 ia = *(const LAS u32x4*)(MET + sl * 512 + 32 * j), ib = *(const LAS u32x4*)(MET + sl * 512 + 32 * j + 16);
            u32x4 v[16];
#pragma unroll
            for (int b = 0; b < 16; ++b) v[b] = LDG16(Vs, id_of(ia, ib, b) * 128u + vo);
            PV_FETCH(tokn + 2 * nw);
            const unsigned col = 128u * s + 16u * c + 2u * j;
            const f32x2 hold = *(const GAS f32x2*)(Hb + (row * 4096u + col * 4u));
            __builtin_amdgcn_sched_barrier(0);
            const u32x4 av0 = *(const LAS u32x4*)(MET + sl * 512 + 256 + 32 * j), av1 = *(const LAS u32x4*)(MET + sl * 512 + 256 + 32 * j + 16);
            float acc[16];
#pragma unroll
            for (int i = 0; i < 16; ++i) acc[i] = 0.f;
#pragma unroll
            for (int b = 0; b < 16; ++b) { const unsigned aw_ = (b < 8) ? av0[(b >> 1) & 3] : av1[(b >> 1) & 3]; const float a_ = (b & 1) ? bfhi(aw_) : bflo(aw_);
#pragma unroll
                for (int k = 0; k < 4; ++k) { const f32x2 lo = FP8X2(v[b][k], false), hi = FP8X2(v[b][k], true);
                    acc[4 * k] += a_ * lo.x; acc[4 * k + 1] += a_ * lo.y; acc[4 * k + 2] += a_ * hi.x; acc[4 * k + 3] += a_ * hi.y; }
                if (b < 14 && (b & 1)) asm volatile("" : "+v"(v[b + 1].x), "+v"(v[b + 1].y), "+v"(v[b + 1].z), "+v"(v[b + 1].w), "+v"(v[b + 2].x), "+v"(v[b + 2].y), "+v"(v[b + 2].z), "+v"(v[b + 2].w) : "v"(acc[0])); }
            float q[8], r4[4], o2[2];
            { const bool hi = (lane & 32) != 0;
#pragma unroll
              for (int i = 0; i < 8; ++i) q[i] = (hi ? acc[8 + i] : acc[i]) + __shfl_xor(hi ? acc[i] : acc[8 + i], 32); }
            { const bool hi = (lane & 16) != 0;
#pragma unroll
              for (int i = 0; i < 4; ++i) r4[i] = (hi ? q[4 + i] : q[i]) + __shfl_xor(hi ? q[i] : q[4 + i], 16); }
            { const bool hi = (lane & 8) != 0;
#pragma unroll
              for (int i = 0; i < 2; ++i) o2[i] = (hi ? r4[2 + i] : r4[i]) + __shfl_xor(hi ? r4[i] : r4[2 + i], 8); }
            f32x2 hv = hold; hv.x += o2[0]; hv.y += o2[1];
            *(GAS f32x2*)(Hb + (row * 4096u + col * 4u)) = hv; *(GAS unsigned*)(HBb + (row * 2048u + col * 2u)) = pk2(hv.x, hv.y);
            const float sq = wave_sum(hv.x * hv.x + hv.y * hv.y);
            if (lane == 0) { SS[(size_t)row * 16 + s] = sq; SS[(size_t)row * 16 + 8 + s] = 0.f; }
            if (dout && tsel >= NMETA) *(f32x2*)(dout + ((size_t)bsel * SEQ + (tsel - NMETA)) * 1024 + col) = hv;
        }
    }
}

#define PHASE_FRAME() Frame F; { unsigned long long ws_ = wsu; asm volatile("" : "+s"(ws_)); int tid_ = threadIdx.x; asm volatile("" : "+v"(tid_)); \
    F.lds = (LAS unsigned char*)lds; F.ws = (GAS unsigned char*)ws_; F.tid = tid_; F.lane = tid_ & 63; F.wave = __builtin_amdgcn_readfirstlane(tid_ >> 6); F.G = gridDim.x; F.gw = blockIdx.x * NWAVES + F.wave; F.NGW = F.G * NWAVES; } \
    GAS unsigned char* ws = F.ws; (void)ws
__global__ void __launch_bounds__(NT, 2) mk_fwd(Args a) {
    extern __shared__ __attribute__((aligned(16))) unsigned char lds[];
    unsigned long long wsu = (unsigned long long)a.ws; asm volatile("" : "+s"(wsu));
    unsigned long long outu = (unsigned long long)a.out; asm volatile("" : "+s"(outu));
    volatile LAS unsigned* MISC = (volatile LAS unsigned*)((LAS unsigned char*)lds + MISC_OFF);
    if (threadIdx.x < 16) MISC[threadIdx.x] = 0u;
    __syncthreads();
    XcdBarrier bar = xcd_barrier_post((unsigned*)((unsigned char*)wsu + WS_CTL), MISC);
    if (threadIdx.x == 0) MISC[6] = xb_add((unsigned*)((unsigned char*)wsu + WS_CTL + CTL_XRANK) + 64 * bar.x, 1u);
    PG8_LAS unsigned char* glds = (PG8_LAS unsigned char*)lds;

#ifndef PROBE_DUP
#define PROBE_DUP 0
#endif
    constexpr size_t DRY_OFF = WS_END - WS_H;
    { PHASE_FRAME(); phase_prologue(F, a); }
    xcd_barrier(bar);
    if (threadIdx.x == 0) {
        unsigned nx = 0, xp = 0, xn = 1;
        for (unsigned j = 0; j < 16; ++j) { const unsigned c = xb_ld((unsigned*)((unsigned char*)wsu + WS_CTL + CTL_XRANK) + 64 * j); if (j == bar.x) { xp = nx; xn = c ? c : 1u; } nx += (c > 0u) ? 1u : 0u; }
        MISC[4] = xp; MISC[5] = nx ? nx : 1u; MISC[7] = xn;
    }
    __syncthreads();
    if (PROBE_DUP & 1) { { PHASE_FRAME(); phase_prologue(F, a); } xcd_barrier(bar); }
#pragma unroll 1
    for (int layer = 0; layer < 4; ++layer) {
        for (int rep = 0; rep < ((PROBE_DUP & 2) ? 2 : 1); ++rep) {
            PHASE_FRAME();
            const GAS bf16_t* Bt; int N; EpiScale E;
            E.ss = (const GAS float*)(ws + WS_SS); E.vT = nullptr;
            if (layer < 2) { Bt = (const GAS bf16_t*)(ws + WS_WIN) + (size_t)layer * 2048 * 1024; N = 2048; E.O0 = (GAS bf16_t*)(ws + WS_PROJ); E.ld0 = 2048; E.split = 2048; E.O1 = E.O0; E.ld1 = 2048; }
            else if (layer == 2) { Bt = (const GAS bf16_t*)(ws + WS_WKVQ); N = 1536; E.O0 = (GAS bf16_t*)(ws + WS_SKV); E.ld0 = 512; E.split = 512; E.O1 = (GAS bf16_t*)(ws + WS_Q); E.ld1 = 1024; E.vT = (GAS bf16_t*)(ws + WS_VT); }
            else { Bt = (const GAS bf16_t*)(ws + WS_WBQ1); N = 1024; E.O0 = (GAS bf16_t*)(ws + WS_Q); E.ld0 = 1024; E.split = 1024; E.O1 = E.O0; E.ld1 = 1024; }
            pg8::Gemm gm{(const bf16_t*)(ws + WS_HB), (const bf16_t*)Bt, BATCH * SEQ, N, 1024}; pg8::StaticOrder S; S.init(BATCH * SEQ, N, F.G, (int)blockIdx.x);
            { LAS float* RINV = (LAS float*)(F.lds + 131072); LAS int* PML = (LAS int*)(F.lds + 131072 + 4096);
              _Pragma("unroll") for (int q = 0; q < 4; ++q) { const int pmq = unit_pm_of(S, q); if (F.tid == 0) PML[q] = pmq;
                  if (pmq >= 0 && F.tid < 256) RINV[q * 256 + F.tid] = row_rinv((const GAS float*)(ws + WS_SS), pg8::tile_row(pmq) + F.tid); }
              __syncthreads(); E.rinv_lds = RINV; E.pm_lds = PML; }
            pg8::gemm_phase<EpiScale, pg8::StaticOrder>(glds, gm, S, E);
            gemm_tail<EpiScale>((const GAS bf16_t*)(ws + WS_HB), Bt, N, E, F.gw, F.NGW, F.lane, F.lds);
            if (rep == 0 && (PROBE_DUP & 2)) xcd_barrier(bar);
        }
        xcd_barrier(bar);
        if (layer < 2) {
            for (int rep = 0; rep < ((PROBE_DUP & 4) ? 2 : 1); ++rep) {
            { PHASE_FRAME(); phase_a_post(F, a.in[4] + layer * 128, a.in[5] + layer * 128); }
            xcd_barrier(bar);
            for (int rep2 = 0; rep2 < ((PROBE_DUP & 512) ? 2 : 1); ++rep2) { { PHASE_FRAME(); phase_dsa_sel(F); } xcd_barrier(bar); }
            for (int rep2 = 0; rep2 < ((PROBE_DUP & 1024) ? 2 : 1); ++rep2) { { PHASE_FRAME(); phase_dsa_attn(F); } if (rep2 == 0 && (PROBE_DUP & 1024)) xcd_barrier(bar); }
            if (rep == 0 && (PROBE_DUP & 4)) xcd_barrier(bar);
            }
        } else {
            for (int rep = 0; rep < ((PROBE_DUP & 8) ? 2 : 1); ++rep) {
            PHASE_FRAME(); phase_stick(F);
            if (rep == 0 && (PROBE_DUP & 8)) xcd_barrier(bar);
            }
        }
        xcd_barrier(bar);
        for (int rep = ((PROBE_DUP & 16) ? 1 : 0); rep >= 0; --rep) {
            PHASE_FRAME();
            const GAS bf16_t* Bt = (layer < 2) ? (const GAS bf16_t*)(ws + WS_WOA) + (size_t)layer * 1024 * 1024 : (const GAS bf16_t*)(ws + WS_WOB) + (size_t)(layer - 2) * 1024 * 1024;
            EpiResid E; E.H = (GAS float*)(ws + WS_H + (rep ? DRY_OFF : 0)); E.HB = (GAS bf16_t*)(ws + WS_HB + (rep ? DRY_OFF : 0)); E.ss = (GAS float*)(ws + WS_SS + (rep ? DRY_OFF : 0)); E.HB8 = ws + WS_HB8;
            pg8::Gemm gm{(const bf16_t*)(ws + WS_O), (const bf16_t*)Bt, BATCH * SEQ, 1024, 1024}; pg8::StaticOrder S; S.init(BATCH * SEQ, 1024, F.G, (int)blockIdx.x);
            pg8::gemm_phase<EpiResid, pg8::StaticOrder>(glds, gm, S, E);
            gemm_tail<EpiResid>((const GAS bf16_t*)(ws + WS_O), Bt, 1024, E, F.gw, F.NGW, F.lane, F.lds);
            if (rep) xcd_barrier(bar);
        }
        xcd_barrier(bar);
        for (int rep = 0; rep < ((PROBE_DUP & 32) ? 2 : 1); ++rep) {
            PHASE_FRAME();
            EpiScale E; E.ss = (const GAS float*)(ws + WS_SS); E.vT = nullptr; E.O0 = (GAS bf16_t*)(ws + WS_PROJ); E.ld0 = 2048; E.split = 2048; E.O1 = E.O0; E.ld1 = 2048;
            pg8::Gemm gm{(const bf16_t*)(ws + WS_HB), (const bf16_t*)((const GAS bf16_t*)(ws + WS_WPQ) + (size_t)layer * 2048 * 1024), BATCH * SEQ, 2048, 1024}; pg8::StaticOrder S; S.init(BATCH * SEQ, 2048, F.G, (int)blockIdx.x);
            { LAS float* RINV = (LAS float*)(F.lds + 131072); LAS int* PML = (LAS int*)(F.lds + 131072 + 4096);
              _Pragma("unroll") for (int q = 0; q < 4; ++q) { const int pmq = unit_pm_of(S, q); if (F.tid == 0) PML[q] = pmq;
                  if (pmq >= 0 && F.tid < 256) RINV[q * 256 + F.tid] = row_rinv((const GAS float*)(ws + WS_SS), pg8::tile_row(pmq) + F.tid); }
              __syncthreads(); E.rinv_lds = RINV; E.pm_lds = PML; }
            pg8::gemm_phase<EpiScale, pg8::StaticOrder>(glds, gm, S, E);
            gemm_tail<EpiScale>((const GAS bf16_t*)(ws + WS_HB), (const GAS bf16_t*)(ws + WS_WPQ) + (size_t)layer * 2048 * 1024, 2048, E, F.gw, F.NGW, F.lane, F.lds);
            if (rep == 0 && (PROBE_DUP & 32)) xcd_barrier(bar);
        }
        xcd_barrier(bar);
        for (int rep = 0; rep < ((PROBE_DUP & 64) ? 2 : 1); ++rep) { { PHASE_FRAME(); phase_peer_route(F, layer); } xcd_barrier(bar); }
        for (int rep = 0; rep < ((PROBE_DUP & 128) ? 2 : 1); ++rep) { { PHASE_FRAME(); phase_peer_u(F, layer); } xcd_barrier(bar); }
        for (int rep = 0; rep < ((PROBE_DUP & 2048) ? 2 : 1); ++rep) { { PHASE_FRAME(); phase_peer_act(F); } xcd_barrier(bar); }
        if (PROBE_DUP & 4096) { { PHASE_FRAME(); phase_peer_v(F, layer, nullptr, DRY_OFF); } xcd_barrier(bar); }
        { PHASE_FRAME(); unsigned long long o_ = outu; asm volatile("" : "+s"(o_));
          phase_peer_v(F, layer, layer == 3 ? (float*)o_ : nullptr); }
        xcd_barrier(bar);
        if (PROBE_DUP & 256) { for (int rep = 0; rep < 8; ++rep) xcd_barrier(bar); }
    }
}

extern "C" void kernel_launch(void* const* d_in, const int* in_sizes, int n_in, void* d_out, int out_size, void* d_ws, size_t ws_size, hipStream_t stream) {
    static int grid = 0;
    if (grid == 0) {
        if (n_in != 17 || out_size != BATCH * SEQ * DM || ws_size < WS_END + (WS_PROJ - WS_H)) { fprintf(stderr, "kernel_launch: unexpected shapes (n_in %d out %d ws %zu need %zu)\n", n_in, out_size, ws_size, (size_t)WS_END); grid = -1; return; }
        int dev = 0, cus = 0, per_cu = 0;
        if (hipGetDevice(&dev) != hipSuccess || hipDeviceGetAttribute(&cus, hipDeviceAttributeMultiprocessorCount, dev) != hipSuccess) { grid = -1; return; }
        if (hipFuncSetAttribute((const void*)mk_fwd, hipFuncAttributeMaxDynamicSharedMemorySize, LDS_BYTES) != hipSuccess) { fprintf(stderr, "kernel_launch: hipFuncSetAttribute failed\n"); grid = -1; return; }
        if (hipOccupancyMaxActiveBlocksPerMultiprocessor(&per_cu, (const void*)mk_fwd, NT, LDS_BYTES) != hipSuccess || per_cu < 1) fprintf(stderr, "kernel_launch: occupancy query says %d blocks/CU\n", per_cu);
        (void)hipGetLastError();
        grid = cus;
    }
    if (grid < 0) return;
    if (hipMemsetAsync((char*)d_ws + WS_CTL, 0, 65536, stream) != hipSuccess) return;
    Args a{};
    for (int i = 0; i < 17; ++i) a.in[i] = (const float*)d_in[i];
    a.out = (float*)d_out; a.ws = (unsigned char*)d_ws;
    for (int i = 0; i < 16; ++i) a.inv32[i] = pow(500000.0, -(double)(2 * i) / 32.0);
    for (int i = 0; i < 8; ++i) a.inv16[i] = pow(500000.0, -(double)(2 * i) / 16.0);
    hipLaunchKernelGGL(mk_fwd, dim3(grid), dim3(NT), LDS_BYTES, stream, a);
}
```

```cpp
#include <hip/hip_runtime.h>
#include <cstdio>
#include <cmath>
#define LAS __attribute__((address_space(3)))
#define GAS __attribute__((address_space(1)))
typedef unsigned short bf16_t;
typedef short bf16x8 __attribute__((ext_vector_type(8)));
typedef short s16x4 __attribute__((ext_vector_type(4)));
typedef float f32x4 __attribute__((ext_vector_type(4)));
typedef float f32x2 __attribute__((ext_vector_type(2)));
typedef unsigned u32x4 __attribute__((ext_vector_type(4)));
typedef unsigned u32x2 __attribute__((ext_vector_type(2)));
typedef __bf16 bf16x2_t __attribute__((ext_vector_type(2)));
constexpr float U_SCALE = 1024.0f, V_SCALE = 256.0f, X_SCALE = 16.0f, Q_SCALE = 128.0f, K_SCALE = 16.0f, V8_SCALE = 16.0f, P8_SCALE = 256.0f, ACT_SCALE = 64.0f;

constexpr int BATCH = 4, SEQ = 4096, DM = 1024, NMETA = 16, TT = SEQ + NMETA  , TP = 4224, NR = BATCH * TP  ;
constexpr int HD = 128, TOPK = 256;
constexpr int ACOLS = 1860, ACOLS_P = 2048;
constexpr int NEXP = 16384;
constexpr float RMS_EPS = 1e-6f;
constexpr int NT = 512, NWAVES = 8;
constexpr int LDS_BYTES = 160 * 1024;
constexpr int MISC_OFF = LDS_BYTES - 64;
constexpr size_t CTL_XRANK = 16384;

constexpr size_t al256(size_t x) { return (x + 255) & ~(size_t)255; }
constexpr size_t WS_CTL   = 0;
constexpr size_t WS_WIN   = 65536;
constexpr size_t WS_WOA   = WS_WIN  + (size_t)2 * 2048 * 1024 * 2;
constexpr size_t WS_WKVQ  = WS_WOA  + (size_t)2 * 1024 * 1024 * 2;
constexpr size_t WS_WBQ1  = WS_WKVQ + (size_t)1536 * 1024 * 2;
constexpr size_t WS_WOB   = WS_WBQ1 + (size_t)1024 * 1024 * 2;
constexpr size_t WS_WPQ   = WS_WOB  + (size_t)2 * 1024 * 1024 * 2;
constexpr size_t WS_SK    = WS_WPQ  + (size_t)4 * 2048 * 1024 * 2;
constexpr size_t WS_ROPE32= WS_SK   + (size_t)4 * 2 * 128 * 128 * 2;
constexpr size_t WS_ROPE16= WS_ROPE32 + (size_t)TP * 16 * 8;
constexpr size_t WS_U     = al256(WS_ROPE16 + (size_t)TP * 8 * 8);
constexpr size_t WS_V     = WS_U    + (size_t)4 * NEXP * 1024 * 2;
constexpr size_t WS_H     = WS_V    + (size_t)4 * NEXP * 1024 * 2;
constexpr size_t WS_HB    = WS_H    + (size_t)NR * 1024 * 4;
constexpr size_t WS_SS    = WS_HB   + (size_t)NR * 1024 * 2;
constexpr size_t WS_PROJ  = WS_SS   + (size_t)NR * 16 * 4;
constexpr size_t WS_Q     = WS_PROJ + (size_t)NR * 2048 * 2;
constexpr size_t WS_KVA   = WS_Q    + (size_t)NR * 1024 * 2;
constexpr size_t WS_QI    = WS_KVA  + (size_t)NR * 512 * 2;
constexpr size_t WS_KI    = WS_QI   + (size_t)NR * 256 * 2;
constexpr size_t WS_WI    = WS_KI   + (size_t)NR * 64 * 2;
constexpr size_t WS_O     = WS_WI   + (size_t)NR * 4 * 4;
constexpr size_t WS_SKV   = WS_O    + (size_t)NR * 1024 * 2;
constexpr size_t WS_VT    = WS_SKV  + (size_t)NR * 512 * 2;
constexpr size_t WS_RID   = WS_VT   + (size_t)BATCH * 2 * 128 * TP * 2;
constexpr size_t WS_RG    = WS_RID  + (size_t)NR * 128 * 4;
constexpr size_t WS_SELG  = WS_RG   + (size_t)NR * 128 * 4;
constexpr size_t WS_ACT   = WS_SELG + (size_t)NR * 256 * 2;
constexpr size_t WS_PART  = WS_ACT  + (size_t)NR * 128 * 4;
constexpr size_t WS_HB8   = WS_PART + (size_t)16 * NR * 128 * 4;
constexpr size_t WS_RIDT  = WS_HB8  + (size_t)NR * 1024;
constexpr size_t WS_Q8    = WS_RIDT + (size_t)NR * 128 * 2;
constexpr size_t WS_K8    = WS_Q8   + (size_t)NR * 1024;
constexpr size_t WS_V8    = WS_K8   + (size_t)NR * 256;
constexpr size_t WS_END   = WS_V8   + (size_t)NR * 256;

__device__ __forceinline__ float bf2f(unsigned b) { return __uint_as_float(b << 16); }
__device__ __forceinline__ float bflo(unsigned w) { return __uint_as_float(w << 16); }
__device__ __forceinline__ float bfhi(unsigned w) { return __uint_as_float(w & 0xffff0000u); }
__device__ __forceinline__ unsigned f2bf(float f) { unsigned u = __float_as_uint(f); return (u + 0x7fffu + ((u >> 16) & 1u)) >> 16; }
__device__ __forceinline__ unsigned pk2(float lo, float hi) { return f2bf(lo) | (f2bf(hi) << 16); }
__device__ __forceinline__ int lane_id_() { return (int)__builtin_amdgcn_mbcnt_hi(~0u, __builtin_amdgcn_mbcnt_lo(~0u, 0u)); }
__device__ __forceinline__ float wave_sum(float v) {
#pragma unroll
    for (int o = 1; o < 64; o <<= 1) v += __shfl_xor(v, o);
    return v;
}
__device__ __forceinline__ int wave_sum_dpp_i(int x) {
    x += __builtin_amdgcn_update_dpp(0, x, 0xB1, 0xf, 0xf, false);
    x += __builtin_amdgcn_update_dpp(0, x, 0x4E, 0xf, 0xf, false);
    x += __builtin_amdgcn_update_dpp(0, x, 0x141, 0xf, 0xf, false);
    x += __builtin_amdgcn_update_dpp(0, x, 0x140, 0xf, 0xf, false);
    return __builtin_amdgcn_readlane(x, 0) + __builtin_amdgcn_readlane(x, 16) + __builtin_amdgcn_readlane(x, 32) + __builtin_amdgcn_readlane(x, 48);
}
__device__ __forceinline__ float wave_sum_dpp_f(float x) {
#define DPPF_(v, ctrl) __builtin_bit_cast(float, __builtin_amdgcn_update_dpp(0, __builtin_bit_cast(int, v), ctrl, 0xf, 0xf, false))
    x += DPPF_(x, 0xB1); x += DPPF_(x, 0x4E); x += DPPF_(x, 0x141); x += DPPF_(x, 0x140);
#undef DPPF_
    const int xi = __builtin_bit_cast(int, x);
    return (__builtin_bit_cast(float, __builtin_amdgcn_readlane(xi, 0)) + __builtin_bit_cast(float, __builtin_amdgcn_readlane(xi, 16))) + (__builtin_bit_cast(float, __builtin_amdgcn_readlane(xi, 32)) + __builtin_bit_cast(float, __builtin_amdgcn_readlane(xi, 48)));
}
__device__ __forceinline__ unsigned mono_key(float s) { const unsigned u = __float_as_uint(s); return u ^ ((u >> 31) ? 0xFFFFFFFFu : 0x80000000u); }
__device__ __forceinline__ float unmono_key(unsigned k) { const unsigned u = (k >> 31) ? (k ^ 0x80000000u) : ~k; return __uint_as_float(u); }
__device__ __forceinline__ unsigned med3u(unsigned a, unsigned b, unsigned c) { unsigned r; asm("v_med3_u32 %0, %1, %2, %3" : "=v"(r) : "v"(a), "v"(b), "v"(c)); return r; }
__device__ __forceinline__ float dot2bf(unsigned a, unsigned b, float c) { return __builtin_amdgcn_fdot2_f32_bf16(__builtin_bit_cast(bf16x2_t, a), __builtin_bit_cast(bf16x2_t, b), c, false); }
#define MFMA16(a, b, c) __builtin_amdgcn_mfma_f32_16x16x32_bf16((a), (b), (c), 0, 0, 0)

#define XB_TMO      128
#define XB_XCNT(j)  (256  + 64 * (j))
#define XB_XSUB(j)  (1280 + 64 * (j))
#define XB_XGEN(j)  (2304 + 64 * (j))
#define XB_TOP      3328
#define XB_TOPGEN   3392
#define XCD_BAR_WORDS 3456
#define XB_SPIN_CAP (1u << 22)
__device__ __forceinline__ unsigned xb_ld(unsigned* p)              { return __hip_atomic_load((GAS unsigned*)p, __ATOMIC_RELAXED, __HIP_MEMORY_SCOPE_AGENT); }
__device__ __forceinline__ unsigned xb_add(unsigned* p, unsigned v) { return __hip_atomic_fetch_add((GAS unsigned*)p, v, __ATOMIC_RELAXED, __HIP_MEMORY_SCOPE_AGENT); }
__device__ __forceinline__ unsigned xb_xcc_id() { return (unsigned)__builtin_amdgcn_s_getreg((3 << 11) | 20) & 0xFu; }
#define XB_SPIN(cond, bar) do { unsigned _sp = 0; while (cond) { __builtin_amdgcn_s_sleep(1); \
    if ((++_sp & 255u) == 0u) { if (xb_ld(&(bar)[XB_TMO])) break; if (_sp > XB_SPIN_CAP) { xb_add(&(bar)[XB_TMO], 1u); break; } } } } while (0)
struct XcdBarrier { unsigned* bar; unsigned x; volatile LAS unsigned* st; };
__device__ __forceinline__ XcdBarrier xcd_barrier_post(unsigned* bar, volatile LAS unsigned* st) {
    XcdBarrier b; b.bar = bar; b.x = xb_xcc_id(); b.st = st;
    if (threadIdx.x == 0) (void)xb_add(&bar[XB_XCNT(b.x)], 1u);
    return b;
}
__device__ __forceinline__ void xcd_barrier_complete(unsigned* bar, unsigned x, unsigned& nloc, unsigned& nx) {
    const unsigned G = gridDim.x * gridDim.y * gridDim.z;
    unsigned sum, cnt, mine, sp = 0u;
    for (;;) {
        sum = 0u; cnt = 0u; mine = 0u;
#pragma unroll
        for (unsigned j = 0; j < 16; ++j) { const unsigned c = xb_ld(&bar[XB_XCNT(j)]); sum += c; cnt += (c > 0u) ? 1u : 0u; mine = (j == x) ? c : mine; }
        if (sum == G) break;
        __builtin_amdgcn_s_sleep(1);
        if ((++sp & 255u) == 0u) { if (xb_ld(&bar[XB_TMO])) break; if (sp > XB_SPIN_CAP) { xb_add(&bar[XB_TMO], 1u); break; } }
    }
    nloc = mine > 0u ? mine : 1u; nx = cnt > 0u ? cnt : 1u;
}
__device__ __forceinline__ void xcd_barrier(const XcdBarrier& b) {
    asm volatile("s_waitcnt vmcnt(0)" ::: "memory");
    __syncthreads();
    if (threadIdx.x == 0) {
        unsigned* bar = b.bar;
        __builtin_amdgcn_s_waitcnt(0);
        unsigned nloc = b.st[0], nx = b.st[1];
        if (nloc == 0u) { xcd_barrier_complete(bar, b.x, nloc, nx); b.st[0] = nloc; b.st[1] = nx; }
        const unsigned old = xb_add(&bar[XB_XSUB(b.x)], 1u);
        const unsigned gen = old / nloc;
        if (old + 1u == (gen + 1u) * nloc) {
            __builtin_amdgcn_fence(__ATOMIC_RELEASE, "agent");
            asm volatile("s_waitcnt vmcnt(0)" ::: "memory");
            const unsigned og = xb_add(&bar[XB_TOP], 1u);
            const unsigned tg = og / nx;
            if (og + 1u == (tg + 1u) * nx) xb_add(&bar[XB_TOPGEN], 1u);
            else XB_SPIN(xb_ld(&bar[XB_TOPGEN]) == tg, bar);
            __builtin_amdgcn_fence(__ATOMIC_ACQUIRE, "agent");
            xb_add(&bar[XB_XGEN(b.x)], 1u);
            asm volatile("s_waitcnt vmcnt(0)" ::: "memory");
        } else {
            XB_SPIN(xb_ld(&bar[XB_XGEN(b.x)]) == gen, bar);
            __builtin_amdgcn_fence(__ATOMIC_ACQUIRE, "agent");
            asm volatile("s_waitcnt vmcnt(0)" ::: "memory");
        }
    }
    __syncthreads();
}
namespace pg8 {
#define PG8_LAS __attribute__((address_space(3)))
typedef unsigned short bf16_t;
typedef short bf16x8 __attribute__((ext_vector_type(8)));
typedef float f32x4 __attribute__((ext_vector_type(4)));
typedef unsigned u32x4 __attribute__((ext_vector_type(4)));
constexpr int BM = 256, BK = 64, HALF = 128, HTB = HALF * BK * 2  , STAGE_BYTES = 8 * HTB, NXCD = 8, WGM = 8;

__host__ __device__ __forceinline__ int lds_byte(int r, int c) { const int st = (r >> 4) * 2 + (c >> 5), rr = r & 15, cc = c & 31, ob = rr * 64 + cc * 2; return st * 1024 + (ob ^ (((ob >> 9) & 1) << 5)); }
__host__ __device__ __forceinline__ void stage_rc(int b, int& R, int& C) { const int st = b / 1024, sb = b % 1024, swz = sb ^ (((sb >> 9) & 1) << 5); R = (st >> 1) * 16 + swz / 64; C = (st & 1) * 32 + (swz % 64) / 2; }
__host__ __device__ __forceinline__ int perm32(int rho) { const int n = rho >> 4, i = rho & 15; return 8 * (i >> 2) + 4 * n + (i & 3); }

__host__ __device__ __forceinline__ int tile_row(int pm) { return (pm >> 4) * 4224 + 16 + (pm & 15) * 256; }
struct Unit { int pm, pn; };
struct Gemm { const bf16_t* A; const bf16_t* Bt; int M, N, K; };

struct StaticOrder {
    int nM, nN, nwg, G, c;
    __host__ __device__ void init(int M, int N, int G_, int c_) { nM = M / BM; nN = N / BM; nwg = nM * nN; G = G_; c = c_; }
    __host__ __device__ bool next(int i, Unit& u) const {
        const long L = (long)i * G + c; if (L >= nwg) return false;
        int wgid = (int)L; { const int q = nwg / NXCD, r = nwg % NXCD, xcd = wgid % NXCD, off = wgid / NXCD; wgid = (xcd < r ? xcd * (q + 1) : r * (q + 1) + (xcd - r) * q) + off; }
        const int nig = WGM * nN, gid = wgid / nig, fm = gid * WGM, gsz = (nM - fm) < WGM ? (nM - fm) : WGM;
        u.pm = fm + ((wgid % nig) % gsz); u.pn = (wgid % nig) / gsz; return true;
    }
    __device__ __forceinline__ void a_ready(const Unit&) const {}
    __device__ __forceinline__ void done(const Unit&) const {}
};
__device__ __forceinline__ unsigned cvt_pk_bf16(float lo, float hi) { unsigned r; asm volatile("v_cvt_pk_bf16_f32 %0, %1, %2" : "=v"(r) : "v"(lo), "v"(hi)); return r; }
template <class Epi, class Sched>
__device__ __forceinline__ void gemm_phase(PG8_LAS unsigned char* lds, const Gemm g, const Sched& S, const Epi& E) {
    int tid_l = threadIdx.x; asm volatile("" : "+v"(tid_l));
    const int tid = tid_l, wid = __builtin_amdgcn_readfirstlane(tid >> 6), lane = tid & 63, wr = wid >> 2, wc = wid & 3, fr = lane & 15, fq = lane >> 4;
    const int K = g.K, nt = K / BK;
    unsigned voffA[2], voffB[2];
#pragma unroll
    for (int i = 0; i < 2; ++i) { int R, C; stage_rc(tid * 16 + i * 8192, R, C); const int Rb = Epi::PERM ? ((R & ~31) + perm32(R & 31)) : R;
        voffA[i] = (unsigned)(R * K + C) * 2u; voffB[i] = (unsigned)(Rb * K + C) * 2u; }
    const size_t kstep = (size_t)(BK * 2);
    const size_t hstep = (size_t)HALF * K * 2;
    const size_t tstep = 2 * hstep;
    const unsigned ldsw = (unsigned)wid * 1024u;
    const int aoff = lds_byte(wr * 64 + fr, fq * 8), boff = lds_byte(wc * 32 + fr, fq * 8);
#define PG8_SA(b, h) (((b) * 2 + (h)) * HTB)
#define PG8_SB(b, h) ((4 + (b) * 2 + (h)) * HTB)
#define PG8_STAGE(bufoff, gbase, voff) do { _Pragma("unroll") for (int _i = 0; _i < 2; ++_i) \
        __builtin_amdgcn_global_load_lds((const unsigned*)((const char*)(gbase) + (voff)[_i]), (PG8_LAS unsigned*)(lds + (bufoff) + ldsw + _i * 8192), 16, 0, 0); } while (0)
#define PG8_LDA(dst, b, h) do { _Pragma("unroll") for (int m = 0; m < 4; ++m) _Pragma("unroll") for (int k = 0; k < 2; ++k) dst[m][k] = *(const PG8_LAS bf16x8*)(lds + PG8_SA(b, h) + aoff + m * 2048 + k * 1024); } while (0)
#define PG8_LDB(dst, b, h) do { _Pragma("unroll") for (int n = 0; n < 2; ++n) _Pragma("unroll") for (int k = 0; k < 2; ++k) dst[n][k] = *(const PG8_LAS bf16x8*)(lds + PG8_SB(b, h) + boff + n * 2048 + k * 1024); } while (0)
#define PG8_MMA(ai, bj, At, Bt) do { __builtin_amdgcn_s_setprio(1); _Pragma("unroll") for (int m = 0; m < 4; ++m) _Pragma("unroll") for (int n = 0; n < 2; ++n) _Pragma("unroll") for (int k = 0; k < 2; ++k) \
        acc[ai][bj][m][n] = __builtin_amdgcn_mfma_f32_16x16x32_bf16(Bt[n][k], At[m][k], acc[ai][bj][m][n], 0, 0, 0); __builtin_amdgcn_s_setprio(0); } while (0)
#define PG8_WAIT_V(n) asm volatile("s_waitcnt vmcnt(" #n ")" ::: "memory")
#define PG8_WAIT_L(n) asm volatile("s_waitcnt lgkmcnt(" #n ")" ::: "memory")
#define PG8_BAR __builtin_amdgcn_s_barrier()
#define PG8_SCHED __builtin_amdgcn_sched_barrier(0)
    Unit cur, nxt; int ui = 0;
    if (!S.next(0, cur)) return;
    f32x4 acc[2][2][4][2];
#pragma unroll
    for (int a = 0; a < 2; ++a)
#pragma unroll
        for (int b = 0; b < 2; ++b)
#pragma unroll
            for (int m = 0; m < 4; ++m)
#pragma unroll
                for (int n = 0; n < 2; ++n) acc[a][b][m][n] = (f32x4){0.f, 0.f, 0.f, 0.f};
    bf16x8 At[4][2], B0[2][2], B1[2][2];
    const char* cA = (const char*)g.A + (size_t)tile_row(cur.pm) * K * 2; const char* cB = (const char*)g.Bt + (size_t)cur.pn * tstep;
    S.a_ready(cur);
    PG8_STAGE(PG8_SB(0, 0), cB, voffB); PG8_STAGE(PG8_SA(0, 0), cA, voffA); PG8_STAGE(PG8_SB(0, 1), cB + hstep, voffB); PG8_STAGE(PG8_SA(0, 1), cA + hstep, voffA);
    if (wr == 1) PG8_BAR;
    PG8_WAIT_V(4); PG8_BAR;
    PG8_STAGE(PG8_SB(1, 0), cB + kstep, voffB); PG8_STAGE(PG8_SA(1, 0), cA + kstep, voffA); PG8_STAGE(PG8_SB(1, 1), cB + hstep + kstep, voffB);
    PG8_WAIT_V(6); PG8_BAR;
    for (;;) {
        const bool has_next = S.next(ui + 1, nxt);
        const char* nA = has_next ? (const char*)g.A + (size_t)tile_row(nxt.pm) * K * 2 : cA; const char* nB = has_next ? (const char*)g.Bt + (size_t)nxt.pn * tstep : cB;
        for (int t = 0; t < nt; t += 2) {
            const bool last = (t == nt - 2);
            const char* a1 = cA + (size_t)(t + 1) * kstep;
            const char* a2 = last ? nA : cA + (size_t)(t + 2) * kstep; const char* b2 = last ? nB : cB + (size_t)(t + 2) * kstep;
            const char* a3 = a2 + kstep; const char* b3 = b2 + kstep;
            if (last && has_next) S.a_ready(nxt);
            PG8_LDB(B0, 0, 0); PG8_SCHED; PG8_LDA(At, 0, 0); PG8_STAGE(PG8_SA(1, 1), a1 + hstep, voffA);
            PG8_WAIT_L(8); PG8_BAR; PG8_WAIT_L(0); PG8_MMA(0, 0, At, B0); PG8_BAR; PG8_SCHED;
            PG8_LDB(B1, 0, 1); PG8_STAGE(PG8_SB(0, 0), b2, voffB);
            PG8_BAR; PG8_WAIT_L(0); PG8_MMA(0, 1, At, B1); PG8_BAR;
            PG8_LDA(At, 0, 1); PG8_STAGE(PG8_SA(0, 0), a2, voffA);
            PG8_BAR; PG8_WAIT_L(0); PG8_MMA(1, 0, At, B0); PG8_BAR; PG8_SCHED;
            PG8_STAGE(PG8_SB(0, 1), b2 + hstep, voffB);
            PG8_WAIT_V(6); PG8_BAR; PG8_MMA(1, 1, At, B1); PG8_BAR;
            PG8_LDB(B0, 1, 0); PG8_SCHED; PG8_LDA(At, 1, 0); PG8_STAGE(PG8_SA(0, 1), a2 + hstep, voffA);
            PG8_WAIT_L(8); PG8_BAR; PG8_WAIT_L(0); PG8_MMA(0, 0, At, B0); PG8_BAR; PG8_SCHED;
            PG8_LDB(B1, 1, 1); PG8_STAGE(PG8_SB(1, 0), b3, voffB);
            PG8_BAR; PG8_WAIT_L(0); PG8_MMA(0, 1, At, B1); PG8_BAR;
            PG8_LDA(At, 1, 1); PG8_STAGE(PG8_SA(1, 0), a3, voffA);
            PG8_BAR; PG8_WAIT_L(0); PG8_MMA(1, 0, At, B0); PG8_BAR; PG8_SCHED;
            PG8_STAGE(PG8_SB(1, 1), b3 + hstep, voffB);
            PG8_WAIT_V(6); PG8_BAR; PG8_MMA(1, 1, At, B1); PG8_BAR;
        }
        if constexpr (!Epi::AFTER_DRAIN) { E(acc, cur, wr, wc, fr, fq); S.done(cur); }
        if (!has_next) break;
#pragma unroll
        for (int a = 0; a < 2; ++a)
#pragma unroll
            for (int b = 0; b < 2; ++b)
#pragma unroll
                for (int m = 0; m < 4; ++m)
#pragma unroll
                    for (int n = 0; n < 2; ++n) acc[a][b][m][n] = (f32x4){0.f, 0.f, 0.f, 0.f};
        cur = nxt; cA = nA; cB = nB; ++ui;
    }
    PG8_WAIT_V(0);
    if (wr == 0) PG8_BAR;
    PG8_BAR;
    if constexpr (Epi::AFTER_DRAIN) { E.fused(acc, cur, wr, wc, fr, fq, lds, wid, lane); S.done(cur); }
#undef PG8_SA
#undef PG8_SB
#undef PG8_STAGE
#undef PG8_LDA
#undef PG8_LDB
#undef PG8_MMA
#undef PG8_WAIT_V
#undef PG8_WAIT_L
#undef PG8_BAR
#undef PG8_SCHED
}
}
__device__ __forceinline__ float row_rinv(const GAS float* ss, int row) {
    const GAS f32x4* p = (const GAS f32x4*)(ss + (size_t)row * 16);
    const f32x4 a = p[0], b = p[1], c = p[2], d = p[3];
    const float s = ((a[0] + a[1]) + (a[2] + a[3])) + ((b[0] + b[1]) + (b[2] + b[3])) + ((c[0] + c[1]) + (c[2] + c[3])) + ((d[0] + d[1]) + (d[2] + d[3]));
    return 1.0f / sqrtf(s * (1.0f / 1024.0f) + RMS_EPS);
}
struct EpiScale {
    static constexpr bool PERM = true, AFTER_DRAIN = false;
    GAS bf16_t* O0; int ld0; int split; GAS bf16_t* O1; int ld1; const GAS float* ss; GAS bf16_t* vT;
    const LAS float* rinv_lds; const LAS int* pm_lds;
    __device__ __forceinline__ void operator()(const f32x4 (&acc)[2][2][4][2], const pg8::Unit& u, int wr, int wc, int fr, int fq) const {
        asm volatile("" : "+v"(fr), "+v"(fq));
        const int row0 = pg8::tile_row(u.pm) + wr * 64 + fr; const int colt = u.pn * 256;
        GAS bf16_t* base; int ldc, c0;
        if (colt < split) { base = O0; ldc = ld0; c0 = colt; } else { base = O1; ldc = ld1; c0 = colt - split; }
        const int col0 = c0 + wc * 32 + 8 * fq;
        const bool dovt = (vT != nullptr) && (colt == 256);
        int uslot = 0;
#pragma unroll
        for (int q = 1; q < 4; ++q) if (pm_lds[q] == u.pm && pm_lds[0] != u.pm) uslot = (uslot == 0) ? q : uslot;
#pragma unroll
        for (int ai = 0; ai < 2; ++ai)
#pragma unroll
            for (int m = 0; m < 4; ++m) {
                const int row = row0 + ai * 128 + m * 16;
                const float ri = rinv_lds[uslot * 256 + wr * 64 + fr + ai * 128 + m * 16];
                GAS bf16_t* rowp = base + (size_t)row * ldc + col0;
#pragma unroll
                for (int bj = 0; bj < 2; ++bj) {
                    const f32x4 v0 = acc[ai][bj][m][0] * ri, v1 = acc[ai][bj][m][1] * ri;
                    u32x4 w; w.x = pk2(v0[0], v0[1]); w.y = pk2(v0[2], v0[3]); w.z = pk2(v1[0], v1[1]); w.w = pk2(v1[2], v1[3]);
                    *(GAS u32x4*)(rowp + bj * 128) = w;
                    if (dovt) {
                        const int b = row / TP, t = row - b * TP;
                        GAS bf16_t* vp = vT + ((size_t)(b * 2 + bj) * 128 + wc * 32 + 8 * fq) * TP + t;
                        vp[0 * TP] = (bf16_t)(w.x & 0xffff); vp[1 * TP] = (bf16_t)(w.x >> 16); vp[2 * TP] = (bf16_t)(w.y & 0xffff); vp[3 * TP] = (bf16_t)(w.y >> 16);
                        vp[4 * TP] = (bf16_t)(w.z & 0xffff); vp[5 * TP] = (bf16_t)(w.z >> 16); vp[6 * TP] = (bf16_t)(w.w & 0xffff); vp[7 * TP] = (bf16_t)(w.w >> 16);
                    }
                }
            }
    }
    __device__ __forceinline__ void tail(const f32x4 (&acc)[4], int b, int ng, int lane) const {
        const int colt = (ng * 64) & ~255; GAS bf16_t* base; int ldc, c0;
        if (colt < split) { base = O0; ldc = ld0; c0 = ng * 64; } else { base = O1; ldc = ld1; c0 = ng * 64 - split; }
        const bool dovt = (vT != nullptr) && (colt == 256);
#pragma unroll
        for (int i = 0; i < 4; ++i) {
            const int t = 4 * (lane >> 4) + i, row = b * TP + t; const float ri = row_rinv(ss, row);
#pragma unroll
            for (int nt = 0; nt < 4; ++nt) {
                const int col = c0 + nt * 16 + (lane & 15); const bf16_t w = (bf16_t)f2bf(acc[nt][i] * ri);
                base[(size_t)row * ldc + col] = w;
                if (dovt) { const int vc = ng * 64 - 256 + nt * 16 + (lane & 15); vT[((size_t)(b * 2 + (vc >> 7)) * 128 + (vc & 127)) * TP + t] = w; }
            }
        }
    }
};
struct EpiResid {
    static constexpr bool PERM = false, AFTER_DRAIN = false;
    GAS float* H; GAS bf16_t* HB; GAS float* ss; GAS unsigned char* HB8;
    __device__ __forceinline__ void operator()(const f32x4 (&acc)[2][2][4][2], const pg8::Unit& u, int wr, int wc, int fr, int fq) const {
        asm volatile("" : "+v"(fr), "+v"(fq));
        const int row0 = pg8::tile_row(u.pm) + wr * 64 + fr, col0 = u.pn * 256 + wc * 32 + 4 * fq;
        u32x2 hn[4];
#pragma unroll
        for (int q = 0; q < 4; ++q) hn[q] = *(const GAS u32x2*)(HB + (size_t)row0 * 1024 + col0 + (q >> 1) * 128 + (q & 1) * 16);
#pragma unroll
        for (int gi = 0; gi < 8; ++gi) {
            const int ai = gi >> 2, m = gi & 3;
            const int row = row0 + ai * 128 + m * 16; float s = 0.f;
            GAS bf16_t* bp = HB + (size_t)row * 1024 + col0;
            u32x2 hc[4];
#pragma unroll
            for (int q = 0; q < 4; ++q) hc[q] = hn[q];
            if (gi < 7) { const int rown = row0 + ((gi + 1) >> 2) * 128 + ((gi + 1) & 3) * 16;
#pragma unroll
                for (int q = 0; q < 4; ++q) hn[q] = *(const GAS u32x2*)(HB + (size_t)rown * 1024 + col0 + (q >> 1) * 128 + (q & 1) * 16); }
#pragma unroll
            for (int bj = 0; bj < 2; ++bj)
#pragma unroll
                for (int n = 0; n < 2; ++n) {
                    const u32x2 hw = hc[bj * 2 + n];
                    f32x4 hv = acc[ai][bj][m][n];
                    hv[0] += __builtin_bit_cast(float, hw.x << 16); hv[1] += __builtin_bit_cast(float, hw.x & 0xffff0000u); hv[2] += __builtin_bit_cast(float, hw.y << 16); hv[3] += __builtin_bit_cast(float, hw.y & 0xffff0000u);
                    s += (hv[0] * hv[0] + hv[1] * hv[1]) + (hv[2] * hv[2] + hv[3] * hv[3]);
                    u32x2 w; w.x = pk2(hv[0], hv[1]); w.y = pk2(hv[2], hv[3]);
                    *(GAS u32x2*)(bp + bj * 128 + n * 16) = w;
                    { int w8 = __builtin_amdgcn_cvt_pk_fp8_f32(fminf(fmaxf(hv[0] * X_SCALE, -416.f), 416.f), fminf(fmaxf(hv[1] * X_SCALE, -416.f), 416.f), 0, false);
                      w8 = __builtin_amdgcn_cvt_pk_fp8_f32(fminf(fmaxf(hv[2] * X_SCALE, -416.f), 416.f), fminf(fmaxf(hv[3] * X_SCALE, -416.f), 416.f), w8, true);
                      *(GAS unsigned*)(HB8 + (size_t)row * 1024 + col0 + bj * 128 + n * 16) = (unsigned)w8; }
                }
            s += __shfl_xor(s, 16); s += __shfl_xor(s, 32);
            if (fq == 0) ss[(size_t)row * 16 + u.pn * 4 + wc] = s;
        }
    }
    __device__ __forceinline__ void tail(const f32x4 (&acc)[4], int b, int ng, int lane) const {
#pragma unroll
        for (int i = 0; i < 4; ++i) {
            const int t = 4 * (lane >> 4) + i, row = b * TP + t; float s = 0.f;
#pragma unroll
            for (int nt = 0; nt < 4; ++nt) {
                const int col = ng * 64 + nt * 16 + (lane & 15); const size_t o = (size_t)row * 1024 + col;
                const float hv = bf2f((unsigned)HB[o]) + acc[nt][i]; HB[o] = (bf16_t)f2bf(hv); s += hv * hv;
                { const int w8 = __builtin_amdgcn_cvt_pk_fp8_f32(fminf(fmaxf(hv * X_SCALE, -416.f), 416.f), 0.f, 0, false); HB8[o] = (unsigned char)(w8 & 0xff); }
            }
            s += __shfl_xor(s, 1); s += __shfl_xor(s, 2); s += __shfl_xor(s, 4); s += __shfl_xor(s, 8);
            if ((lane & 15) == 0) ss[(size_t)row * 16 + ng] = s;
        }
    }
};

__device__ __forceinline__ int unit_pm_of(const pg8::StaticOrder& S, int i) {
    const long L = (long)i * S.G + S.c; if (L >= S.nwg) return -1;
    int wgid = (int)L; { const int q = S.nwg / pg8::NXCD, r = S.nwg % pg8::NXCD, xcd = wgid % pg8::NXCD, off = wgid / pg8::NXCD; wgid = (xcd < r ? xcd * (q + 1) : r * (q + 1) + (xcd - r) * q) + off; }
    const int nig = pg8::WGM * S.nN, gid = wgid / nig, fm = gid * pg8::WGM, gsz = (S.nM - fm) < pg8::WGM ? (S.nM - fm) : pg8::WGM;
    return fm + ((wgid % nig) % gsz);
}
template <class Epi>
__device__ __forceinline__ void gemm_tail(const GAS bf16_t* A, const GAS bf16_t* Bt, int N, const Epi& E, int gw, int NGW, int lane, LAS unsigned char* lds) {
    const int r = lane & 15, g = lane >> 4, njobs = BATCH * (N / 64);
    const int G_ = NGW / NWAVES, wv_ = gw % NWAVES, bk_ = gw / NWAVES;
    LAS f32x4* RED = (LAS f32x4*)lds;
#pragma unroll 1
    for (int job = bk_; job < njobs; job += G_) {
        const int b = job & 3, ng = job >> 2;
        const GAS bf16_t* ap = A + ((size_t)b * TP + r) * 1024 + 8 * g + wv_ * 128; const GAS bf16_t* bp = Bt + ((size_t)ng * 64 + r) * 1024 + 8 * g + wv_ * 128;
        bf16x8 af[4], bf[4][4];
#pragma unroll
        for (int ks = 0; ks < 4; ++ks) { af[ks] = *(const GAS bf16x8*)(ap + ks * 32);
#pragma unroll
            for (int nt = 0; nt < 4; ++nt) bf[nt][ks] = *(const GAS bf16x8*)(bp + (size_t)nt * 16 * 1024 + ks * 32); }
        f32x4 acc[4];
#pragma unroll
        for (int nt = 0; nt < 4; ++nt) { acc[nt] = (f32x4){0.f, 0.f, 0.f, 0.f};
#pragma unroll
            for (int ks = 0; ks < 4; ++ks) acc[nt] = MFMA16(af[ks], bf[nt][ks], acc[nt]); }
#pragma unroll
        for (int nt = 0; nt < 4; ++nt) RED[(wv_ * 4 + nt) * 64 + lane] = acc[nt];
        __syncthreads();
        if (wv_ == 0) {
#pragma unroll
            for (int nt = 0; nt < 4; ++nt) {
#pragma unroll
                for (int w = 1; w < 8; ++w) acc[nt] += RED[(w * 4 + nt) * 64 + lane];
            }
            E.tail(acc, b, ng, lane);
        }
        __syncthreads();
    }
}

struct Args {
    const float* in[17]; float* out; unsigned char* ws;
    double inv32[16]; double inv16[8];
};
struct Frame {
    LAS unsigned char* lds; GAS unsigned char* ws; int tid, lane, wave, G, gw, NGW;
};

__device__ __forceinline__ void p0_transpose_item(const float* W, int N, const float* gain, GAS bf16_t* WT, LAS float* scr, int item, int lane, int nblk) {
    const int kb = item / nblk, nb = item - kb * nblk, k0 = 64 * kb, n0 = 32 * nb;
    const int n = n0 + (lane & 31);
#pragma unroll 8
    for (int i = 0; i < 32; ++i) { const int kk = 2 * i + (lane >> 5); float v = 0.f; if (n < N) { v = W[(size_t)(k0 + kk) * N + n]; if (gain) v *= gain[k0 + kk]; } scr[kk * 33 + (lane & 31)] = v; }
    asm volatile("s_waitcnt lgkmcnt(0)" ::: "memory");
    const int c = lane & 7;
#pragma unroll
    for (int j = 0; j < 4; ++j) { const int nn = (lane >> 3) + 8 * j; const LAS float* s = scr + (8 * c) * 33 + nn;
        u32x4 o; o.x = pk2(s[0 * 33], s[1 * 33]); o.y = pk2(s[2 * 33], s[3 * 33]); o.z = pk2(s[4 * 33], s[5 * 33]); o.w = pk2(s[6 * 33], s[7 * 33]);
        *(GAS u32x4*)(WT + (size_t)(n0 + nn) * 1024 + k0 + 8 * c) = o; }
    asm volatile("s_waitcnt lgkmcnt(0)" ::: "memory");
}
__device__ __forceinline__ void sincos_rev(double ang, float& c, float& s) {
    double rev = ang * 0.15915494309189533577; rev -= rint(rev);
    const double r = rev * 6.28318530717958647692, r2 = r * r;
    double ts = r, ss = r, tc = 1.0, cc = 1.0;
#pragma unroll
    for (int k = 1; k <= 13; ++k) { tc *= -r2 / (double)((2 * k - 1) * (2 * k)); cc += tc; ts *= -r2 / (double)((2 * k) * (2 * k + 1)); ss += ts; }
    c = (float)cc; s = (float)ss;
}
__device__ __forceinline__ void phase_prologue(const Frame& F, const Args& a) {
    GAS unsigned char* ws = F.ws;
    {
        LAS float* scr = (LAS float*)(F.lds + F.wave * 8704);
        const float* a_norm = a.in[2]; const float* a_w_in = a.in[3]; const float* a_w_o = a.in[6]; const float* kv_norm = a.in[7]; const float* kv_w = a.in[8];
        const float* b_norm = a.in[9]; const float* b_w_q = a.in[10]; const float* b_w_o = a.in[11]; const float* ffn_norm = a.in[12]; const float* peer_w_q = a.in[13];
        constexpr int I2048 = 16 * 64, I1024 = 16 * 32, I512 = 16 * 16;
        constexpr int NITEMS = 2 * I2048 + 2 * I1024 + I512 + I1024 + I1024 + 2 * I1024 + 4 * I2048;
        for (int it = F.gw; it < NITEMS; it += F.NGW) {
            int r = it;
            if (r < 2 * I2048) { const int l = r / I2048; r -= l * I2048; p0_transpose_item(a_w_in + (size_t)l * 1024 * ACOLS, ACOLS, a_norm + l * 1024, (GAS bf16_t*)(ws + WS_WIN) + (size_t)l * 2048 * 1024, scr, r, F.lane, 64); continue; } r -= 2 * I2048;
            if (r < 2 * I1024) { const int l = r / I1024; r -= l * I1024; p0_transpose_item(a_w_o + (size_t)l * 1024 * 1024, 1024, nullptr, (GAS bf16_t*)(ws + WS_WOA) + (size_t)l * 1024 * 1024, scr, r, F.lane, 32); continue; } r -= 2 * I1024;
            if (r < I512) { p0_transpose_item(kv_w, 512, kv_norm, (GAS bf16_t*)(ws + WS_WKVQ), scr, r, F.lane, 16); continue; } r -= I512;
            if (r < I1024) { p0_transpose_item(b_w_q, 1024, b_norm, (GAS bf16_t*)(ws + WS_WKVQ) + (size_t)512 * 1024, scr, r, F.lane, 32); continue; } r -= I1024;
            if (r < I1024) { p0_transpose_item(b_w_q + (size_t)1024 * 1024, 1024, b_norm + 1024, (GAS bf16_t*)(ws + WS_WBQ1), scr, r, F.lane, 32); continue; } r -= I1024;
            if (r < 2 * I1024) { const int l = r / I1024; r -= l * I1024; p0_transpose_item(b_w_o + (size_t)l * 1024 * 1024, 1024, nullptr, (GAS bf16_t*)(ws + WS_WOB) + (size_t)l * 1024 * 1024, scr, r, F.lane, 32); continue; } r -= 2 * I1024;
            { const int l = r / I2048; r -= l * I2048; p0_transpose_item(peer_w_q + (size_t)l * 1024 * 2048, 2048, ffn_norm + l * 1024, (GAS bf16_t*)(ws + WS_WPQ) + (size_t)l * 2048 * 1024, scr, r, F.lane, 64); }
        }
    }
    const size_t gtid = (size_t)blockIdx.x * NT + F.tid, gthreads = (size_t)F.G * NT;
    {
        const float* pu = a.in[15]; const float* pv = a.in[16]; const float* ffn_norm = a.in[12];
        GAS unsigned char* U = (GAS unsigned char*)(ws + WS_U); GAS unsigned char* V = (GAS unsigned char*)(ws + WS_V);
        const int lane = F.lane;
#pragma unroll 1
        for (int l = 0; l < 4; ++l) {
            f32x4 gq[4];
#pragma unroll
            for (int q = 0; q < 4; ++q) gq[q] = *(const f32x4*)(ffn_norm + l * 1024 + 256 * q + 4 * lane) * U_SCALE;
#pragma unroll 2
            for (int ex = F.gw; ex < NEXP; ex += F.NGW) {
                const size_t ro = ((size_t)l * NEXP + ex) * 1024 + 4 * lane;
                f32x4 u4[4], v4[4];
#pragma unroll
                for (int q = 0; q < 4; ++q) { u4[q] = __builtin_nontemporal_load((const f32x4*)(pu + ro + 256 * q)); v4[q] = __builtin_nontemporal_load((const f32x4*)(pv + ro + 256 * q)); }
#pragma unroll
                for (int q = 0; q < 4; ++q) {
                    f32x4 u0 = u4[q] * gq[q], v0 = v4[q] * V_SCALE;
#pragma unroll
                    for (int k = 0; k < 4; ++k) { u0[k] = fminf(fmaxf(u0[k], -416.f), 416.f); v0[k] = fminf(fmaxf(v0[k], -416.f), 416.f); }
                    int wu = __builtin_amdgcn_cvt_pk_fp8_f32(u0[0], u0[1], 0, false); wu = __builtin_amdgcn_cvt_pk_fp8_f32(u0[2], u0[3], wu, true);
                    int wv = __builtin_amdgcn_cvt_pk_fp8_f32(v0[0], v0[1], 0, false); wv = __builtin_amdgcn_cvt_pk_fp8_f32(v0[2], v0[3], wv, true);
                    const size_t so = (((size_t)l * 8 + 2 * q + (lane >> 5)) * NEXP + ex) * 128 + 4 * (lane & 31);
                    *(GAS unsigned*)(U + so) = (unsigned)wu; *(GAS unsigned*)(V + so) = (unsigned)wv;
                }
            }
        }
    }
    { const float* sk = a.in[14]; GAS bf16_t* o = (GAS bf16_t*)(ws + WS_SK); for (size_t i = gtid; i < (size_t)4 * 2 * 128 * 128; i += gthreads) o[i] = (bf16_t)f2bf(sk[i]); }
    {
        GAS f32x2* r32 = (GAS f32x2*)(ws + WS_ROPE32); GAS f32x2* r16 = (GAS f32x2*)(ws + WS_ROPE16);
        for (size_t i = gtid; i < (size_t)TP * 24; i += gthreads) {
            const int t = (int)(i / 24), j = (int)(i - (size_t)t * 24); float c, s;
            if (j < 16) { sincos_rev((double)t * a.inv32[j], c, s); r32[t * 16 + j] = (f32x2){c, s}; }
            else { sincos_rev((double)t * a.inv16[j - 16], c, s); r16[t * 8 + (j - 16)] = (f32x2){c, s}; }
        }
    }
    {
        const float* x = a.in[0]; const float* meta = a.in[1];
        GAS float* H = (GAS float*)(ws + WS_H); GAS bf16_t* HB = (GAS bf16_t*)(ws + WS_HB); GAS float* SS = (GAS float*)(ws + WS_SS); GAS bf16_t* O = (GAS bf16_t*)(ws + WS_O);
        for (int row = F.gw; row < NR; row += F.NGW) {
            const int b = row / TP, t = row - b * TP;
            f32x4 v[4]; float s = 0.f;
#pragma unroll
            for (int j = 0; j < 4; ++j) {
                if (t < NMETA) v[j] = *(const f32x4*)(meta + (size_t)t * 1024 + 256 * j + 4 * F.lane);
                else if (t < TT) v[j] = *(const f32x4*)(x + ((size_t)b * SEQ + (t - NMETA)) * 1024 + 256 * j + 4 * F.lane);
                else v[j] = (f32x4){0.f, 0.f, 0.f, 0.f};
                s += (v[j][0] * v[j][0] + v[j][1] * v[j][1]) + (v[j][2] * v[j][2] + v[j][3] * v[j][3]);
            }
            s = wave_sum(s);
#pragma unroll
            for (int j = 0; j < 4; ++j) {
                u32x2 w; w.x = pk2(v[j][0], v[j][1]); w.y = pk2(v[j][2], v[j][3]);
                *(GAS u32x2*)(HB + (size_t)row * 1024 + 256 * j + 4 * F.lane) = w;
                if (t >= TT) *(GAS u32x2*)(O + (size_t)row * 1024 + 256 * j + 4 * F.lane) = (u32x2){0u, 0u};
            }
            if (F.lane < 16) SS[(size_t)row * 16 + F.lane] = (F.lane == 0) ? s : 0.f;
        }
    }
}
#ifndef TRB8_HYP
#define TRB8_HYP 0
#endif
#if TRB8_HYP == 0
#define TRB8_ROW(r) ((r) >> 1)
#define TRB8_COL(r) ((r) & 1)
#else
#define TRB8_ROW(r) ((r) & 7)
#define TRB8_COL(r) ((r) >> 3)
#endif
__device__ __forceinline__ void unpack8(const u32x4& w, float (&x)[8]) {
#pragma unroll
    for (int k = 0; k < 4; ++k) { x[2 * k] = bflo(w[k]); x[2 * k + 1] = bfhi(w[k]); }
}
__device__ __forceinline__ u32x4 pack8(const float (&x)[8]) { u32x4 w; w.x = pk2(x[0], x[1]); w.y = pk2(x[2], x[3]); w.z = pk2(x[4], x[5]); w.w = pk2(x[6], x[7]); return w; }
__device__ __forceinline__ void phase_a_post(const Frame& F, const float* qgain, const float* kgain) {
    GAS unsigned char* ws = F.ws;
    const GAS bf16_t* PROJ = (const GAS bf16_t*)(ws + WS_PROJ);
    GAS unsigned char* Q8 = ws + WS_Q8; GAS unsigned char* K8 = ws + WS_K8; GAS unsigned char* V8 = ws + WS_V8; GAS bf16_t* QI = (GAS bf16_t*)(ws + WS_QI); GAS bf16_t* KI = (GAS bf16_t*)(ws + WS_KI); GAS float* WI = (GAS float*)(ws + WS_WI);
    const GAS f32x2* r32 = (const GAS f32x2*)(ws + WS_ROPE32); const GAS f32x2* r16 = (const GAS f32x2*)(ws + WS_ROPE16);
    const int lane = F.lane, l16 = lane & 15;
    float qg[8], kg[8];
#pragma unroll
    for (int j = 0; j < 8; ++j) { qg[j] = qgain[l16 * 8 + j]; kg[j] = kgain[l16 * 8 + j]; }
    for (int rown = F.gw; rown < BATCH * TT; rown += F.NGW) {
        const int b = rown / TT, t = rown - b * TT; const int row = b * TP + t;
        const GAS bf16_t* pr = PROJ + (size_t)row * 2048;
        const u32x4 wA = *(const GAS u32x4*)(pr + 8 * lane), wB = *(const GAS u32x4*)(pr + 512 + 8 * lane), wC = *(const GAS u32x4*)(pr + 1024 + 8 * lane), wD = *(const GAS u32x4*)(pr + 1536 + 8 * lane);
        f32x2 cs32[8], cs16[8];
#pragma unroll
        for (int j = 0; j < 8; ++j) { cs32[j] = r32[t * 16 + (lane & 1) * 8 + j]; cs16[j] = r16[t * 8 + j]; }
#pragma unroll
        for (int gp = 0; gp < 3; ++gp) {
            float x[8]; unpack8(gp == 0 ? wA : (gp == 1 ? wB : wC), x);
            float ssq = 0.f;
#pragma unroll
            for (int j = 0; j < 8; ++j) ssq += x[j] * x[j];
            ssq += __shfl_xor(ssq, 1); ssq += __shfl_xor(ssq, 2); ssq += __shfl_xor(ssq, 4); ssq += __shfl_xor(ssq, 8);
            const float ri = 1.0f / sqrtf(ssq * (1.0f / 128.0f) + RMS_EPS);
            const bool rot = l16 < 4, second = (lane & 2) != 0;
#pragma unroll
            for (int j = 0; j < 8; ++j) {
                float y = x[j] * ri * (gp < 2 ? qg[j] : kg[j]);
                const float p = __shfl_xor(y, 2);
                if (rot) y = second ? (y * cs32[j].x + p * cs32[j].y) : (y * cs32[j].x - p * cs32[j].y);
                x[j] = (gp < 2) ? y * 0.08838834764831845f : y;
            }
            {
                const float sc = (gp < 2) ? Q_SCALE : K_SCALE; float y8[8];
#pragma unroll
                for (int j = 0; j < 8; ++j) y8[j] = fminf(fmaxf(x[j] * sc, -416.f), 416.f);
                int w0 = __builtin_amdgcn_cvt_pk_fp8_f32(y8[0], y8[1], 0, false); w0 = __builtin_amdgcn_cvt_pk_fp8_f32(y8[2], y8[3], w0, true);
                int w1 = __builtin_amdgcn_cvt_pk_fp8_f32(y8[4], y8[5], 0, false); w1 = __builtin_amdgcn_cvt_pk_fp8_f32(y8[6], y8[7], w1, true);
                if (gp < 2) *(GAS u32x2*)(Q8 + (size_t)row * 1024 + gp * 512 + 8 * lane) = (u32x2){(unsigned)w0, (unsigned)w1};
                else if (lane < 32) *(GAS u32x2*)(K8 + (size_t)row * 256 + 8 * lane) = (u32x2){(unsigned)w0, (unsigned)w1};
            }
            if (gp == 2 && lane >= 32) {
                float xv[8]; unpack8(wC, xv);
#pragma unroll
                for (int j = 0; j < 8; ++j) xv[j] = fminf(fmaxf(xv[j] * V8_SCALE, -416.f), 416.f);
                int w0 = __builtin_amdgcn_cvt_pk_fp8_f32(xv[0], xv[1], 0, false); w0 = __builtin_amdgcn_cvt_pk_fp8_f32(xv[2], xv[3], w0, true);
                int w1 = __builtin_amdgcn_cvt_pk_fp8_f32(xv[4], xv[5], 0, false); w1 = __builtin_amdgcn_cvt_pk_fp8_f32(xv[6], xv[7], w1, true);
                *(GAS u32x2*)(V8 + (size_t)row * 256 + 8 * (lane - 32)) = (u32x2){(unsigned)w0, (unsigned)w1};
            }
        }
        {
            float x[8]; unpack8(wD, x);
            const bool rot = (lane & 7) < 2 && lane < 40, second = (lane & 1) != 0;
#pragma unroll
            for (int j = 0; j < 8; ++j) {
                float y = x[j]; const float p = __shfl_xor(y, 1);
                if (rot) y = second ? (y * cs16[j].x + p * cs16[j].y) : (y * cs16[j].x - p * cs16[j].y);
                x[j] = (lane < 32) ? y * 0.125f : y;
            }
            if (lane < 32) *(GAS u32x4*)(QI + (size_t)row * 256 + 8 * lane) = pack8(x);
            else if (lane < 40) *(GAS u32x4*)(KI + (size_t)row * 64 + 8 * (lane - 32)) = pack8(x);
            else if (lane == 40) *(GAS f32x4*)(WI + (size_t)row * 4) = (f32x4){x[0] * 0.5f, x[1] * 0.5f, x[2] * 0.5f, x[3] * 0.5f};
        }
    }
}

constexpr int SCS = 4232;
constexpr int DSA_SC = 0, DSA_HIST = 8 * SCS * 4, DSA_SEL = DSA_HIST + 8 * 256 * 4;
__device__ __forceinline__ int wave_incl_scan(int v, int lane) {
#pragma unroll
    for (int o = 1; o < 64; o <<= 1) { const int t = __shfl_up(v, o); if (lane >= o) v += t; }
    return v;
}
__device__ __forceinline__ void phase_dsa_sel(const Frame& F) {
    GAS unsigned char* ws = F.ws;
    GAS bf16_t* SELG = (GAS bf16_t*)(ws + WS_SELG); const GAS bf16_t* QI = (const GAS bf16_t*)(ws + WS_QI);
    const GAS bf16_t* KI = (const GAS bf16_t*)(ws + WS_KI); const GAS float* WI = (const GAS float*)(ws + WS_WI);
    LAS unsigned* SC = (LAS unsigned*)(F.lds + DSA_SC); LAS unsigned* HIST = (LAS unsigned*)(F.lds + DSA_HIST) + F.wave * 256; LAS unsigned* SEL = (LAS unsigned*)(F.lds + DSA_SEL) + F.wave * 256;
    const int lane = F.lane, wave = F.wave, r = lane & 15, g = lane >> 4;
    const unsigned long long ltmask = (1ull << lane) - 1ull;
    constexpr int NITEM = BATCH * (TT / 8), NFIRST = (NITEM / 256) * 256;
    for (int it = blockIdx.x; it < NITEM; it += F.G) {
        const int b = it & 3, qb = (it < NFIRST) ? (it >> 2) + (NITEM - NFIRST) / 4 : (it - NFIRST) >> 2, t0 = qb * 8, nkeys = t0 + 8;
        const size_t rb = (size_t)b * TP;
        {
            bf16x8 A[2][2]; f32x4 wv[2];
#pragma unroll
            for (int mt = 0; mt < 2; ++mt) {
                const GAS bf16_t* qp = QI + (rb + t0 + 4 * mt + (r >> 2)) * 256 + (r & 3) * 64 + 8 * g;
                A[mt][0] = *(const GAS bf16x8*)qp; A[mt][1] = *(const GAS bf16x8*)(qp + 32);
                wv[mt] = *(const GAS f32x4*)(WI + (rb + t0 + 4 * mt + g) * 4);
            }
            const int ntile = (nkeys + 15) >> 4;
            LAS unsigned char* KTL = F.lds + DSA_HIST + wave * 2048;
            const int kq8 = lane >> 3, c8 = lane & 7;
#pragma unroll 1
            for (int kt0 = wave; kt0 < ntile; kt0 += 32) {
                u32x4 kl[4][2];
#pragma unroll
                for (int u = 0; u < 4; ++u)
#pragma unroll
                    for (int h = 0; h < 2; ++h) kl[u][h] = *(const GAS u32x4*)(KI + (rb + (kt0 + 8 * u) * 16 + 8 * h + kq8) * 64 + 8 * c8);
#pragma unroll
                for (int u = 0; u < 4; ++u) {
                    const int kt = kt0 + 8 * u;
                    if (kt < ntile) {
#pragma unroll
                        for (int h = 0; h < 2; ++h) { const int rw = 8 * h + kq8; *(LAS u32x4*)(KTL + rw * 128 + ((c8 ^ (rw & 7)) << 4)) = kl[u][h]; }
                        const bf16x8 B0 = *(const LAS bf16x8*)(KTL + r * 128 + ((g ^ (r & 7)) << 4)), B1 = *(const LAS bf16x8*)(KTL + r * 128 + (((4 + g) ^ (r & 7)) << 4));
                        const int key = kt * 16 + r;
#pragma unroll
                        for (int mt = 0; mt < 2; ++mt) {
                            f32x4 d = (f32x4){0.f, 0.f, 0.f, 0.f};
                            d = MFMA16(A[mt][0], B0, d); d = MFMA16(A[mt][1], B1, d);
                            float s = fmaxf(d[0], 0.f) * wv[mt][0] + fmaxf(d[1], 0.f) * wv[mt][1] + fmaxf(d[2], 0.f) * wv[mt][2] + fmaxf(d[3], 0.f) * wv[mt][3];
                            if (s == 0.f) s = 0.f;
                            const int qpos = t0 + 4 * mt + g;
                            SC[(4 * mt + g) * SCS + key] = (key <= qpos) ? mono_key(s) : 0u;
                        }
                    }
                }
            }
        }
        __syncthreads();
        const int qpos = t0 + wave, n = qpos + 1;
        LAS unsigned* row = SC + wave * SCS;
        int cnt;
        if (n <= TOPK) { for (int i = lane; i < TOPK; i += 64) SEL[i] = (i < n) ? (unsigned)i : 0u; cnt = n; }
        else {
            unsigned kreg[65];
#pragma unroll
            for (int c = 0; c < 65; ++c) { const int i = 64 * c + lane; kreg[c] = (i < n) ? row[i] : 0u; }
            const int nch = (n + 63) >> 6;
            unsigned prefix = 0u, mask = 0u; int want = TOPK;
#pragma unroll 1
            for (int pass = 3; pass >= 0; --pass) {
                const int sh = pass * 8;
#pragma unroll
                for (int i = 0; i < 4; ++i) HIST[lane + 64 * i] = 0u;
#pragma unroll
                for (int cb = 0; cb < 65; cb += 13) {
                    if (cb < nch) {
#pragma unroll
                        for (int c = cb; c < cb + 13; ++c) { const unsigned k = kreg[c]; if ((64 * c + lane) < n && (k & mask) == prefix) __hip_atomic_fetch_add(&HIST[(k >> sh) & 255u], 1u, __ATOMIC_RELAXED, __HIP_MEMORY_SCOPE_WORKGROUP); }
                    }
                }
                asm volatile("s_waitcnt lgkmcnt(0)" ::: "memory");
                const int h0 = (int)HIST[255 - 4 * lane], h1 = (int)HIST[254 - 4 * lane], h2 = (int)HIST[253 - 4 * lane], h3 = (int)HIST[252 - 4 * lane];
                const int local = h0 + h1 + h2 + h3, incl = wave_incl_scan(local, lane), excl = incl - local;
                const bool here = (excl < want) && (want <= incl);
                int bin = 0, above = 0;
                if (here) { int c = excl;
                    if (c + h0 >= want) { bin = 255 - 4 * lane; above = c; } else { c += h0;
                    if (c + h1 >= want) { bin = 254 - 4 * lane; above = c; } else { c += h1;
                    if (c + h2 >= want) { bin = 253 - 4 * lane; above = c; } else { c += h2; bin = 252 - 4 * lane; above = c; } } } }
                const unsigned long long bm = __ballot(here);
                const int src = (int)__builtin_ctzll(bm);
                bin = __shfl(bin, src); above = __shfl(above, src);
                want -= above; prefix |= (unsigned)bin << sh; mask |= 0xFFu << sh;
            }
            const unsigned T = prefix; const int need = want;
            int outbase = 0, eqbase = 0;
#pragma unroll
            for (int cb = 0; cb < 65; cb += 13) {
                if (cb < nch) {
#pragma unroll
                    for (int c = cb; c < cb + 13; ++c) {
                        const int i = 64 * c + lane; const unsigned k = kreg[c];
                        const bool gt = k > T, eq = (k == T) && (i < n);
                        const unsigned long long beq = __ballot(eq);
                        const int eqrank = eqbase + __popcll(beq & ltmask);
                        const bool take = gt || (eq && eqrank < need);
                        const unsigned long long bt = __ballot(take);
                        const int pos = outbase + __popcll(bt & ltmask);
                        if (take && pos < TOPK) SEL[pos] = (unsigned)i;
                        outbase += __popcll(bt); eqbase += __popcll(beq);
                    }
                }
            }
            cnt = TOPK;
        }
        asm volatile("s_waitcnt lgkmcnt(0)" ::: "memory");
        { const unsigned s0 = SEL[4 * lane], s1 = SEL[4 * lane + 1], s2 = SEL[4 * lane + 2], s3 = SEL[4 * lane + 3];
          *(GAS u32x2*)(SELG + (rb + qpos) * 256 + 4 * lane) = (u32x2){s0 | (s1 << 16), s2 | (s3 << 16)}; }
        (void)cnt;
        __syncthreads();
    }
}

__device__ __forceinline__ void phase_dsa_attn(const Frame& F) {
    GAS unsigned char* ws = F.ws;
    const GAS unsigned char* Q8 = ws + WS_Q8; const GAS unsigned char* K8 = ws + WS_K8; const GAS unsigned char* V8 = ws + WS_V8; const GAS bf16_t* SELG = (const GAS bf16_t*)(ws + WS_SELG); GAS bf16_t* O = (GAS bf16_t*)(ws + WS_O);
    const int lane = F.lane, wave = F.wave, r = lane & 15, g = lane >> 4;
    volatile LAS unsigned* MISC = (volatile LAS unsigned*)(F.lds + MISC_OFF);
    const int xp = (int)MISC[4], nx = (int)MISC[5], xrank = (int)MISC[6], xn = (int)MISC[7];
    LAS unsigned* SEL = (LAS unsigned*)(F.lds) + wave * 256; LAS float* Pb = (LAS float*)(F.lds + 8192) + wave * 1024; LAS unsigned char* KT = F.lds + 40960 + wave * 8704; LAS unsigned char* PT8 = F.lds + 110592 + wave * 1024;
    const int wrank = xrank * NWAVES + wave, nw = xn * NWAVES;
#pragma unroll 1
    for (int P = xp; P < 2 * BATCH; P += nx) {
        const int b = P >> 1, kvh = P & 1;
        const size_t rb = (size_t)b * TP;
#pragma unroll 1
        for (int qpos = wrank; qpos < TT; qpos += nw) {
            const size_t qrow = rb + qpos;
            const int cnt = (qpos + 1 < TOPK) ? qpos + 1 : TOPK;
            { const u32x2 sw = *(const GAS u32x2*)(SELG + qrow * 256 + 4 * lane);
              SEL[4 * lane] = sw.x & 0xffffu; SEL[4 * lane + 1] = sw.x >> 16; SEL[4 * lane + 2] = sw.y & 0xffffu; SEL[4 * lane + 3] = sw.y >> 16; }
            asm volatile("s_waitcnt lgkmcnt(0)" ::: "memory");
            long Aq[4];
            {
                const GAS unsigned char* qp = Q8 + qrow * 1024 + (kvh * 4 + (r & 3)) * 128 + g * 32;
                u32x4 q0 = *(const GAS u32x4*)qp, q1 = *(const GAS u32x4*)(qp + 16);
                if (r >= 4) { q0 = (u32x4){0u, 0u, 0u, 0u}; q1 = q0; }
                Aq[0] = (long)(((unsigned long long)q0.y << 32) | q0.x); Aq[1] = (long)(((unsigned long long)q0.w << 32) | q0.z);
                Aq[2] = (long)(((unsigned long long)q1.y << 32) | q1.x); Aq[3] = (long)(((unsigned long long)q1.w << 32) | q1.z);
            }
#ifndef NO_QK
            {
                const int kq8 = lane >> 3, c8 = lane & 7;
                const GAS unsigned char* kbase = K8 + rb * 256 + kvh * 128 + 16 * c8;
                u32x4 ka[4], kb2[4];
#define DSA_LOADK(buf, st) do { _Pragma("unroll") for (int u_ = 0; u_ < 4; ++u_) { const int key_ = (int)SEL[(st) * 32 + 8 * u_ + kq8]; buf[u_] = *(const GAS u32x4*)(kbase + (size_t)key_ * 256); } } while (0)
#define DSA_QKSTEP(buf, st) do { _Pragma("unroll") for (int u_ = 0; u_ < 4; ++u_) *(LAS u32x4*)(KT + (8 * u_ + kq8) * 144 + 16 * c8) = buf[u_]; \
                    _Pragma("unroll") for (int h_ = 0; h_ < 2; ++h_) { f32x4 d_ = (f32x4){0.f, 0.f, 0.f, 0.f}; \
                        const u32x4 k0_ = *(const LAS u32x4*)(KT + (16 * h_ + r) * 144 + g * 32), k1_ = *(const LAS u32x4*)(KT + (16 * h_ + r) * 144 + g * 32 + 16); \
                        d_ = __builtin_amdgcn_mfma_f32_16x16x32_fp8_fp8(Aq[0], (long)(((unsigned long long)k0_.y << 32) | k0_.x), d_, 0, 0, 0); \
                        d_ = __builtin_amdgcn_mfma_f32_16x16x32_fp8_fp8(Aq[1], (long)(((unsigned long long)k0_.w << 32) | k0_.z), d_, 0, 0, 0); \
                        d_ = __builtin_amdgcn_mfma_f32_16x16x32_fp8_fp8(Aq[2], (long)(((unsigned long long)k1_.y << 32) | k1_.x), d_, 0, 0, 0); \
                        d_ = __builtin_amdgcn_mfma_f32_16x16x32_fp8_fp8(Aq[3], (long)(((unsigned long long)k1_.w << 32) | k1_.z), d_, 0, 0, 0); \
                        d_ *= (1.0f / (Q_SCALE * K_SCALE)); \
                        const int kk_ = (st) * 32 + 16 * h_ + r; if (kk_ >= cnt) d_ = (f32x4){-INFINITY, -INFINITY, -INFINITY, -INFINITY}; \
                        if (g == 0) *(LAS f32x4*)(Pb + kk_ * 4) = d_; } } while (0)
                DSA_LOADK(ka, 0);
#pragma unroll 1
                for (int st = 0; st < 8; st += 2) {
                    DSA_LOADK(kb2, st + 1);
                    DSA_QKSTEP(ka, st);
                    if (st + 2 < 8) DSA_LOADK(ka, st + 2);
                    DSA_QKSTEP(kb2, st + 1);
                }
            }
#endif
            asm volatile("s_waitcnt lgkmcnt(0)" ::: "memory");
            {
                f32x4 sv[4];
#pragma unroll
                for (int j = 0; j < 4; ++j) sv[j] = *(const LAS f32x4*)(Pb + (lane + 64 * j) * 4);
                float mx[4], sm[4];
#pragma unroll
                for (int i = 0; i < 4; ++i) { float m = fmaxf(fmaxf(sv[0][i], sv[1][i]), fmaxf(sv[2][i], sv[3][i]));
#pragma unroll
                    for (int o = 1; o < 64; o <<= 1) m = fmaxf(m, __shfl_xor(m, o));
                    mx[i] = m; }
#pragma unroll
                for (int i = 0; i < 4; ++i) { float t = 0.f;
#pragma unroll
                    for (int j = 0; j < 4; ++j) { const float e = __expf(sv[j][i] - mx[i]); sv[j][i] = e; t += e; }
                    sm[i] = 1.0f / wave_sum(t); }
#pragma unroll
                for (int j = 0; j < 4; ++j)
#pragma unroll
                    for (int i = 0; i < 4; ++i) { const int w8 = __builtin_amdgcn_cvt_pk_fp8_f32(sv[j][i] * sm[i] * P8_SCALE, 0.f, 0, false); PT8[i * 256 + lane + 64 * j] = (unsigned char)(w8 & 0xff); }
            }
            asm volatile("s_waitcnt lgkmcnt(0)" ::: "memory");
#ifndef NO_PV
            {
                const int kq8 = lane >> 3, c8 = lane & 7;
                const GAS unsigned char* vbase = V8 + rb * 256 + kvh * 128 + 16 * c8;
                f32x4 Od[8];
#pragma unroll
                for (int c = 0; c < 8; ++c) Od[c] = (f32x4){0.f, 0.f, 0.f, 0.f};
                const unsigned vt_lane = (unsigned)(size_t)KT + (unsigned)((8 * g + TRB8_ROW(r)) * 144 + 8 * TRB8_COL(r));
                u32x4 va[4], vb[4];
#define DSA_LOADV(buf, ks) do { _Pragma("unroll") for (int u_ = 0; u_ < 4; ++u_) { const int key_ = (int)SEL[(ks) * 32 + 8 * u_ + kq8]; buf[u_] = *(const GAS u32x4*)(vbase + (size_t)key_ * 256); } } while (0)
#define DSA_PVSTEP(buf, ks) do { _Pragma("unroll") for (int u_ = 0; u_ < 4; ++u_) *(LAS u32x4*)(KT + (8 * u_ + kq8) * 144 + 16 * c8) = buf[u_]; \
                    const u32x2 pw_ = *(const LAS u32x2*)(PT8 + (r & 3) * 256 + (ks) * 32 + 8 * g); const long pa_ = (long)(((unsigned long long)pw_.y << 32) | pw_.x); \
                    long t0_, t1_, t2_, t3_, t4_, t5_, t6_, t7_; \
                    asm volatile("ds_read_b64_tr_b8 %0, %8\n\tds_read_b64_tr_b8 %1, %8 offset:16\n\tds_read_b64_tr_b8 %2, %8 offset:32\n\tds_read_b64_tr_b8 %3, %8 offset:48\n\t" \
                                 "ds_read_b64_tr_b8 %4, %8 offset:64\n\tds_read_b64_tr_b8 %5, %8 offset:80\n\tds_read_b64_tr_b8 %6, %8 offset:96\n\tds_read_b64_tr_b8 %7, %8 offset:112\n\t" \
                                 "s_waitcnt lgkmcnt(0)" \
                                 : "=&v"(t0_), "=&v"(t1_), "=&v"(t2_), "=&v"(t3_), "=&v"(t4_), "=&v"(t5_), "=&v"(t6_), "=&v"(t7_) : "v"(vt_lane) : "memory"); \
                    __builtin_amdgcn_sched_barrier(0); \
                    Od[0] = __builtin_amdgcn_mfma_f32_16x16x32_fp8_fp8(pa_, t0_, Od[0], 0, 0, 0); Od[1] = __builtin_amdgcn_mfma_f32_16x16x32_fp8_fp8(pa_, t1_, Od[1], 0, 0, 0); \
                    Od[2] = __builtin_amdgcn_mfma_f32_16x16x32_fp8_fp8(pa_, t2_, Od[2], 0, 0, 0); Od[3] = __builtin_amdgcn_mfma_f32_16x16x32_fp8_fp8(pa_, t3_, Od[3], 0, 0, 0); \
                    Od[4] = __builtin_amdgcn_mfma_f32_16x16x32_fp8_fp8(pa_, t4_, Od[4], 0, 0, 0); Od[5] = __builtin_amdgcn_mfma_f32_16x16x32_fp8_fp8(pa_, t5_, Od[5], 0, 0, 0); \
                    Od[6] = __builtin_amdgcn_mfma_f32_16x16x32_fp8_fp8(pa_, t6_, Od[6], 0, 0, 0); Od[7] = __builtin_amdgcn_mfma_f32_16x16x32_fp8_fp8(pa_, t7_, Od[7], 0, 0, 0); } while (0)
                DSA_LOADV(va, 0);
#pragma unroll 1
                for (int ks = 0; ks < 8; ks += 2) {
                    DSA_LOADV(vb, ks + 1);
                    DSA_PVSTEP(va, ks);
                    if (ks + 2 < 8) DSA_LOADV(va, ks + 2);
                    DSA_PVSTEP(vb, ks + 1);
                }
                if (g == 0) {
#pragma unroll
                    for (int c = 0; c < 8; ++c)
#pragma unroll
                        for (int i = 0; i < 4; ++i) Pb[i * 128 + c * 16 + r] = Od[c][i] * (1.0f / (P8_SCALE * V8_SCALE));
                }
                asm volatile("s_waitcnt lgkmcnt(0)" ::: "memory");
                { const int kq = lane >> 4, c16 = lane & 15;
                  const f32x4 o0 = *(const LAS f32x4*)(Pb + kq * 128 + 8 * c16), o1 = *(const LAS f32x4*)(Pb + kq * 128 + 8 * c16 + 4);
                  u32x4 w; w.x = pk2(o0[0], o0[1]); w.y = pk2(o0[2], o0[3]); w.z = pk2(o1[0], o1[1]); w.w = pk2(o1[2], o1[3]);
                  *(GAS u32x4*)(O + qrow * 1024 + (kvh * 4 + kq) * 128 + 8 * c16) = w; }
            }
#endif
            asm volatile("s_waitcnt lgkmcnt(0)" ::: "memory");
            asm volatile("s_waitcnt lgkmcnt(0)" ::: "memory");
        }
    }
}

__device__ __forceinline__ float softplus_f(float z) { return fmaxf(z, 0.f) + __logf(1.0f + __expf(-fabsf(z))); }
__device__ __forceinline__ void phase_stick(const Frame& F) {
    GAS unsigned char* ws = F.ws;
    const GAS bf16_t* BQ = (const GAS bf16_t*)(ws + WS_Q); const GAS bf16_t* SKV = (const GAS bf16_t*)(ws + WS_SKV); GAS bf16_t* O = (GAS bf16_t*)(ws + WS_O);
    const int lane = F.lane, wave = F.wave, r = lane & 15, g = lane >> 4, kq = lane >> 4, c16 = lane & 15;
    LAS unsigned char* KTs = F.lds + wave * 17408; LAS unsigned char* VTs = KTs + 8704;
    const unsigned vt_lane = (unsigned)(size_t)VTs + (unsigned)((4 * g + (r >> 2)) * 272 + 8 * (r & 3));
    constexpr int NQT = TT / 16;
    constexpr int NH = 2;
    for (int it = F.gw; it < BATCH * (8 / NH) * NQT; it += F.NGW) {
        constexpr int NMAIN = BATCH * (8 / NH) * (NQT - 1);
        const int qt = (it < NMAIN) ? (it % (NQT - 1)) + 1 : 0, hb = (it < NMAIN) ? it / (NQT - 1) : it - NMAIN, head0 = (hb % (8 / NH)) * NH, b = hb / (8 / NH), kvh = head0 >> 2, t0 = qt * 16;
        const size_t rb = (size_t)b * TP;
        bf16x8 Bq[NH][4];
#pragma unroll
        for (int hh = 0; hh < NH; ++hh) { const GAS bf16_t* qp = BQ + (rb + t0 + r) * 1024 + (head0 + hh) * 128 + 32 * g;
#pragma unroll
          for (int ks = 0; ks < 4; ++ks) Bq[hh][ks] = *(const GAS bf16x8*)(qp + ks * 8); }
        f32x4 Oa[NH][8];
#pragma unroll
        for (int hh = 0; hh < NH; ++hh)
#pragma unroll
            for (int dt = 0; dt < 8; ++dt) Oa[hh][dt] = (f32x4){0.f, 0.f, 0.f, 0.f};
        float carry[NH];
#pragma unroll
        for (int hh = 0; hh < NH; ++hh) carry[hh] = 0.f;
        const int qpos = t0 + r;
        const GAS bf16_t* kvb = SKV + rb * 512 + kvh * 128 + 8 * c16;
        for (int kb = t0; kb >= 0; kb -= 32) {
            u32x4 kl[8], vl[8];
#pragma unroll
            for (int u = 0; u < 8; ++u) { int key = kb - 16 + 4 * u + kq; key = key < 0 ? 0 : key; kl[u] = *(const GAS u32x4*)(kvb + (size_t)key * 512); vl[u] = *(const GAS u32x4*)(kvb + (size_t)key * 512 + 256); }
#pragma unroll
            for (int u = 0; u < 8; ++u) { *(LAS u32x4*)(KTs + (4 * u + kq) * 272 + 16 * c16) = kl[u]; *(LAS u32x4*)(VTs + (4 * u + kq) * 272 + 16 * c16) = vl[u]; }
            bool done = true;
            bf16x8 Pbh[NH];
#pragma unroll
            for (int hh = 0; hh < NH; ++hh) {
                float a_hi[4], a_lo[4];
                float zz[2][4], sp[2][4], tot[2];
#pragma unroll
                for (int tl = 0; tl < 2; ++tl) {
                    const int kbase = kb - 16 * tl;
                    f32x4 z = (f32x4){0.f, 0.f, 0.f, 0.f};
#pragma unroll
                    for (int ks = 0; ks < 4; ++ks) z = MFMA16(*(const LAS bf16x8*)(KTs + (16 * (1 - tl) + r) * 272 + g * 64 + ks * 16), Bq[hh][ks], z);
                    float gsum = 0.f;
#pragma unroll
                    for (int i = 0; i < 4; ++i) { const int key = kbase + 4 * g + i; const bool valid = (key >= 0) && (key < qpos);
                        const float zv = z[i] * 0.08838834764831845f; zz[tl][i] = zv; const float s_ = valid ? softplus_f(zv) : 0.f; sp[tl][i] = s_; gsum += s_; }
                    const float g0 = __shfl(gsum, r), g1 = __shfl(gsum, r + 16), g2 = __shfl(gsum, r + 32), g3 = __shfl(gsum, r + 48);
                    tot[tl] = (g0 + g1) + (g2 + g3);
                    float above = (g < 3 ? g3 : 0.f) + (g < 2 ? g2 : 0.f) + (g < 1 ? g1 : 0.f);
                    float c3 = above + sp[tl][3], c2 = c3 + sp[tl][2], c1 = c2 + sp[tl][1], c0 = c1 + sp[tl][0];
                    sp[tl][3] = c3; sp[tl][2] = c2; sp[tl][1] = c1; sp[tl][0] = c0;
                }
#pragma unroll
                for (int i = 0; i < 4; ++i) {
                    const int khi = kb + 4 * g + i, klo = kb - 16 + 4 * g + i;
                    a_hi[i] = (khi < qpos) ? __expf(zz[0][i] - (carry[hh] + sp[0][i])) : 0.f;
                    a_lo[i] = (klo >= 0 && klo < qpos) ? __expf(zz[1][i] - (carry[hh] + tot[0] + sp[1][i])) : 0.f;
                }
                carry[hh] += tot[0] + tot[1];
                { const unsigned w0 = pk2(a_hi[0], a_hi[1]), w1 = pk2(a_hi[2], a_hi[3]), w2 = pk2(a_lo[0], a_lo[1]), w3 = pk2(a_lo[2], a_lo[3]);
                  const u32x4 w = (u32x4){w0, w1, w2, w3}; Pbh[hh] = __builtin_bit_cast(bf16x8, w); }
                done = done && (carry[hh] > 104.0f);
            }
#pragma unroll
            for (int dh = 0; dh < 8; dh += 4) {
                s16x4 t0_, t1_, t2_, t3_, t4_, t5_, t6_, t7_;
                if (dh == 0) asm volatile("ds_read_b64_tr_b16 %0, %8 offset:4352\n\tds_read_b64_tr_b16 %1, %8\n\tds_read_b64_tr_b16 %2, %8 offset:4384\n\tds_read_b64_tr_b16 %3, %8 offset:32\n\t"
                             "ds_read_b64_tr_b16 %4, %8 offset:4416\n\tds_read_b64_tr_b16 %5, %8 offset:64\n\tds_read_b64_tr_b16 %6, %8 offset:4448\n\tds_read_b64_tr_b16 %7, %8 offset:96\n\ts_waitcnt lgkmcnt(0)"
                             : "=&v"(t0_), "=&v"(t1_), "=&v"(t2_), "=&v"(t3_), "=&v"(t4_), "=&v"(t5_), "=&v"(t6_), "=&v"(t7_) : "v"(vt_lane) : "memory");
                else asm volatile("ds_read_b64_tr_b16 %0, %8 offset:4480\n\tds_read_b64_tr_b16 %1, %8 offset:128\n\tds_read_b64_tr_b16 %2, %8 offset:4512\n\tds_read_b64_tr_b16 %3, %8 offset:160\n\t"
                             "ds_read_b64_tr_b16 %4, %8 offset:4544\n\tds_read_b64_tr_b16 %5, %8 offset:192\n\tds_read_b64_tr_b16 %6, %8 offset:4576\n\tds_read_b64_tr_b16 %7, %8 offset:224\n\ts_waitcnt lgkmcnt(0)"
                             : "=&v"(t0_), "=&v"(t1_), "=&v"(t2_), "=&v"(t3_), "=&v"(t4_), "=&v"(t5_), "=&v"(t6_), "=&v"(t7_) : "v"(vt_lane) : "memory");
                __builtin_amdgcn_sched_barrier(0);
                const bf16x8 V0 = __builtin_shufflevector(t0_, t1_, 0, 1, 2, 3, 4, 5, 6, 7), V1 = __builtin_shufflevector(t2_, t3_, 0, 1, 2, 3, 4, 5, 6, 7), V2 = __builtin_shufflevector(t4_, t5_, 0, 1, 2, 3, 4, 5, 6, 7), V3 = __builtin_shufflevector(t6_, t7_, 0, 1, 2, 3, 4, 5, 6, 7);
#pragma unroll
                for (int hh = 0; hh < NH; ++hh) { Oa[hh][dh] = MFMA16(V0, Pbh[hh], Oa[hh][dh]); Oa[hh][dh + 1] = MFMA16(V1, Pbh[hh], Oa[hh][dh + 1]); Oa[hh][dh + 2] = MFMA16(V2, Pbh[hh], Oa[hh][dh + 2]); Oa[hh][dh + 3] = MFMA16(V3, Pbh[hh], Oa[hh][dh + 3]); }
            }
            if (__all(done)) break;
        }
#pragma unroll
        for (int hh = 0; hh < NH; ++hh) {
            GAS bf16_t* op = O + (rb + t0 + r) * 1024 + (head0 + hh) * 128 + 4 * g;
#pragma unroll
            for (int dt = 0; dt < 8; ++dt) { u32x2 w; w.x = pk2(Oa[hh][dt][0], Oa[hh][dt][1]); w.y = pk2(Oa[hh][dt][2], Oa[hh][dt][3]); *(GAS u32x2*)(op + dt * 16) = w; }
        }
    }
}
constexpr int SCPH = 130;
constexpr int SKP = 272;
constexpr int PE_SC = 0, PE_TOP = 256 * SCPH * 2  , PE_SK = PE_TOP + 16384, PE_END = PE_SK + 2 * 128 * SKP;
__device__ __forceinline__ float gelu_erf(float v) { return 0.5f * v * (1.0f + erff(v * 0.70710678118654752f)); }
__device__ __forceinline__ void phase_peer_route(const Frame& F, int layer) {
    GAS unsigned char* ws = F.ws;
    const GAS bf16_t* PQ = (const GAS bf16_t*)(ws + WS_PROJ); const GAS bf16_t* SK = (const GAS bf16_t*)(ws + WS_SK) + (size_t)layer * 2 * 128 * 128;
    LAS _Float16* SCP = (LAS _Float16*)(F.lds + PE_SC); LAS unsigned* TOPL = (LAS unsigned*)(F.lds + PE_TOP); LAS unsigned char* SKL = F.lds + PE_SK;
    static_assert(PE_END <= MISC_OFF, "PEER routing LDS");
    for (int i = F.tid; i < 2 * 128 * 16; i += NT) { const int rw = i >> 4, ch = i & 15; *(LAS u32x4*)(SKL + rw * SKP + ch * 16) = *(const GAS u32x4*)(SK + (size_t)rw * 128 + ch * 8); }
    __syncthreads();
    GAS bf16_t* RIDG = (GAS bf16_t*)(ws + WS_RID); GAS bf16_t* RIDT = (GAS bf16_t*)(ws + WS_RIDT); GAS float* RGG = (GAS float*)(ws + WS_RG);
    const int lane = F.lane, wave = F.wave, tid = F.tid, r = lane & 15, g = lane >> 4;
    constexpr int NIT = BATCH * (TT / 16);
    for (int it = blockIdx.x; it < NIT; it += F.G) {
        const int b = it / (TT / 16), tb = it - b * (TT / 16);
        const size_t row0 = (size_t)b * TP + tb * 16;
#ifndef PROBE_ROUTE
#define PROBE_ROUTE 0
#endif
        for (int rp = 0; rp < ((PROBE_ROUTE & 1) ? 2 : 1); ++rp) {
            const int h = wave;
#pragma unroll 1
            for (int c = 0; c < 2; ++c) {
                bf16x8 A[4];
                const GAS bf16_t* ap = PQ + (row0 + r) * 2048 + h * 256 + c * 128 + 8 * g;
#pragma unroll
                for (int ks = 0; ks < 4; ++ks) A[ks] = *(const GAS bf16x8*)(ap + ks * 32);
#pragma unroll
                for (int kt = 0; kt < 8; ++kt) {
                    const LAS unsigned char* bp = SKL + (c * 128 + kt * 16 + r) * SKP + 16 * g;
                    f32x4 d = (f32x4){0.f, 0.f, 0.f, 0.f};
#pragma unroll
                    for (int ks = 0; ks < 4; ++ks) d = MFMA16(A[ks], *(const LAS bf16x8*)(bp + ks * 64), d);
#pragma unroll
                    for (int i = 0; i < 4; ++i) SCP[((4 * g + i) * 16 + h * 2 + c) * SCPH + kt * 16 + r] = (_Float16)d[i];
                }
            }
        }
        __syncthreads();
        for (int rp = 0; rp < ((PROBE_ROUTE & 2) ? 2 : 1); ++rp) {
            if (rp) __syncthreads();
            const int list = tid >> 1, half = tid & 1;
            const LAS _Float16* lp = SCP + list * SCPH + 64 * half;
            unsigned a[16];
#pragma unroll
            for (int i = 0; i < 16; ++i) a[i] = 0u;
#pragma unroll 4
            for (int k = 0; k < 64; ++k) {
                const unsigned x = (mono_key((float)lp[k]) & ~127u) | (unsigned)(127 - (64 * half + k));
#pragma unroll
                for (int i = 15; i >= 1; --i) a[i] = med3u(a[i - 1], a[i], x);
                a[0] = a[0] > x ? a[0] : x;
            }
            if (half) {
#pragma unroll
                for (int i = 0; i < 16; ++i) TOPL[list * 16 + i] = a[i];
            }
            __syncthreads();
            if (!half) {
#pragma unroll 4
                for (int k = 0; k < 16; ++k) {
                    const unsigned x = TOPL[list * 16 + k];
#pragma unroll
                    for (int i = 15; i >= 1; --i) a[i] = med3u(a[i - 1], a[i], x);
                    a[0] = a[0] > x ? a[0] : x;
                }
            }
            __syncthreads();
            if (!half) {
#pragma unroll
                for (int i = 0; i < 16; ++i) TOPL[list * 16 + i] = a[i];
            }
        }
        __syncthreads();
        for (int rp = 0; rp < ((PROBE_ROUTE & 4) ? 2 : 1); ++rp)
        if (tid < 128) {
            const int token = tid >> 3, h = tid & 7;
            const LAS unsigned* L1 = TOPL + (token * 16 + h * 2) * 16; const LAS unsigned* L2 = L1 + 16;
            float v1[16], v2[16];
#pragma unroll
            for (int i = 0; i < 16; ++i) { v1[i] = unmono_key(L1[i] & ~127u); v2[i] = unmono_key(L2[i] & ~127u); }
            unsigned cc[16];
#pragma unroll
            for (int i = 0; i < 16; ++i) cc[i] = 0u;
#pragma unroll
            for (int ia = 0; ia < 16; ++ia)
#pragma unroll
                for (int ib = 0; ib < 16; ++ib) if ((ia + 1) * (ib + 1) <= 16) {
                    const unsigned x = (mono_key(v1[ia] + v2[ib]) & ~255u) | (unsigned)(255 - (ia * 16 + ib));
#pragma unroll
                    for (int i = 15; i >= 1; --i) cc[i] = med3u(cc[i - 1], cc[i], x);
                    cc[0] = cc[0] > x ? cc[0] : x;
                }
            const float bmax = unmono_key(cc[0] & ~255u);
            float e[16], esum = 0.f;
#pragma unroll
            for (int i = 0; i < 16; ++i) { e[i] = __expf(unmono_key(cc[i] & ~255u) - bmax); esum += e[i]; }
            const float inv = 1.0f / esum;
#pragma unroll
            for (int i = 0; i < 16; ++i) {
                const int flat = 255 - (int)(cc[i] & 255u), ia = flat >> 4, ib = flat & 15;
                const int i1 = 127 - (int)(L1[ia] & 127u), i2 = 127 - (int)(L2[ib] & 127u);
                RIDG[(row0 + token) * 128 + h * 16 + i] = (bf16_t)(i1 * 128 + i2); RGG[(row0 + token) * 128 + i * 8 + h] = e[i] * inv;
            }
        }
        __syncthreads();
    }
}

constexpr int NTOK = BATCH * TT;
#define XCC_FRAME() volatile LAS unsigned* MISC_ = (volatile LAS unsigned*)(F.lds + MISC_OFF); \
    const int xp = (int)MISC_[4], nx = (int)MISC_[5], wrank = (int)MISC_[6] * NWAVES + F.wave, nw = (int)MISC_[7] * NWAVES
__device__ __forceinline__ unsigned id_of(const u32x4& a, const u32x4& b, int k) {
    const unsigned w = (k < 8) ? a[(k >> 1) & 3] : b[(k >> 1) & 3]; return (k & 1) ? (w >> 16) : (w & 0xffffu);
}
#define FP8X2(w, hi) __builtin_amdgcn_cvt_pk_f32_fp8((int)(w), hi)
__device__ __forceinline__ size_t tok_row(int tokn) { const int bsel = tokn / TT; return (size_t)bsel * TP + (tokn - bsel * TT); }
#define LDG16(base, off) (*(const GAS u32x4*)((const GAS unsigned char*)(base) + (unsigned)(off)))
__device__ __forceinline__ void phase_peer_u(const Frame& F, int layer, unsigned idmask = 0xffffu) {
    GAS unsigned char* ws = F.ws;
    const GAS unsigned char* X8 = ws + WS_HB8; const GAS unsigned char* RIDb = ws + WS_RID;
    const int lane = F.lane, j = lane >> 3, c = lane & 7, r = lane & 15, g = lane >> 4;
    LAS unsigned char* MET = F.lds + F.wave * 1024;
    LAS unsigned char* TIL = F.lds + 8192 + F.wave * 9216;
    XCC_FRAME();
#pragma unroll 1
    for (int s = xp; s < 8; s += nx) {
        const GAS unsigned char* Us = ws + WS_U + ((size_t)layer * 8 + s) * NEXP * 128;
        GAS unsigned char* Ps = ws + WS_PART + (size_t)s * NR * 128 * 4;
        const unsigned uo = 16u * c;
#define PU_FETCH(tk) do { const int tk_ = (tk) < NTOK ? (tk) : NTOK - 1; const unsigned r_ = (unsigned)tok_row(tk_); \
        pid = *(const GAS unsigned*)(RIDb + (r_ * 256u + 4u * lane)); px = *(const GAS unsigned*)(X8 + (r_ * 1024u + 128u * s + 4u * (lane & 31))); } while (0)
#define PU_STAGE(slot) do { *(LAS unsigned*)(MET + (slot) * 512 + 4 * lane) = pid; if (lane < 32) *(LAS unsigned*)(MET + (slot) * 512 + 256 + 4 * lane) = px; } while (0)
#define PU_GATHER(buf, slot) do { const u32x4 ia_ = *(const LAS u32x4*)(MET + (slot) * 512 + 32 * j), ib_ = *(const LAS u32x4*)(MET + (slot) * 512 + 32 * j + 16); \
        _Pragma("unroll") for (int b_ = 0; b_ < 16; ++b_) buf[b_] = LDG16(Us, (id_of(ia_, ib_, b_) & idmask) * 128u + uo); } while (0)
#define PU_STEP(cur, nxt) do { const unsigned row = (unsigned)tok_row(tokn); const int sl = it & 1; \
        PU_STAGE(sl ^ 1); PU_GATHER(nxt, sl ^ 1); PU_FETCH(tokn + 2 * nw); \
        const u32x4 xa = *(const LAS u32x4*)(MET + sl * 512 + 256 + 32 * g), xb = *(const LAS u32x4*)(MET + sl * 512 + 256 + 32 * g + 16); \
        const long x0 = (long)(((unsigned long long)xa.y << 32) | xa.x), x1 = (long)(((unsigned long long)xa.w << 32) | xa.z), x2 = (long)(((unsigned long long)xb.y << 32) | xb.x), x3 = (long)(((unsigned long long)xb.w << 32) | xb.z); \
        __builtin_amdgcn_sched_barrier(0); \
        f32x4 outv = (f32x4){0.f, 0.f, 0.f, 0.f}; \
        _Pragma("unroll") for (int hf = 0; hf < 2; ++hf) { \
            _Pragma("unroll") for (int b = 0; b < 8; ++b) *(LAS u32x4*)(TIL + ((b >> 1) * 16 + (b & 1) * 8 + j) * 144 + 16 * c) = cur[8 * hf + b]; \
            _Pragma("unroll") for (int tl = 0; tl < 4; ++tl) { \
                const u32x4 k0 = *(const LAS u32x4*)(TIL + (tl * 16 + r) * 144 + 32 * g), k1 = *(const LAS u32x4*)(TIL + (tl * 16 + r) * 144 + 32 * g + 16); \
                f32x4 d = (f32x4){0.f, 0.f, 0.f, 0.f}; \
                d = __builtin_amdgcn_mfma_f32_16x16x32_fp8_fp8((long)(((unsigned long long)k0.y << 32) | k0.x), x0, d, 0, 0, 0); \
                d = __builtin_amdgcn_mfma_f32_16x16x32_fp8_fp8((long)(((unsigned long long)k0.w << 32) | k0.z), x1, d, 0, 0, 0); \
                d = __builtin_amdgcn_mfma_f32_16x16x32_fp8_fp8((long)(((unsigned long long)k1.y << 32) | k1.x), x2, d, 0, 0, 0); \
                d = __builtin_amdgcn_mfma_f32_16x16x32_fp8_fp8((long)(((unsigned long long)k1.w << 32) | k1.z), x3, d, 0, 0, 0); \
                if (r == 4 * hf + tl) outv = d; } } \
        if (r < 8) *(GAS f32x4*)(Ps + (row * 512u + 64u * r + 16u * g)) = outv;        \
        tokn += nw; ++it; } while (0)
        unsigned pid, px; int it = 0, tokn = wrank;
        u32x4 uA[16], uB[16];
        PU_FETCH(wrank); PU_STAGE(0); PU_GATHER(uA, 0); PU_FETCH(wrank + nw);
#pragma unroll 1
        while (tokn < NTOK) {
            PU_STEP(uA, uB);
            if (tokn >= NTOK) break;
            PU_STEP(uB, uA);
        }
    }
}
__device__ __forceinline__ void phase_peer_act(const Frame& F) {
    GAS unsigned char* ws = F.ws;
    const GAS float* PART = (const GAS float*)(ws + WS_PART); const GAS float* RGG = (const GAS float*)(ws + WS_RG); const GAS float* SS = (const GAS float*)(ws + WS_SS); GAS unsigned char* ACT8 = ws + WS_ACT;
    const size_t n4 = (size_t)NTOK * 32;
    for (size_t i = (size_t)blockIdx.x * NT + F.tid; i < n4; i += (size_t)F.G * NT) {
        const int tokn = (int)(i >> 5), q4 = (int)(i & 31); const int bsel = tokn / TT; const size_t row = (size_t)bsel * TP + (tokn - bsel * TT);
        const size_t o = row * 128 + 4 * q4;
        f32x4 acc = *(const GAS f32x4*)(PART + o);
#pragma unroll
        for (int s = 1; s < 8; ++s) acc += *(const GAS f32x4*)(PART + (size_t)s * NR * 128 + o);
        const float ri = row_rinv(SS, (int)row) * (1.0f / (U_SCALE * X_SCALE)); const f32x4 gt = *(const GAS f32x4*)(RGG + o) * ACT_SCALE;
        float a4[4];
#pragma unroll
        for (int e = 0; e < 4; ++e) a4[e] = fminf(fmaxf(gelu_erf(acc[e] * ri) * gt[e], -416.f), 416.f);
        int w8 = __builtin_amdgcn_cvt_pk_fp8_f32(a4[0], a4[1], 0, false); w8 = __builtin_amdgcn_cvt_pk_fp8_f32(a4[2], a4[3], w8, true);
        *(GAS unsigned*)(ACT8 + o) = (unsigned)w8;
    }
}
__device__ __forceinline__ void phase_peer_v(const Frame& F, int layer, float* dout, size_t dry_off = 0) {
    GAS unsigned char* ws = F.ws;
    const GAS unsigned char* RIDb = ws + WS_RID; const GAS unsigned char* ACTb = ws + WS_ACT;
    GAS unsigned char* Hb = ws + WS_H + dry_off; GAS unsigned char* HBb = ws + WS_HB + dry_off; GAS float* SS = (GAS float*)(ws + WS_SS + dry_off);
    const int lane = F.lane, j = lane >> 3, c = lane & 7, r = lane & 15, g = lane >> 4;
    LAS unsigned char* MET = F.lds + F.wave * 1024;
    LAS unsigned char* TIL = F.lds + 8192 + F.wave * 18432;
    LAS float* OUTL = (LAS float*)(F.lds + 8192 + 8 * 18432) + F.wave * 128;
    const unsigned vt_lane = (unsigned)(size_t)TIL + (unsigned)((8 * g + TRB8_ROW(r)) * 144 + 8 * TRB8_COL(r));
    XCC_FRAME();
#pragma unroll 1
    for (int s = xp; s < 8; s += nx) {
        const GAS unsigned char* Vs = ws + WS_V + ((size_t)layer * 8 + s) * NEXP * 128;
        const unsigned vo = 16u * c;
#define PV_FETCH(tk) do { const int tk_ = (tk) < NTOK ? (tk) : NTOK - 1; const unsigned r_ = (unsigned)tok_row(tk_); \
        pid = *(const GAS unsigned*)(RIDb + (r_ * 256u + 4u * lane)); pact = *(const GAS unsigned*)(ACTb + (r_ * 128u + 4u * (lane & 31))); } while (0)
#define PV_STAGE(slot) do { *(LAS unsigned*)(MET + (slot) * 512 + 4 * lane) = pid; if (lane < 32) *(LAS unsigned*)(MET + (slot) * 512 + 256 + 4 * lane) = pact; } while (0)
#define PV_GATHER(slot) do { const u32x4 ia_ = *(const LAS u32x4*)(MET + (slot) * 512 + 32 * j), ib_ = *(const LAS u32x4*)(MET + (slot) * 512 + 32 * j + 16); \
        _Pragma("unroll") for (int b_ = 0; b_ < 16; ++b_) v[b_] = LDG16(Vs, id_of(ia_, ib_, b_) * 128u + vo); } while (0)
#define PV_TR(ASM_) asm volatile(ASM_ : "=&v"(t0_), "=&v"(t1_), "=&v"(t2_), "=&v"(t3_), "=&v"(t4_), "=&v"(t5_), "=&v"(t6_), "=&v"(t7_) : "v"(vt_lane) : "memory")
#define PV_STORES() do { const unsigned col_ = 128u * s + 16u * c + 2u * j; \
        *(GAS unsigned*)(HBb + (row_p * 2048u + col_ * 2u)) = pk2(hv_p.x, hv_p.y); \
        if (lane == 0) { SS[(size_t)row_p * 16 + s] = sq_p; SS[(size_t)row_p * 16 + 8 + s] = 0.f; } \
        if (dout && tsel_p >= NMETA) *(f32x2*)(dout + ((size_t)bsel_p * SEQ + (tsel_p - NMETA)) * 1024 + col_) = hv_p; } while (0)
        unsigned pid, pact; int it = 0;
        u32x4 v[16];
        f32x2 hv_p = (f32x2){0.f, 0.f}; float sq_p = 0.f; unsigned row_p = 0; int tsel_p = 0, bsel_p = 0;
        PV_FETCH(wrank); PV_STAGE(0); PV_GATHER(0); PV_FETCH(wrank + nw);
#pragma unroll 1
        for (int tokn = wrank; tokn < NTOK; tokn += nw, ++it) {
            const int bsel = tokn / TT, tsel = tokn - bsel * TT; const unsigned row = (unsigned)(bsel * TP + tsel);
            const int sl = it & 1;
            const unsigned col = 128u * s + 16u * c + 2u * j;
            PV_STAGE(sl ^ 1);
#pragma unroll
            for (int b = 0; b < 16; ++b) *(LAS u32x4*)(TIL + (8 * b + j) * 144 + 16 * c) = v[b];
            const unsigned hold = *(const GAS unsigned*)(HBb + (row * 2048u + col * 2u));
            __builtin_amdgcn_sched_barrier(0);
            PV_GATHER(sl ^ 1);
            PV_FETCH(tokn + 2 * nw);
            __builtin_amdgcn_sched_barrier(0);
            if (it > 0) PV_STORES();
            __builtin_amdgcn_sched_barrier(0);
            f32x4 Od[8];
#pragma unroll
            for (int cc = 0; cc < 8; ++cc) Od[cc] = (f32x4){0.f, 0.f, 0.f, 0.f};
#pragma unroll
            for (int ks = 0; ks < 4; ++ks) {
                const u32x2 aw = *(const LAS u32x2*)(MET + sl * 512 + 256 + 32 * ks + 8 * g); const long pa = (long)(((unsigned long long)aw.y << 32) | aw.x);
                long t0_, t1_, t2_, t3_, t4_, t5_, t6_, t7_;
                if (ks == 0) PV_TR("ds_read_b64_tr_b8 %0, %8 offset:0\n\tds_read_b64_tr_b8 %1, %8 offset:16\n\tds_read_b64_tr_b8 %2, %8 offset:32\n\tds_read_b64_tr_b8 %3, %8 offset:48\n\tds_read_b64_tr_b8 %4, %8 offset:64\n\tds_read_b64_tr_b8 %5, %8 offset:80\n\tds_read_b64_tr_b8 %6, %8 offset:96\n\tds_read_b64_tr_b8 %7, %8 offset:112\n\ts_waitcnt lgkmcnt(0)"); else if (ks == 1) PV_TR("ds_read_b64_tr_b8 %0, %8 offset:4608\n\tds_read_b64_tr_b8 %1, %8 offset:4624\n\tds_read_b64_tr_b8 %2, %8 offset:4640\n\tds_read_b64_tr_b8 %3, %8 offset:4656\n\tds_read_b64_tr_b8 %4, %8 offset:4672\n\tds_read_b64_tr_b8 %5, %8 offset:4688\n\tds_read_b64_tr_b8 %6, %8 offset:4704\n\tds_read_b64_tr_b8 %7, %8 offset:4720\n\ts_waitcnt lgkmcnt(0)"); else if (ks == 2) PV_TR("ds_read_b64_tr_b8 %0, %8 offset:9216\n\tds_read_b64_tr_b8 %1, %8 offset:9232\n\tds_read_b64_tr_b8 %2, %8 offset:9248\n\tds_read_b64_tr_b8 %3, %8 offset:9264\n\tds_read_b64_tr_b8 %4, %8 offset:9280\n\tds_read_b64_tr_b8 %5, %8 offset:9296\n\tds_read_b64_tr_b8 %6, %8 offset:9312\n\tds_read_b64_tr_b8 %7, %8 offset:9328\n\ts_waitcnt lgkmcnt(0)"); else PV_TR("ds_read_b64_tr_b8 %0, %8 offset:13824\n\tds_read_b64_tr_b8 %1, %8 offset:13840\n\tds_read_b64_tr_b8 %2, %8 offset:13856\n\tds_read_b64_tr_b8 %3, %8 offset:13872\n\tds_read_b64_tr_b8 %4, %8 offset:13888\n\tds_read_b64_tr_b8 %5, %8 offset:13904\n\tds_read_b64_tr_b8 %6, %8 offset:13920\n\tds_read_b64_tr_b8 %7, %8 offset:13936\n\ts_waitcnt lgkmcnt(0)");
                __builtin_amdgcn_sched_barrier(0);
                Od[0] = __builtin_amdgcn_mfma_f32_16x16x32_fp8_fp8(pa, t0_, Od[0], 0, 0, 0); Od[1] = __builtin_amdgcn_mfma_f32_16x16x32_fp8_fp8(pa, t1_, Od[1], 0, 0, 0);
                Od[2] = __builtin_amdgcn_mfma_f32_16x16x32_fp8_fp8(pa, t2_, Od[2], 0, 0, 0); Od[3] = __builtin_amdgcn_mfma_f32_16x16x32_fp8_fp8(pa, t3_, Od[3], 0, 0, 0);
                Od[4] = __builtin_amdgcn_mfma_f32_16x16x32_fp8_fp8(pa, t4_, Od[4], 0, 0, 0); Od[5] = __builtin_amdgcn_mfma_f32_16x16x32_fp8_fp8(pa, t5_, Od[5], 0, 0, 0);
                Od[6] = __builtin_amdgcn_mfma_f32_16x16x32_fp8_fp8(pa, t6_, Od[6], 0, 0, 0); Od[7] = __builtin_amdgcn_mfma_f32_16x16x32_fp8_fp8(pa, t7_, Od[7], 0, 0, 0);
            }
            if (g == 0) {
#pragma unroll
                for (int cc = 0; cc < 8; ++cc) OUTL[16 * cc + r] = Od[cc][0];
            }
            asm volatile("s_waitcnt lgkmcnt(0)" ::: "memory");
            const f32x2 o2 = *(const LAS f32x2*)(OUTL + 16 * c + 2 * j);
            hv_p.x = __builtin_bit_cast(float, hold << 16) + o2.x * (1.0f / (ACT_SCALE * V_SCALE)); hv_p.y = __builtin_bit_cast(float, hold & 0xffff0000u) + o2.y * (1.0f / (ACT_SCALE * V_SCALE));
            sq_p = wave_sum_dpp_f(hv_p.x * hv_p.x + hv_p.y * hv_p.y); row_p = row; tsel_p = tsel; bsel_p = bsel;
        }
        if (it > 0) PV_STORES();
    }
}

#define PHASE_FRAME() Frame F; { unsigned long long ws_ = wsu; asm volatile("" : "+s"(ws_)); int tid_ = threadIdx.x; asm volatile("" : "+v"(tid_)); \
    F.lds = (LAS unsigned char*)lds; F.ws = (GAS unsigned char*)ws_; F.tid = tid_; F.lane = tid_ & 63; F.wave = __builtin_amdgcn_readfirstlane(tid_ >> 6); F.G = gridDim.x; F.gw = blockIdx.x * NWAVES + F.wave; F.NGW = F.G * NWAVES; } \
    GAS unsigned char* ws = F.ws; (void)ws
__global__ void __launch_bounds__(NT, 2) mk_fwd(Args a) {
    extern __shared__ __attribute__((aligned(16))) unsigned char lds[];
    unsigned long long wsu = (unsigned long long)a.ws; asm volatile("" : "+s"(wsu));
    unsigned long long outu = (unsigned long long)a.out; asm volatile("" : "+s"(outu));
    volatile LAS unsigned* MISC = (volatile LAS unsigned*)((LAS unsigned char*)lds + MISC_OFF);
    if (threadIdx.x < 16) MISC[threadIdx.x] = 0u;
    __syncthreads();
    XcdBarrier bar = xcd_barrier_post((unsigned*)((unsigned char*)wsu + WS_CTL), MISC);
    if (threadIdx.x == 0) MISC[6] = xb_add((unsigned*)((unsigned char*)wsu + WS_CTL + CTL_XRANK) + 64 * bar.x, 1u);
    PG8_LAS unsigned char* glds = (PG8_LAS unsigned char*)lds;

#ifndef PROBE_DUP
#define PROBE_DUP 0
#endif
    constexpr size_t DRY_OFF = WS_END - WS_H;
    { PHASE_FRAME(); phase_prologue(F, a); }
    xcd_barrier(bar);
    if (threadIdx.x == 0) {
        unsigned nx = 0, xp = 0, xn = 1;
        for (unsigned j = 0; j < 16; ++j) { const unsigned c = xb_ld((unsigned*)((unsigned char*)wsu + WS_CTL + CTL_XRANK) + 64 * j); if (j == bar.x) { xp = nx; xn = c ? c : 1u; } nx += (c > 0u) ? 1u : 0u; }
        MISC[4] = xp; MISC[5] = nx ? nx : 1u; MISC[7] = xn;
    }
    __syncthreads();
    if (PROBE_DUP & 1) { { PHASE_FRAME(); phase_prologue(F, a); } xcd_barrier(bar); }
#pragma unroll 1
    for (int layer = 0; layer < 4; ++layer) {
        for (int rep = 0; rep < ((PROBE_DUP & 2) ? 2 : 1); ++rep) {
            PHASE_FRAME();
            const GAS bf16_t* Bt; int N; EpiScale E;
            E.ss = (const GAS float*)(ws + WS_SS); E.vT = nullptr;
            if (layer < 2) { Bt = (const GAS bf16_t*)(ws + WS_WIN) + (size_t)layer * 2048 * 1024; N = 2048; E.O0 = (GAS bf16_t*)(ws + WS_PROJ); E.ld0 = 2048; E.split = 2048; E.O1 = E.O0; E.ld1 = 2048; }
            else if (layer == 2) { Bt = (const GAS bf16_t*)(ws + WS_WKVQ); N = 1536; E.O0 = (GAS bf16_t*)(ws + WS_SKV); E.ld0 = 512; E.split = 512; E.O1 = (GAS bf16_t*)(ws + WS_Q); E.ld1 = 1024; }
            else { Bt = (const GAS bf16_t*)(ws + WS_WBQ1); N = 1024; E.O0 = (GAS bf16_t*)(ws + WS_Q); E.ld0 = 1024; E.split = 1024; E.O1 = E.O0; E.ld1 = 1024; }
            pg8::Gemm gm{(const bf16_t*)(ws + WS_HB), (const bf16_t*)Bt, BATCH * SEQ, N, 1024}; pg8::StaticOrder S; S.init(BATCH * SEQ, N, F.G, (int)blockIdx.x);
            { LAS float* RINV = (LAS float*)(F.lds + 131072); LAS int* PML = (LAS int*)(F.lds + 131072 + 4096);
              _Pragma("unroll") for (int q = 0; q < 4; ++q) { const int pmq = unit_pm_of(S, q); if (F.tid == 0) PML[q] = pmq;
                  if (pmq >= 0 && F.tid < 256) RINV[q * 256 + F.tid] = row_rinv((const GAS float*)(ws + WS_SS), pg8::tile_row(pmq) + F.tid); }
              __syncthreads(); E.rinv_lds = RINV; E.pm_lds = PML; }
            pg8::gemm_phase<EpiScale, pg8::StaticOrder>(glds, gm, S, E);
            gemm_tail<EpiScale>((const GAS bf16_t*)(ws + WS_HB), Bt, N, E, F.gw, F.NGW, F.lane, F.lds);
            if (rep == 0 && (PROBE_DUP & 2)) xcd_barrier(bar);
        }
        xcd_barrier(bar);
        if (layer < 2) {
            for (int rep = 0; rep < ((PROBE_DUP & 4) ? 2 : 1); ++rep) {
            { PHASE_FRAME(); phase_a_post(F, a.in[4] + layer * 128, a.in[5] + layer * 128); }
            xcd_barrier(bar);
            for (int rep2 = 0; rep2 < ((PROBE_DUP & 512) ? 2 : 1); ++rep2) { { PHASE_FRAME(); phase_dsa_sel(F); } xcd_barrier(bar); }
            for (int rep2 = 0; rep2 < ((PROBE_DUP & 1024) ? 2 : 1); ++rep2) { { PHASE_FRAME(); phase_dsa_attn(F); } if (rep2 == 0 && (PROBE_DUP & 1024)) xcd_barrier(bar); }
            if (rep == 0 && (PROBE_DUP & 4)) xcd_barrier(bar);
            }
        } else {
            for (int rep = 0; rep < ((PROBE_DUP & 8) ? 2 : 1); ++rep) {
            PHASE_FRAME(); phase_stick(F);
            if (rep == 0 && (PROBE_DUP & 8)) xcd_barrier(bar);
            }
        }
        xcd_barrier(bar);
        for (int rep = ((PROBE_DUP & 16) ? 1 : 0); rep >= 0; --rep) {
            PHASE_FRAME();
            const GAS bf16_t* Bt = (layer < 2) ? (const GAS bf16_t*)(ws + WS_WOA) + (size_t)layer * 1024 * 1024 : (const GAS bf16_t*)(ws + WS_WOB) + (size_t)(layer - 2) * 1024 * 1024;
            EpiResid E; E.H = (GAS float*)(ws + WS_H + (rep ? DRY_OFF : 0)); E.HB = (GAS bf16_t*)(ws + WS_HB + (rep ? DRY_OFF : 0)); E.ss = (GAS float*)(ws + WS_SS + (rep ? DRY_OFF : 0)); E.HB8 = ws + WS_HB8;
            pg8::Gemm gm{(const bf16_t*)(ws + WS_O), (const bf16_t*)Bt, BATCH * SEQ, 1024, 1024}; pg8::StaticOrder S; S.init(BATCH * SEQ, 1024, F.G, (int)blockIdx.x);
            pg8::gemm_phase<EpiResid, pg8::StaticOrder>(glds, gm, S, E);
            gemm_tail<EpiResid>((const GAS bf16_t*)(ws + WS_O), Bt, 1024, E, F.gw, F.NGW, F.lane, F.lds);
            if (rep) xcd_barrier(bar);
        }
        xcd_barrier(bar);
        for (int rep = 0; rep < ((PROBE_DUP & 32) ? 2 : 1); ++rep) {
            PHASE_FRAME();
            EpiScale E; E.ss = (const GAS float*)(ws + WS_SS); E.vT = nullptr; E.O0 = (GAS bf16_t*)(ws + WS_PROJ); E.ld0 = 2048; E.split = 2048; E.O1 = E.O0; E.ld1 = 2048;
            pg8::Gemm gm{(const bf16_t*)(ws + WS_HB), (const bf16_t*)((const GAS bf16_t*)(ws + WS_WPQ) + (size_t)layer * 2048 * 1024), BATCH * SEQ, 2048, 1024}; pg8::StaticOrder S; S.init(BATCH * SEQ, 2048, F.G, (int)blockIdx.x);
            { LAS float* RINV = (LAS float*)(F.lds + 131072); LAS int* PML = (LAS int*)(F.lds + 131072 + 4096);
              _Pragma("unroll") for (int q = 0; q < 4; ++q) { const int pmq = unit_pm_of(S, q); if (F.tid == 0) PML[q] = pmq;
                  if (pmq >= 0 && F.tid < 256) RINV[q * 256 + F.tid] = row_rinv((const GAS float*)(ws + WS_SS), pg8::tile_row(pmq) + F.tid); }
              __syncthreads(); E.rinv_lds = RINV; E.pm_lds = PML; }
            pg8::gemm_phase<EpiScale, pg8::StaticOrder>(glds, gm, S, E);
            gemm_tail<EpiScale>((const GAS bf16_t*)(ws + WS_HB), (const GAS bf16_t*)(ws + WS_WPQ) + (size_t)layer * 2048 * 1024, 2048, E, F.gw, F.NGW, F.lane, F.lds);
            if (rep == 0 && (PROBE_DUP & 32)) xcd_barrier(bar);
        }
        xcd_barrier(bar);
        for (int rep = 0; rep < ((PROBE_DUP & 64) ? 2 : 1); ++rep) { { PHASE_FRAME(); phase_peer_route(F, layer); } xcd_barrier(bar); }
        for (int rep = 0; rep < ((PROBE_DUP & (128 | 8192)) ? 2 : 1); ++rep) { { PHASE_FRAME(); phase_peer_u(F, layer, ((PROBE_DUP & 8192) && rep == 0) ? 0u : 0xffffu); } xcd_barrier(bar); }
        for (int rep = 0; rep < ((PROBE_DUP & 2048) ? 2 : 1); ++rep) { { PHASE_FRAME(); phase_peer_act(F); } xcd_barrier(bar); }
        if (PROBE_DUP & 4096) { { PHASE_FRAME(); phase_peer_v(F, layer, nullptr, DRY_OFF); } xcd_barrier(bar); }
        { PHASE_FRAME(); unsigned long long o_ = outu; asm volatile("" : "+s"(o_));
          phase_peer_v(F, layer, layer == 3 ? (float*)o_ : nullptr); }
        xcd_barrier(bar);
        if (PROBE_DUP & 256) { for (int rep = 0; rep < 8; ++rep) xcd_barrier(bar); }
    }
}

extern "C" void kernel_launch(void* const* d_in, const int* in_sizes, int n_in, void* d_out, int out_size, void* d_ws, size_t ws_size, hipStream_t stream) {
    static int grid = 0;
    if (grid == 0) {
        if (n_in != 17 || out_size != BATCH * SEQ * DM || ws_size < WS_END + (WS_PROJ - WS_H)) { fprintf(stderr, "kernel_launch: unexpected shapes (n_in %d out %d ws %zu need %zu)\n", n_in, out_size, ws_size, (size_t)WS_END); grid = -1; return; }
        int dev = 0, cus = 0, per_cu = 0;
        if (hipGetDevice(&dev) != hipSuccess || hipDeviceGetAttribute(&cus, hipDeviceAttributeMultiprocessorCount, dev) != hipSuccess) { grid = -1; return; }
        if (hipFuncSetAttribute((const void*)mk_fwd, hipFuncAttributeMaxDynamicSharedMemorySize, LDS_BYTES) != hipSuccess) { fprintf(stderr, "kernel_launch: hipFuncSetAttribute failed\n"); grid = -1; return; }
        if (hipOccupancyMaxActiveBlocksPerMultiprocessor(&per_cu, (const void*)mk_fwd, NT, LDS_BYTES) != hipSuccess || per_cu < 1) fprintf(stderr, "kernel_launch: occupancy query says %d blocks/CU\n", per_cu);
        (void)hipGetLastError();
        grid = cus;
    }
    if (grid < 0) return;
    if (hipMemsetAsync((char*)d_ws + WS_CTL, 0, 65536, stream) != hipSuccess) return;
    Args a{};
    for (int i = 0; i < 17; ++i) a.in[i] = (const float*)d_in[i];
    a.out = (float*)d_out; a.ws = (unsigned char*)d_ws;
    for (int i = 0; i < 16; ++i) a.inv32[i] = pow(500000.0, -(double)(2 * i) / 32.0);
    for (int i = 0; i < 8; ++i) a.inv16[i] = pow(500000.0, -(double)(2 * i) / 16.0);
    hipLaunchKernelGGL(mk_fwd, dim3(grid), dim3(NT), LDS_BYTES, stream, a);
}
```

```cpp
#include <hip/hip_runtime.h>
#include <cstdio>
#include <cmath>
#define LAS __attribute__((address_space(3)))
#define GAS __attribute__((address_space(1)))
typedef unsigned short bf16_t;
typedef short bf16x8 __attribute__((ext_vector_type(8)));
typedef short s16x4 __attribute__((ext_vector_type(4)));
typedef float f32x4 __attribute__((ext_vector_type(4)));
typedef float f32x2 __attribute__((ext_vector_type(2)));
typedef unsigned u32x4 __attribute__((ext_vector_type(4)));
typedef unsigned u32x2 __attribute__((ext_vector_type(2)));
typedef __bf16 bf16x2_t __attribute__((ext_vector_type(2)));
constexpr float U_SCALE = 1024.0f, V_SCALE = 256.0f, X_SCALE = 16.0f, Q_SCALE = 128.0f, K_SCALE = 16.0f, V8_SCALE = 16.0f, P8_SCALE = 256.0f, ACT_SCALE = 64.0f;

constexpr int BATCH = 4, SEQ = 4096, DM = 1024, NMETA = 16, TT = SEQ + NMETA  , TP = 4224, NR = BATCH * TP  ;
constexpr int HD = 128, TOPK = 256;
constexpr int ACOLS = 1860, ACOLS_P = 2048;
constexpr int NEXP = 16384;
constexpr float RMS_EPS = 1e-6f;
constexpr int NT = 512, NWAVES = 8;
constexpr int LDS_BYTES = 160 * 1024;
constexpr int MISC_OFF = LDS_BYTES - 64;
constexpr size_t CTL_XRANK = 16384;

constexpr size_t al256(size_t x) { return (x + 255) & ~(size_t)255; }
constexpr size_t WS_CTL   = 0;
constexpr size_t WS_WIN   = 65536;
constexpr size_t WS_WOA   = WS_WIN  + (size_t)2 * 2048 * 1024 * 2;
constexpr size_t WS_WKVQ  = WS_WOA  + (size_t)2 * 1024 * 1024 * 2;
constexpr size_t WS_WBQ1  = WS_WKVQ + (size_t)1536 * 1024 * 2;
constexpr size_t WS_WOB   = WS_WBQ1 + (size_t)1024 * 1024 * 2;
constexpr size_t WS_WPQ   = WS_WOB  + (size_t)2 * 1024 * 1024 * 2;
constexpr size_t WS_SK    = WS_WPQ  + (size_t)4 * 2048 * 1024 * 2;
constexpr size_t WS_ROPE32= WS_SK   + (size_t)4 * 2 * 128 * 128 * 2;
constexpr size_t WS_ROPE16= WS_ROPE32 + (size_t)TP * 16 * 8;
constexpr size_t WS_U     = al256(WS_ROPE16 + (size_t)TP * 8 * 8);
constexpr size_t WS_V     = WS_U    + (size_t)4 * NEXP * 1024 * 2;
constexpr size_t WS_H     = WS_V    + (size_t)4 * NEXP * 1024 * 2;
constexpr size_t WS_HB    = WS_H    + (size_t)NR * 1024 * 4;
constexpr size_t WS_SS    = WS_HB   + (size_t)NR * 1024 * 2;
constexpr size_t WS_PROJ  = WS_SS   + (size_t)NR * 16 * 4;
constexpr size_t WS_Q     = WS_PROJ + (size_t)NR * 2048 * 2;
constexpr size_t WS_KVA   = WS_Q    + (size_t)NR * 1024 * 2;
constexpr size_t WS_QI    = WS_KVA  + (size_t)NR * 512 * 2;
constexpr size_t WS_KI    = WS_QI   + (size_t)NR * 256 * 2;
constexpr size_t WS_WI    = WS_KI   + (size_t)NR * 64 * 2;
constexpr size_t WS_O     = WS_WI   + (size_t)NR * 4 * 4;
constexpr size_t WS_SKV   = WS_O    + (size_t)NR * 1024 * 2;
constexpr size_t WS_VT    = WS_SKV  + (size_t)NR * 512 * 2;
constexpr size_t WS_RID   = WS_VT   + (size_t)BATCH * 2 * 128 * TP * 2;
constexpr size_t WS_RG    = WS_RID  + (size_t)NR * 128 * 4;
constexpr size_t WS_SELG  = WS_RG   + (size_t)NR * 128 * 4;
constexpr size_t WS_ACT   = WS_SELG + (size_t)NR * 256 * 2;
constexpr size_t WS_PART  = WS_ACT  + (size_t)NR * 128 * 4;
constexpr size_t WS_HB8   = WS_PART + (size_t)16 * NR * 128 * 4;
constexpr size_t WS_RIDT  = WS_HB8  + (size_t)NR * 1024;
constexpr size_t WS_Q8    = WS_RIDT + (size_t)NR * 128 * 2;
constexpr size_t WS_K8    = WS_Q8   + (size_t)NR * 1024;
constexpr size_t WS_V8    = WS_K8   + (size_t)NR * 256;
constexpr size_t WS_END   = WS_V8   + (size_t)NR * 256;

__device__ __forceinline__ float bf2f(unsigned b) { return __uint_as_float(b << 16); }
__device__ __forceinline__ float bflo(unsigned w) { return __uint_as_float(w << 16); }
__device__ __forceinline__ float bfhi(unsigned w) { return __uint_as_float(w & 0xffff0000u); }
__device__ __forceinline__ unsigned f2bf(float f) { unsigned u = __float_as_uint(f); return (u + 0x7fffu + ((u >> 16) & 1u)) >> 16; }
__device__ __forceinline__ unsigned pk2(float lo, float hi) { bf16x2_t v; v[0] = (__bf16)lo; v[1] = (__bf16)hi; return __builtin_bit_cast(unsigned, v); }
__device__ __forceinline__ float fexp(float x) { return __builtin_amdgcn_exp2f(x * 1.4426950408889634f); }
__device__ __forceinline__ float flog(float x) { return __builtin_amdgcn_logf(x) * 0.6931471805599453f; }
__device__ __forceinline__ int lane_id_() { return (int)__builtin_amdgcn_mbcnt_hi(~0u, __builtin_amdgcn_mbcnt_lo(~0u, 0u)); }
__device__ __forceinline__ float wave_sum(float v) {
#pragma unroll
    for (int o = 1; o < 64; o <<= 1) v += __shfl_xor(v, o);
    return v;
}
__device__ __forceinline__ int wave_sum_dpp_i(int x) {
    x += __builtin_amdgcn_update_dpp(0, x, 0xB1, 0xf, 0xf, false);
    x += __builtin_amdgcn_update_dpp(0, x, 0x4E, 0xf, 0xf, false);
    x += __builtin_amdgcn_update_dpp(0, x, 0x141, 0xf, 0xf, false);
    x += __builtin_amdgcn_update_dpp(0, x, 0x140, 0xf, 0xf, false);
    return __builtin_amdgcn_readlane(x, 0) + __builtin_amdgcn_readlane(x, 16) + __builtin_amdgcn_readlane(x, 32) + __builtin_amdgcn_readlane(x, 48);
}
__device__ __forceinline__ float wave_sum_dpp_f(float x) {
#define DPPF_(v, ctrl) __builtin_bit_cast(float, __builtin_amdgcn_update_dpp(0, __builtin_bit_cast(int, v), ctrl, 0xf, 0xf, false))
    x += DPPF_(x, 0xB1); x += DPPF_(x, 0x4E); x += DPPF_(x, 0x141); x += DPPF_(x, 0x140);
#undef DPPF_
    const int xi = __builtin_bit_cast(int, x);
    return (__builtin_bit_cast(float, __builtin_amdgcn_readlane(xi, 0)) + __builtin_bit_cast(float, __builtin_amdgcn_readlane(xi, 16))) + (__builtin_bit_cast(float, __builtin_amdgcn_readlane(xi, 32)) + __builtin_bit_cast(float, __builtin_amdgcn_readlane(xi, 48)));
}
__device__ __forceinline__ float wave_max_dpp_f(float x) {
#define DPPF_(v, ctrl) __builtin_bit_cast(float, __builtin_amdgcn_update_dpp(0, __builtin_bit_cast(int, v), ctrl, 0xf, 0xf, false))
    x = fmaxf(x, DPPF_(x, 0xB1)); x = fmaxf(x, DPPF_(x, 0x4E)); x = fmaxf(x, DPPF_(x, 0x141)); x = fmaxf(x, DPPF_(x, 0x140));
#undef DPPF_
    const int xi = __builtin_bit_cast(int, x);
    return fmaxf(fmaxf(__builtin_bit_cast(float, __builtin_amdgcn_readlane(xi, 0)), __builtin_bit_cast(float, __builtin_amdgcn_readlane(xi, 16))), fmaxf(__builtin_bit_cast(float, __builtin_amdgcn_readlane(xi, 32)), __builtin_bit_cast(float, __builtin_amdgcn_readlane(xi, 48))));
}
__device__ __forceinline__ unsigned wave_min_dpp_u(unsigned x) {
#define DPPU_(v, ctrl) (unsigned)__builtin_amdgcn_update_dpp(0, (int)(v), ctrl, 0xf, 0xf, false)
    unsigned t; t = DPPU_(x, 0xB1); x = t < x ? t : x; t = DPPU_(x, 0x4E); x = t < x ? t : x; t = DPPU_(x, 0x141); x = t < x ? t : x; t = DPPU_(x, 0x140); x = t < x ? t : x;
    const unsigned a = (unsigned)__builtin_amdgcn_readlane((int)x, 0), b = (unsigned)__builtin_amdgcn_readlane((int)x, 16), c = (unsigned)__builtin_amdgcn_readlane((int)x, 32), d = (unsigned)__builtin_amdgcn_readlane((int)x, 48);
    const unsigned ab = a < b ? a : b, cd = c < d ? c : d; return ab < cd ? ab : cd;
}
__device__ __forceinline__ unsigned wave_max_dpp_u(unsigned x) {
    unsigned t; t = DPPU_(x, 0xB1); x = t > x ? t : x; t = DPPU_(x, 0x4E); x = t > x ? t : x; t = DPPU_(x, 0x141); x = t > x ? t : x; t = DPPU_(x, 0x140); x = t > x ? t : x;
    const unsigned a = (unsigned)__builtin_amdgcn_readlane((int)x, 0), b = (unsigned)__builtin_amdgcn_readlane((int)x, 16), c = (unsigned)__builtin_amdgcn_readlane((int)x, 32), d = (unsigned)__builtin_amdgcn_readlane((int)x, 48);
    const unsigned ab = a > b ? a : b, cd = c > d ? c : d; return ab > cd ? ab : cd;
#undef DPPU_
}
__device__ __forceinline__ unsigned mono_key(float s) { const unsigned u = __float_as_uint(s); return u ^ ((u >> 31) ? 0xFFFFFFFFu : 0x80000000u); }
__device__ __forceinline__ float unmono_key(unsigned k) { const unsigned u = (k >> 31) ? (k ^ 0x80000000u) : ~k; return __uint_as_float(u); }
__device__ __forceinline__ unsigned med3u(unsigned a, unsigned b, unsigned c) { unsigned r; asm("v_med3_u32 %0, %1, %2, %3" : "=v"(r) : "v"(a), "v"(b), "v"(c)); return r; }
__device__ __forceinline__ float dot2bf(unsigned a, unsigned b, float c) { return __builtin_amdgcn_fdot2_f32_bf16(__builtin_bit_cast(bf16x2_t, a), __builtin_bit_cast(bf16x2_t, b), c, false); }
#define MFMA16(a, b, c) __builtin_amdgcn_mfma_f32_16x16x32_bf16((a), (b), (c), 0, 0, 0)

#define XB_TMO      128
#define XB_XCNT(j)  (256  + 64 * (j))
#define XB_XSUB(j)  (1280 + 64 * (j))
#define XB_XGEN(j)  (2304 + 64 * (j))
#define XB_TOP      3328
#define XB_TOPGEN   3392
#define XCD_BAR_WORDS 3456
#define XB_SPIN_CAP (1u << 22)
__device__ __forceinline__ unsigned xb_ld(unsigned* p)              { return __hip_atomic_load((GAS unsigned*)p, __ATOMIC_RELAXED, __HIP_MEMORY_SCOPE_AGENT); }
__device__ __forceinline__ unsigned xb_add(unsigned* p, unsigned v) { return __hip_atomic_fetch_add((GAS unsigned*)p, v, __ATOMIC_RELAXED, __HIP_MEMORY_SCOPE_AGENT); }
__device__ __forceinline__ unsigned xb_xcc_id() { return (unsigned)__builtin_amdgcn_s_getreg((3 << 11) | 20) & 0xFu; }
#define XB_SPIN(cond, bar) do { unsigned _sp = 0; while (cond) { __builtin_amdgcn_s_sleep(1); \
    if ((++_sp & 255u) == 0u) { if (xb_ld(&(bar)[XB_TMO])) break; if (_sp > XB_SPIN_CAP) { xb_add(&(bar)[XB_TMO], 1u); break; } } } } while (0)
struct XcdBarrier { unsigned* bar; unsigned x; volatile LAS unsigned* st; };
__device__ __forceinline__ XcdBarrier xcd_barrier_post(unsigned* bar, volatile LAS unsigned* st) {
    XcdBarrier b; b.bar = bar; b.x = xb_xcc_id(); b.st = st;
    if (threadIdx.x == 0) (void)xb_add(&bar[XB_XCNT(b.x)], 1u);
    return b;
}
__device__ __forceinline__ void xcd_barrier_complete(unsigned* bar, unsigned x, unsigned& nloc, unsigned& nx) {
    const unsigned G = gridDim.x * gridDim.y * gridDim.z;
    unsigned sum, cnt, mine, sp = 0u;
    for (;;) {
        sum = 0u; cnt = 0u; mine = 0u;
#pragma unroll
        for (unsigned j = 0; j < 16; ++j) { const unsigned c = xb_ld(&bar[XB_XCNT(j)]); sum += c; cnt += (c > 0u) ? 1u : 0u; mine = (j == x) ? c : mine; }
        if (sum == G) break;
        __builtin_amdgcn_s_sleep(1);
        if ((++sp & 255u) == 0u) { if (xb_ld(&bar[XB_TMO])) break; if (sp > XB_SPIN_CAP) { xb_add(&bar[XB_TMO], 1u); break; } }
    }
    nloc = mine > 0u ? mine : 1u; nx = cnt > 0u ? cnt : 1u;
}
__device__ __forceinline__ void xcd_barrier(const XcdBarrier& b) {
    asm volatile("s_waitcnt vmcnt(0)" ::: "memory");
    __syncthreads();
    if (threadIdx.x == 0) {
        unsigned* bar = b.bar;
        __builtin_amdgcn_s_waitcnt(0);
        unsigned nloc = b.st[0], nx = b.st[1];
        if (nloc == 0u) { xcd_barrier_complete(bar, b.x, nloc, nx); b.st[0] = nloc; b.st[1] = nx; }
        const unsigned old = xb_add(&bar[XB_XSUB(b.x)], 1u);
        const unsigned gen = old / nloc;
        if (old + 1u == (gen + 1u) * nloc) {
            __builtin_amdgcn_fence(__ATOMIC_RELEASE, "agent");
            asm volatile("s_waitcnt vmcnt(0)" ::: "memory");
            const unsigned og = xb_add(&bar[XB_TOP], 1u);
            const unsigned tg = og / nx;
            if (og + 1u == (tg + 1u) * nx) xb_add(&bar[XB_TOPGEN], 1u);
            else XB_SPIN(xb_ld(&bar[XB_TOPGEN]) == tg, bar);
            __builtin_amdgcn_fence(__ATOMIC_ACQUIRE, "agent");
            xb_add(&bar[XB_XGEN(b.x)], 1u);
            asm volatile("s_waitcnt vmcnt(0)" ::: "memory");
        } else {
            XB_SPIN(xb_ld(&bar[XB_XGEN(b.x)]) == gen, bar);
            __builtin_amdgcn_fence(__ATOMIC_ACQUIRE, "agent");
            asm volatile("s_waitcnt vmcnt(0)" ::: "memory");
        }
    }
    __syncthreads();
}
namespace pg8 {
#define PG8_LAS __attribute__((address_space(3)))
typedef unsigned short bf16_t;
typedef short bf16x8 __attribute__((ext_vector_type(8)));
typedef float f32x4 __attribute__((ext_vector_type(4)));
typedef unsigned u32x4 __attribute__((ext_vector_type(4)));
constexpr int BM = 256, BK = 64, HALF = 128, HTB = HALF * BK * 2  , STAGE_BYTES = 8 * HTB, NXCD = 8, WGM = 8;

__host__ __device__ __forceinline__ int lds_byte(int r, int c) { const int st = (r >> 4) * 2 + (c >> 5), rr = r & 15, cc = c & 31, ob = rr * 64 + cc * 2; return st * 1024 + (ob ^ (((ob >> 9) & 1) << 5)); }
__host__ __device__ __forceinline__ void stage_rc(int b, int& R, int& C) { const int st = b / 1024, sb = b % 1024, swz = sb ^ (((sb >> 9) & 1) << 5); R = (st >> 1) * 16 + swz / 64; C = (st & 1) * 32 + (swz % 64) / 2; }
__host__ __device__ __forceinline__ int perm32(int rho) { const int n = rho >> 4, i = rho & 15; return 8 * (i >> 2) + 4 * n + (i & 3); }

__host__ __device__ __forceinline__ int tile_row(int pm) { return (pm >> 4) * 4224 + 16 + (pm & 15) * 256; }
struct Unit { int pm, pn; };
struct Gemm { const bf16_t* A; const bf16_t* Bt; int M, N, K; };

struct StaticOrder {
    int nM, nN, nwg, G, c;
    __host__ __device__ void init(int M, int N, int G_, int c_) { nM = M / BM; nN = N / BM; nwg = nM * nN; G = G_; c = c_; }
    __host__ __device__ bool next(int i, Unit& u) const {
        const long L = (long)i * G + c; if (L >= nwg) return false;
        int wgid = (int)L; { const int q = nwg / NXCD, r = nwg % NXCD, xcd = wgid % NXCD, off = wgid / NXCD; wgid = (xcd < r ? xcd * (q + 1) : r * (q + 1) + (xcd - r) * q) + off; }
        const int nig = WGM * nN, gid = wgid / nig, fm = gid * WGM, gsz = (nM - fm) < WGM ? (nM - fm) : WGM;
        u.pm = fm + ((wgid % nig) % gsz); u.pn = (wgid % nig) / gsz; return true;
    }
    __device__ __forceinline__ void a_ready(const Unit&) const {}
    __device__ __forceinline__ void done(const Unit&) const {}
};
__device__ __forceinline__ unsigned cvt_pk_bf16(float lo, float hi) { unsigned r; asm volatile("v_cvt_pk_bf16_f32 %0, %1, %2" : "=v"(r) : "v"(lo), "v"(hi)); return r; }
template <class Epi, class Sched>
__device__ __forceinline__ void gemm_phase(PG8_LAS unsigned char* lds, const Gemm g, const Sched& S, const Epi& E) {
    int tid_l = threadIdx.x; asm volatile("" : "+v"(tid_l));
    const int tid = tid_l, wid = __builtin_amdgcn_readfirstlane(tid >> 6), lane = tid & 63, wr = wid >> 2, wc = wid & 3, fr = lane & 15, fq = lane >> 4;
    const int K = g.K, nt = K / BK;
    unsigned voffA[2], voffB[2];
#pragma unroll
    for (int i = 0; i < 2; ++i) { int R, C; stage_rc(tid * 16 + i * 8192, R, C); const int Rb = Epi::PERM ? ((R & ~31) + perm32(R & 31)) : R;
        voffA[i] = (unsigned)(R * K + C) * 2u; voffB[i] = (unsigned)(Rb * K + C) * 2u; }
    const size_t kstep = (size_t)(BK * 2);
    const size_t hstep = (size_t)HALF * K * 2;
    const size_t tstep = 2 * hstep;
    const unsigned ldsw = (unsigned)wid * 1024u;
    const int aoff = lds_byte(wr * 64 + fr, fq * 8), boff = lds_byte(wc * 32 + fr, fq * 8);
#define PG8_SA(b, h) (((b) * 2 + (h)) * HTB)
#define PG8_SB(b, h) ((4 + (b) * 2 + (h)) * HTB)
#define PG8_STAGE(bufoff, gbase, voff) do { _Pragma("unroll") for (int _i = 0; _i < 2; ++_i) \
        __builtin_amdgcn_global_load_lds((const unsigned*)((const char*)(gbase) + (voff)[_i]), (PG8_LAS unsigned*)(lds + (bufoff) + ldsw + _i * 8192), 16, 0, 0); } while (0)
#define PG8_LDA(dst, b, h) do { _Pragma("unroll") for (int m = 0; m < 4; ++m) _Pragma("unroll") for (int k = 0; k < 2; ++k) dst[m][k] = *(const PG8_LAS bf16x8*)(lds + PG8_SA(b, h) + aoff + m * 2048 + k * 1024); } while (0)
#define PG8_LDB(dst, b, h) do { _Pragma("unroll") for (int n = 0; n < 2; ++n) _Pragma("unroll") for (int k = 0; k < 2; ++k) dst[n][k] = *(const PG8_LAS bf16x8*)(lds + PG8_SB(b, h) + boff + n * 2048 + k * 1024); } while (0)
#define PG8_MMA(ai, bj, At, Bt) do { __builtin_amdgcn_s_setprio(1); _Pragma("unroll") for (int m = 0; m < 4; ++m) _Pragma("unroll") for (int n = 0; n < 2; ++n) _Pragma("unroll") for (int k = 0; k < 2; ++k) \
        acc[ai][bj][m][n] = __builtin_amdgcn_mfma_f32_16x16x32_bf16(Bt[n][k], At[m][k], acc[ai][bj][m][n], 0, 0, 0); __builtin_amdgcn_s_setprio(0); } while (0)
#define PG8_WAIT_V(n) asm volatile("s_waitcnt vmcnt(" #n ")" ::: "memory")
#define PG8_WAIT_L(n) asm volatile("s_waitcnt lgkmcnt(" #n ")" ::: "memory")
#define PG8_BAR __builtin_amdgcn_s_barrier()
#define PG8_SCHED __builtin_amdgcn_sched_barrier(0)
    Unit cur, nxt; int ui = 0;
    if (!S.next(0, cur)) return;
    f32x4 acc[2][2][4][2];
#pragma unroll
    for (int a = 0; a < 2; ++a)
#pragma unroll
        for (int b = 0; b < 2; ++b)
#pragma unroll
            for (int m = 0; m < 4; ++m)
#pragma unroll
                for (int n = 0; n < 2; ++n) acc[a][b][m][n] = (f32x4){0.f, 0.f, 0.f, 0.f};
    bf16x8 At[4][2], B0[2][2], B1[2][2];
    const char* cA = (const char*)g.A + (size_t)tile_row(cur.pm) * K * 2; const char* cB = (const char*)g.Bt + (size_t)cur.pn * tstep;
    S.a_ready(cur);
    PG8_STAGE(PG8_SB(0, 0), cB, voffB); PG8_STAGE(PG8_SA(0, 0), cA, voffA); PG8_STAGE(PG8_SB(0, 1), cB + hstep, voffB); PG8_STAGE(PG8_SA(0, 1), cA + hstep, voffA);
    if (wr == 1) PG8_BAR;
    PG8_WAIT_V(4); PG8_BAR;
    PG8_STAGE(PG8_SB(1, 0), cB + kstep, voffB); PG8_STAGE(PG8_SA(1, 0), cA + kstep, voffA); PG8_STAGE(PG8_SB(1, 1), cB + hstep + kstep, voffB);
    PG8_WAIT_V(6); PG8_BAR;
    for (;;) {
        const bool has_next = S.next(ui + 1, nxt);
        const char* nA = has_next ? (const char*)g.A + (size_t)tile_row(nxt.pm) * K * 2 : cA; const char* nB = has_next ? (const char*)g.Bt + (size_t)nxt.pn * tstep : cB;
        for (int t = 0; t < nt; t += 2) {
            const bool last = (t == nt - 2);
            const char* a1 = cA + (size_t)(t + 1) * kstep;
            const char* a2 = last ? nA : cA + (size_t)(t + 2) * kstep; const char* b2 = last ? nB : cB + (size_t)(t + 2) * kstep;
            const char* a3 = a2 + kstep; const char* b3 = b2 + kstep;
            if (last && has_next) S.a_ready(nxt);
            PG8_LDB(B0, 0, 0); PG8_SCHED; PG8_LDA(At, 0, 0); PG8_STAGE(PG8_SA(1, 1), a1 + hstep, voffA);
            PG8_WAIT_L(8); PG8_BAR; PG8_WAIT_L(0); PG8_MMA(0, 0, At, B0); PG8_BAR; PG8_SCHED;
            PG8_LDB(B1, 0, 1); PG8_STAGE(PG8_SB(0, 0), b2, voffB);
            PG8_BAR; PG8_WAIT_L(0); PG8_MMA(0, 1, At, B1); PG8_BAR;
            PG8_LDA(At, 0, 1); PG8_STAGE(PG8_SA(0, 0), a2, voffA);
            PG8_BAR; PG8_WAIT_L(0); PG8_MMA(1, 0, At, B0); PG8_BAR; PG8_SCHED;
            PG8_STAGE(PG8_SB(0, 1), b2 + hstep, voffB);
            PG8_WAIT_V(6); PG8_BAR; PG8_MMA(1, 1, At, B1); PG8_BAR;
            PG8_LDB(B0, 1, 0); PG8_SCHED; PG8_LDA(At, 1, 0); PG8_STAGE(PG8_SA(0, 1), a2 + hstep, voffA);
            PG8_WAIT_L(8); PG8_BAR; PG8_WAIT_L(0); PG8_MMA(0, 0, At, B0); PG8_BAR; PG8_SCHED;
            PG8_LDB(B1, 1, 1); PG8_STAGE(PG8_SB(1, 0), b3, voffB);
            PG8_BAR; PG8_WAIT_L(0); PG8_MMA(0, 1, At, B1); PG8_BAR;
            PG8_LDA(At, 1, 1); PG8_STAGE(PG8_SA(1, 0), a3, voffA);
            PG8_BAR; PG8_WAIT_L(0); PG8_MMA(1, 0, At, B0); PG8_BAR; PG8_SCHED;
            PG8_STAGE(PG8_SB(1, 1), b3 + hstep, voffB);
            PG8_WAIT_V(6); PG8_BAR; PG8_MMA(1, 1, At, B1); PG8_BAR;
        }
        if constexpr (!Epi::AFTER_DRAIN) { E(acc, cur, wr, wc, fr, fq); S.done(cur); }
        if (!has_next) break;
#pragma unroll
        for (int a = 0; a < 2; ++a)
#pragma unroll
            for (int b = 0; b < 2; ++b)
#pragma unroll
                for (int m = 0; m < 4; ++m)
#pragma unroll
                    for (int n = 0; n < 2; ++n) acc[a][b][m][n] = (f32x4){0.f, 0.f, 0.f, 0.f};
        cur = nxt; cA = nA; cB = nB; ++ui;
    }
    PG8_WAIT_V(0);
    if (wr == 0) PG8_BAR;
    PG8_BAR;
    if constexpr (Epi::AFTER_DRAIN) { E.fused(acc, cur, wr, wc, fr, fq, lds, wid, lane); S.done(cur); }
#undef PG8_SA
#undef PG8_SB
#undef PG8_STAGE
#undef PG8_LDA
#undef PG8_LDB
#undef PG8_MMA
#undef PG8_WAIT_V
#undef PG8_WAIT_L
#undef PG8_BAR
#undef PG8_SCHED
}
}
__device__ __forceinline__ float row_rinv(const GAS float* ss, int row) {
    const GAS f32x4* p = (const GAS f32x4*)(ss + (size_t)row * 16);
    const f32x4 a = p[0], b = p[1], c = p[2], d = p[3];
    const float s = ((a[0] + a[1]) + (a[2] + a[3])) + ((b[0] + b[1]) + (b[2] + b[3])) + ((c[0] + c[1]) + (c[2] + c[3])) + ((d[0] + d[1]) + (d[2] + d[3]));
    return __builtin_amdgcn_rsqf(s * (1.0f / 1024.0f) + RMS_EPS);
}
__device__ __forceinline__ unsigned pkh2(float lo, float hi) { const _Float16 a = (_Float16)lo, b = (_Float16)hi; return (unsigned)__builtin_bit_cast(unsigned short, a) | ((unsigned)__builtin_bit_cast(unsigned short, b) << 16); }
struct EpiScale {
    static constexpr bool PERM = true, AFTER_DRAIN = false;
    GAS bf16_t* O0; int ld0; int split; GAS bf16_t* O1; int ld1; const GAS float* ss; GAS bf16_t* vT;
    bool f16 = false;
    const LAS float* rinv_lds; const LAS int* pm_lds;
    __device__ __forceinline__ void operator()(const f32x4 (&acc)[2][2][4][2], const pg8::Unit& u, int wr, int wc, int fr, int fq) const {
        asm volatile("" : "+v"(fr), "+v"(fq));
        const int row0 = pg8::tile_row(u.pm) + wr * 64 + fr; const int colt = u.pn * 256;
        GAS bf16_t* base; int ldc, c0;
        if (colt < split) { base = O0; ldc = ld0; c0 = colt; } else { base = O1; ldc = ld1; c0 = colt - split; }
        const int col0 = c0 + wc * 32 + 8 * fq;
        const bool dovt = (vT != nullptr) && (colt == 256);
        int uslot = 0;
#pragma unroll
        for (int q = 1; q < 4; ++q) if (pm_lds[q] == u.pm && pm_lds[0] != u.pm) uslot = (uslot == 0) ? q : uslot;
#pragma unroll
        for (int ai = 0; ai < 2; ++ai)
#pragma unroll
            for (int m = 0; m < 4; ++m) {
                const int row = row0 + ai * 128 + m * 16;
                const float ri = rinv_lds[uslot * 256 + wr * 64 + fr + ai * 128 + m * 16];
                GAS bf16_t* rowp = base + (size_t)row * ldc + col0;
#pragma unroll
                for (int bj = 0; bj < 2; ++bj) {
                    const f32x4 v0 = acc[ai][bj][m][0] * ri, v1 = acc[ai][bj][m][1] * ri;
                    u32x4 w;
                    if (f16) { w.x = pkh2(v0[0], v0[1]); w.y = pkh2(v0[2], v0[3]); w.z = pkh2(v1[0], v1[1]); w.w = pkh2(v1[2], v1[3]); }
                    else { w.x = pk2(v0[0], v0[1]); w.y = pk2(v0[2], v0[3]); w.z = pk2(v1[0], v1[1]); w.w = pk2(v1[2], v1[3]); }
                    *(GAS u32x4*)(rowp + bj * 128) = w;
                    if (dovt) {
                        const int b = row / TP, t = row - b * TP;
                        GAS bf16_t* vp = vT + ((size_t)(b * 2 + bj) * 128 + wc * 32 + 8 * fq) * TP + t;
                        vp[0 * TP] = (bf16_t)(w.x & 0xffff); vp[1 * TP] = (bf16_t)(w.x >> 16); vp[2 * TP] = (bf16_t)(w.y & 0xffff); vp[3 * TP] = (bf16_t)(w.y >> 16);
                        vp[4 * TP] = (bf16_t)(w.z & 0xffff); vp[5 * TP] = (bf16_t)(w.z >> 16); vp[6 * TP] = (bf16_t)(w.w & 0xffff); vp[7 * TP] = (bf16_t)(w.w >> 16);
                    }
                }
            }
    }
    struct TailPre { float v[4]; };
    __device__ __forceinline__ void tail_pre(TailPre& P, int b, int ng, int lane) const {
#pragma unroll
        for (int i = 0; i < 4; ++i) P.v[i] = ss[(size_t)(b * TP + 4 * (lane >> 4) + i) * 16 + (lane & 15)];
    }
    __device__ __forceinline__ void tail(const f32x4 (&acc)[4], int b, int ng, int lane, const TailPre& P) const {
        const int colt = (ng * 64) & ~255; GAS bf16_t* base; int ldc, c0;
        if (colt < split) { base = O0; ldc = ld0; c0 = ng * 64; } else { base = O1; ldc = ld1; c0 = ng * 64 - split; }
        const bool dovt = (vT != nullptr) && (colt == 256);
#pragma unroll
        for (int i = 0; i < 4; ++i) {
            const int t = 4 * (lane >> 4) + i, row = b * TP + t; float sq = P.v[i];
            sq += __shfl_xor(sq, 1); sq += __shfl_xor(sq, 2); sq += __shfl_xor(sq, 4); sq += __shfl_xor(sq, 8);
            const float ri = __builtin_amdgcn_rsqf(sq * (1.0f / 1024.0f) + RMS_EPS);
#pragma unroll
            for (int nt = 0; nt < 4; ++nt) {
                const int col = c0 + nt * 16 + (lane & 15); const bf16_t w = f16 ? (bf16_t)(pkh2(acc[nt][i] * ri, 0.f) & 0xffffu) : (bf16_t)f2bf(acc[nt][i] * ri);
                base[(size_t)row * ldc + col] = w;
                if (dovt) { const int vc = ng * 64 - 256 + nt * 16 + (lane & 15); vT[((size_t)(b * 2 + (vc >> 7)) * 128 + (vc & 127)) * TP + t] = w; }
            }
        }
    }
};
struct EpiResid {
    static constexpr bool PERM = true, AFTER_DRAIN = false;
    GAS float* H; GAS bf16_t* HB; GAS float* ss; GAS unsigned char* HB8;
    __device__ __forceinline__ void operator()(const f32x4 (&acc)[2][2][4][2], const pg8::Unit& u, int wr, int wc, int fr, int fq) const {
        asm volatile("" : "+v"(fr), "+v"(fq));
        const int row0 = pg8::tile_row(u.pm) + wr * 64 + fr, col0 = u.pn * 256 + wc * 32 + 8 * fq;
        u32x4 hn[2];
#pragma unroll
        for (int bj = 0; bj < 2; ++bj) hn[bj] = *(const GAS u32x4*)(HB + (size_t)row0 * 1024 + col0 + bj * 128);
#pragma unroll
        for (int gi = 0; gi < 8; ++gi) {
            const int ai = gi >> 2, m = gi & 3;
            const int row = row0 + ai * 128 + m * 16; float s = 0.f;
            GAS bf16_t* bp = HB + (size_t)row * 1024 + col0;
            u32x4 hc[2];
#pragma unroll
            for (int bj = 0; bj < 2; ++bj) hc[bj] = hn[bj];
            if (gi < 7) { const int rown = row0 + ((gi + 1) >> 2) * 128 + ((gi + 1) & 3) * 16;
#pragma unroll
                for (int bj = 0; bj < 2; ++bj) hn[bj] = *(const GAS u32x4*)(HB + (size_t)rown * 1024 + col0 + bj * 128); }
#pragma unroll
            for (int bj = 0; bj < 2; ++bj) {
                const u32x4 hw = hc[bj];
                f32x4 h0 = acc[ai][bj][m][0], h1 = acc[ai][bj][m][1];
                h0[0] += __builtin_bit_cast(float, hw.x << 16); h0[1] += __builtin_bit_cast(float, hw.x & 0xffff0000u); h0[2] += __builtin_bit_cast(float, hw.y << 16); h0[3] += __builtin_bit_cast(float, hw.y & 0xffff0000u);
                h1[0] += __builtin_bit_cast(float, hw.z << 16); h1[1] += __builtin_bit_cast(float, hw.z & 0xffff0000u); h1[2] += __builtin_bit_cast(float, hw.w << 16); h1[3] += __builtin_bit_cast(float, hw.w & 0xffff0000u);
                s += ((h0[0] * h0[0] + h0[1] * h0[1]) + (h0[2] * h0[2] + h0[3] * h0[3])) + ((h1[0] * h1[0] + h1[1] * h1[1]) + (h1[2] * h1[2] + h1[3] * h1[3]));
                u32x4 w; w.x = pk2(h0[0], h0[1]); w.y = pk2(h0[2], h0[3]); w.z = pk2(h1[0], h1[1]); w.w = pk2(h1[2], h1[3]);
                *(GAS u32x4*)(bp + bj * 128) = w;
                { int wa = __builtin_amdgcn_cvt_pk_fp8_f32(__builtin_amdgcn_fmed3f(h0[0] * X_SCALE, -416.f, 416.f), __builtin_amdgcn_fmed3f(h0[1] * X_SCALE, -416.f, 416.f), 0, false);
                  wa = __builtin_amdgcn_cvt_pk_fp8_f32(__builtin_amdgcn_fmed3f(h0[2] * X_SCALE, -416.f, 416.f), __builtin_amdgcn_fmed3f(h0[3] * X_SCALE, -416.f, 416.f), wa, true);
                  int wb = __builtin_amdgcn_cvt_pk_fp8_f32(__builtin_amdgcn_fmed3f(h1[0] * X_SCALE, -416.f, 416.f), __builtin_amdgcn_fmed3f(h1[1] * X_SCALE, -416.f, 416.f), 0, false);
                  wb = __builtin_amdgcn_cvt_pk_fp8_f32(__builtin_amdgcn_fmed3f(h1[2] * X_SCALE, -416.f, 416.f), __builtin_amdgcn_fmed3f(h1[3] * X_SCALE, -416.f, 416.f), wb, true);
                  *(GAS u32x2*)(HB8 + (size_t)row * 1024 + col0 + bj * 128) = (u32x2){(unsigned)wa, (unsigned)wb}; }
            }
            s += __shfl_xor(s, 16); s += __shfl_xor(s, 32);
            if (fq == 0) ss[(size_t)row * 16 + u.pn * 4 + wc] = s;
        }
    }
    struct TailPre { unsigned v[16]; };
    __device__ __forceinline__ void tail_pre(TailPre& P, int b, int ng, int lane) const {
#pragma unroll
        for (int i = 0; i < 4; ++i)
#pragma unroll
            for (int nt = 0; nt < 4; ++nt) P.v[i * 4 + nt] = (unsigned)HB[(size_t)(b * TP + 4 * (lane >> 4) + i) * 1024 + ng * 64 + nt * 16 + (lane & 15)];
    }
    __device__ __forceinline__ void tail(const f32x4 (&acc)[4], int b, int ng, int lane, const TailPre& P) const {
#pragma unroll
        for (int i = 0; i < 4; ++i) {
            const int t = 4 * (lane >> 4) + i, row = b * TP + t; float s = 0.f;
#pragma unroll
            for (int nt = 0; nt < 4; ++nt) {
                const int col = ng * 64 + nt * 16 + (lane & 15); const size_t o = (size_t)row * 1024 + col;
                const float hv = bf2f(P.v[i * 4 + nt]) + acc[nt][i]; HB[o] = (bf16_t)f2bf(hv); s += hv * hv;
                { const int w8 = __builtin_amdgcn_cvt_pk_fp8_f32(__builtin_amdgcn_fmed3f(hv * X_SCALE, -416.f, 416.f), 0.f, 0, false); HB8[o] = (unsigned char)(w8 & 0xff); }
            }
            s += __shfl_xor(s, 1); s += __shfl_xor(s, 2); s += __shfl_xor(s, 4); s += __shfl_xor(s, 8);
            if ((lane & 15) == 0) ss[(size_t)row * 16 + ng] = s;
        }
    }
};

__device__ __forceinline__ int unit_pm_of(const pg8::StaticOrder& S, int i) {
    const long L = (long)i * S.G + S.c; if (L >= S.nwg) return -1;
    int wgid = (int)L; { const int q = S.nwg / pg8::NXCD, r = S.nwg % pg8::NXCD, xcd = wgid % pg8::NXCD, off = wgid / pg8::NXCD; wgid = (xcd < r ? xcd * (q + 1) : r * (q + 1) + (xcd - r) * q) + off; }
    const int nig = pg8::WGM * S.nN, gid = wgid / nig, fm = gid * pg8::WGM, gsz = (S.nM - fm) < pg8::WGM ? (S.nM - fm) : pg8::WGM;
    return fm + ((wgid % nig) % gsz);
}
template <class Epi>
__device__ __forceinline__ void gemm_tail(const GAS bf16_t* A, const GAS bf16_t* Bt, int N, const Epi& E, int gw, int NGW, int lane, LAS unsigned char* lds) {
    const int r = lane & 15, g = lane >> 4, njobs = BATCH * (N / 64);
    const int G_ = NGW / NWAVES, wv_ = gw % NWAVES, bk_ = G_ - 1 - gw / NWAVES;
    LAS unsigned char* PAN = lds + wv_ * 13056;
    LAS f32x4* RED = (LAS f32x4*)(lds + 8 * 13056);
#pragma unroll 1
    for (int job = bk_; job < njobs; job += G_) {
        const int b = job & 3, ng = job >> 2;
        const GAS bf16_t* ap = A + ((size_t)b * TP + g) * 1024 + wv_ * 128 + 8 * r; const GAS bf16_t* bp = Bt + ((size_t)ng * 64 + g) * 1024 + wv_ * 128 + 8 * r;
        typename Epi::TailPre pre; E.tail_pre(pre, b, ng, lane);
        u32x4 la[4], lb[16];
#pragma unroll
        for (int u = 0; u < 4; ++u) la[u] = *(const GAS u32x4*)(ap + (size_t)(4 * u) * 1024);
#pragma unroll
        for (int u = 0; u < 16; ++u) lb[u] = *(const GAS u32x4*)(bp + (size_t)(4 * u) * 1024);
#pragma unroll
        for (int u = 0; u < 4; ++u) *(LAS u32x4*)(PAN + (4 * u + g) * 272 + 16 * r) = la[u];
        f32x4 acc[4];
#pragma unroll
        for (int hf = 0; hf < 2; ++hf) {
#pragma unroll
            for (int u = 0; u < 8; ++u) *(LAS u32x4*)(PAN + (16 + 4 * u + g) * 272 + 16 * r) = lb[8 * hf + u];
#pragma unroll
            for (int n2 = 0; n2 < 2; ++n2) { f32x4 d = (f32x4){0.f, 0.f, 0.f, 0.f};
#pragma unroll
                for (int ks = 0; ks < 4; ++ks) d = MFMA16(*(const LAS bf16x8*)(PAN + r * 272 + 16 * g + 64 * ks), *(const LAS bf16x8*)(PAN + (16 + 16 * n2 + r) * 272 + 16 * g + 64 * ks), d);
                acc[2 * hf + n2] = d; }
        }
#pragma unroll
        for (int nt = 0; nt < 4; ++nt) RED[(wv_ * 4 + nt) * 64 + lane] = acc[nt];
        __syncthreads();
        if (wv_ == 0) {
#pragma unroll
            for (int nt = 0; nt < 4; ++nt) {
#pragma unroll
                for (int w = 1; w < 8; ++w) acc[nt] += RED[(w * 4 + nt) * 64 + lane];
            }
            E.tail(acc, b, ng, lane, pre);
        }
        __syncthreads();
    }
}

struct Args {
    const float* in[17]; float* out; unsigned char* ws;
    double inv32[16]; double inv16[8];
};
struct Frame {
    LAS unsigned char* lds; GAS unsigned char* ws; int tid, lane, wave, G, gw, NGW;
};

__device__ __forceinline__ void p0_transpose_item(const float* W, int N, const float* gain, GAS bf16_t* WT, LAS float* scr, int item, int lane, int nblk) {
    const int kb = item / nblk, nb = item - kb * nblk, k0 = 64 * kb, n0 = 32 * nb;
    const int n = n0 + (lane & 31);
    const int nc = n < N ? n : N - 1; const float* gp = gain ? gain : W;
    float vv[32], gg[32];
#pragma unroll
    for (int i = 0; i < 32; ++i) { const int kk = 2 * i + (lane >> 5); vv[i] = W[(size_t)(k0 + kk) * N + nc]; gg[i] = gp[k0 + kk]; }
#pragma unroll
    for (int i = 0; i < 32; ++i) { const int kk = 2 * i + (lane >> 5); scr[kk * 33 + (lane & 31)] = (n < N) ? vv[i] * (gain ? gg[i] : 1.0f) : 0.f; }
    asm volatile("s_waitcnt lgkmcnt(0)" ::: "memory");
    const int c = lane & 7;
#pragma unroll
    for (int j = 0; j < 4; ++j) { const int nn = (lane >> 3) + 8 * j; const LAS float* s = scr + (8 * c) * 33 + nn;
        u32x4 o; o.x = pk2(s[0 * 33], s[1 * 33]); o.y = pk2(s[2 * 33], s[3 * 33]); o.z = pk2(s[4 * 33], s[5 * 33]); o.w = pk2(s[6 * 33], s[7 * 33]);
        *(GAS u32x4*)(WT + (size_t)(n0 + nn) * 1024 + k0 + 8 * c) = o; }
    asm volatile("s_waitcnt lgkmcnt(0)" ::: "memory");
}
__device__ __forceinline__ void sincos_rev(double ang, float& c, float& s) {
    double rev = ang * 0.15915494309189533577; rev -= rint(rev);
    const double r = rev * 6.28318530717958647692, r2 = r * r;
    double ts = r, ss = r, tc = 1.0, cc = 1.0;
#pragma unroll
    for (int k = 1; k <= 13; ++k) { tc *= -r2 / (double)((2 * k - 1) * (2 * k)); cc += tc; ts *= -r2 / (double)((2 * k) * (2 * k + 1)); ss += ts; }
    c = (float)cc; s = (float)ss;
}
constexpr int P0_I2048 = 16 * 64, P0_I1024 = 16 * 32, P0_I512 = 16 * 16;
constexpr int P0_NITEMS = 2 * P0_I2048 + 2 * P0_I1024 + P0_I512 + P0_I1024 + P0_I1024 + 2 * P0_I1024;
constexpr int P0_DEF0 = 2 * P0_I2048 + 2 * P0_I1024 + P0_I512 + P0_I1024, P0_DEF1 = P0_NITEMS - P0_I1024;
__device__ __forceinline__ void p0_weight_item(const Frame& F, const Args& a, int it) {
    GAS unsigned char* ws = F.ws;
    LAS float* scr = (LAS float*)(F.lds + F.wave * 8704);
    const float* a_norm = a.in[2]; const float* a_w_in = a.in[3]; const float* a_w_o = a.in[6]; const float* kv_norm = a.in[7]; const float* kv_w = a.in[8];
    const float* b_norm = a.in[9]; const float* b_w_q = a.in[10]; const float* b_w_o = a.in[11];
    constexpr int I2048 = P0_I2048, I1024 = P0_I1024, I512 = P0_I512;
    int r = it;
    if (r < 2 * I2048) { const int l = r / I2048; r -= l * I2048; p0_transpose_item(a_w_in + (size_t)l * 1024 * ACOLS, ACOLS, a_norm + l * 1024, (GAS bf16_t*)(ws + WS_WIN) + (size_t)l * 2048 * 1024, scr, r, F.lane, 64); return; } r -= 2 * I2048;
    if (r < 2 * I1024) { const int l = r / I1024; r -= l * I1024; p0_transpose_item(a_w_o + (size_t)l * 1024 * 1024, 1024, nullptr, (GAS bf16_t*)(ws + WS_WOA) + (size_t)l * 1024 * 1024, scr, r, F.lane, 32); return; } r -= 2 * I1024;
    if (r < I512) { p0_transpose_item(kv_w, 512, kv_norm, (GAS bf16_t*)(ws + WS_WKVQ), scr, r, F.lane, 16); return; } r -= I512;
    if (r < I1024) { p0_transpose_item(b_w_q, 1024, b_norm, (GAS bf16_t*)(ws + WS_WKVQ) + (size_t)512 * 1024, scr, r, F.lane, 32); return; } r -= I1024;
    if (r < I1024) { p0_transpose_item(b_w_q + (size_t)1024 * 1024, 1024, b_norm + 1024, (GAS bf16_t*)(ws + WS_WBQ1), scr, r, F.lane, 32); return; } r -= I1024;
    { const int l = r / I1024; r -= l * I1024; p0_transpose_item(b_w_o + (size_t)l * 1024 * 1024, 1024, nullptr, (GAS bf16_t*)(ws + WS_WOB) + (size_t)l * 1024 * 1024, scr, r, F.lane, 32); }
}
__device__ __forceinline__ void p0_wprime_job(const Frame& F, const Args& a, int job) {
    GAS unsigned char* ws = F.ws;
    const float* ffn_norm = a.in[12]; const float* peer_w_q = a.in[13];
    const float* sk = a.in[14]; const int lane = F.lane, r_ = lane & 15, g_ = lane >> 4;
    {
                const int l = job >> 10, hc = (job >> 6) & 15, kt = job & 63, c = hc & 1;
                const float gk = ffn_norm[l * 1024 + 16 * kt + r_];
                const float* ap = peer_w_q + ((size_t)l * 1024 + 16 * kt + r_) * 2048 + hc * 128 + 8 * g_;
                bf16x8 A[4];
#pragma unroll
                for (int ks = 0; ks < 4; ++ks) { const f32x4 x0 = *(const f32x4*)(ap + 32 * ks) * gk, x1 = *(const f32x4*)(ap + 32 * ks + 4) * gk;
                    const u32x4 w = (u32x4){pk2(x0[0], x0[1]), pk2(x0[2], x0[3]), pk2(x1[0], x1[1]), pk2(x1[2], x1[3])}; A[ks] = __builtin_bit_cast(bf16x8, w); }
                GAS bf16_t* wo = (GAS bf16_t*)(ws + WS_WPQ) + ((size_t)l * 2048 + hc * 128 + r_) * 1024 + 16 * kt + 4 * g_;
#pragma unroll 4
                for (int nt = 0; nt < 8; ++nt) {
                    const float* bp = sk + (((size_t)l * 2 + c) * 128 + 16 * nt + r_) * 128 + 8 * g_;
                    f32x4 d = (f32x4){0.f, 0.f, 0.f, 0.f};
#pragma unroll
                    for (int ks = 0; ks < 4; ++ks) { const f32x4 y0 = *(const f32x4*)(bp + 32 * ks), y1 = *(const f32x4*)(bp + 32 * ks + 4);
                        const u32x4 w = (u32x4){pk2(y0[0], y0[1]), pk2(y0[2], y0[3]), pk2(y1[0], y1[1]), pk2(y1[2], y1[3])}; d = MFMA16(A[ks], __builtin_bit_cast(bf16x8, w), d); }
                    *(GAS u32x2*)(wo + (size_t)(16 * nt) * 1024) = (u32x2){pk2(d[0], d[1]), pk2(d[2], d[3])};
                }
    }
}
__device__ __forceinline__ void p0_deferred(const Frame& F, const Args& a, int dgw, int dn) {
#pragma unroll 1
    for (int it0 = dgw; it0 < 2 * P0_I1024; it0 += dn) p0_weight_item(F, a, it0 < P0_I1024 ? P0_DEF0 + it0 : P0_DEF1 + (it0 - P0_I1024));
#pragma unroll 1
    for (int job = 3 * 1024 + dgw; job < 4 * 1024; job += dn) p0_wprime_job(F, a, job);
}
__device__ __forceinline__ void phase_prologue(const Frame& F, const Args& a) {
    GAS unsigned char* ws = F.ws;
    {
#pragma unroll 1
        for (int it0 = F.gw; it0 < P0_NITEMS - 2 * P0_I1024; it0 += F.NGW) p0_weight_item(F, a, it0 < P0_DEF0 ? it0 : it0 + P0_I1024);
#pragma unroll 1
        for (int job = F.gw; job < 3 * 1024; job += F.NGW) p0_wprime_job(F, a, job);
    }
    const size_t gtid = (size_t)blockIdx.x * NT + F.tid, gthreads = (size_t)F.G * NT;
    { const float* sk = a.in[14]; GAS bf16_t* o = (GAS bf16_t*)(ws + WS_SK); for (size_t i = gtid; i < (size_t)4 * 2 * 128 * 128; i += gthreads) o[i] = (bf16_t)f2bf(sk[i]); }
    {
        GAS f32x2* r32 = (GAS f32x2*)(ws + WS_ROPE32); GAS f32x2* r16 = (GAS f32x2*)(ws + WS_ROPE16);
        for (size_t i = gtid; i < (size_t)TP * 24; i += gthreads) {
            const int t = (int)(i / 24), j = (int)(i - (size_t)t * 24); float c, s;
            if (j < 16) { sincos_rev((double)t * a.inv32[j], c, s); r32[t * 16 + j] = (f32x2){c, s}; }
            else { sincos_rev((double)t * a.inv16[j - 16], c, s); r16[t * 8 + (j - 16)] = (f32x2){c, s}; }
        }
    }
    {
        const float* x = a.in[0]; const float* meta = a.in[1];
        GAS float* H = (GAS float*)(ws + WS_H); GAS bf16_t* HB = (GAS bf16_t*)(ws + WS_HB); GAS float* SS = (GAS float*)(ws + WS_SS); GAS bf16_t* O = (GAS bf16_t*)(ws + WS_O);
        for (int row = F.gw; row < NR; row += F.NGW) {
            const int b = row / TP, t = row - b * TP;
            f32x4 v[4]; float s = 0.f;
#pragma unroll
            for (int j = 0; j < 4; ++j) {
                if (t < NMETA) v[j] = *(const f32x4*)(meta + (size_t)t * 1024 + 256 * j + 4 * F.lane);
                else if (t < TT) v[j] = *(const f32x4*)(x + ((size_t)b * SEQ + (t - NMETA)) * 1024 + 256 * j + 4 * F.lane);
                else v[j] = (f32x4){0.f, 0.f, 0.f, 0.f};
                s += (v[j][0] * v[j][0] + v[j][1] * v[j][1]) + (v[j][2] * v[j][2] + v[j][3] * v[j][3]);
            }
            s = wave_sum(s);
#pragma unroll
            for (int j = 0; j < 4; ++j) {
                u32x2 w; w.x = pk2(v[j][0], v[j][1]); w.y = pk2(v[j][2], v[j][3]);
                *(GAS u32x2*)(HB + (size_t)row * 1024 + 256 * j + 4 * F.lane) = w;
                if (t >= TT) *(GAS u32x2*)(O + (size_t)row * 1024 + 256 * j + 4 * F.lane) = (u32x2){0u, 0u};
            }
            if (F.lane < 16) SS[(size_t)row * 16 + F.lane] = (F.lane == 0) ? s : 0.f;
        }
    }
}
#define DPPXF(v, ctrl) __builtin_bit_cast(float, __builtin_amdgcn_update_dpp(0, __builtin_bit_cast(int, (float)(v)), ctrl, 0xf, 0xf, false))
#ifndef TRB8_HYP
#define TRB8_HYP 0
#endif
#if TRB8_HYP == 0
#define TRB8_ROW(r) ((r) >> 1)
#define TRB8_COL(r) ((r) & 1)
#else
#define TRB8_ROW(r) ((r) & 7)
#define TRB8_COL(r) ((r) >> 3)
#endif
__device__ __forceinline__ void unpack8(const u32x4& w, float (&x)[8]) {
#pragma unroll
    for (int k = 0; k < 4; ++k) { x[2 * k] = bflo(w[k]); x[2 * k + 1] = bfhi(w[k]); }
}
__device__ __forceinline__ u32x4 pack8(const float (&x)[8]) { u32x4 w; w.x = pk2(x[0], x[1]); w.y = pk2(x[2], x[3]); w.z = pk2(x[4], x[5]); w.w = pk2(x[6], x[7]); return w; }
__device__ __forceinline__ void phase_a_post(const Frame& F, const float* qgain, const float* kgain) {
    GAS unsigned char* ws = F.ws;
    const GAS bf16_t* PROJ = (const GAS bf16_t*)(ws + WS_PROJ);
    GAS unsigned char* Q8 = ws + WS_Q8; GAS unsigned char* K8 = ws + WS_K8; GAS unsigned char* V8 = ws + WS_V8; GAS bf16_t* QI = (GAS bf16_t*)(ws + WS_QI); GAS bf16_t* KI = (GAS bf16_t*)(ws + WS_KI); GAS float* WI = (GAS float*)(ws + WS_WI);
    const GAS f32x2* r32 = (const GAS f32x2*)(ws + WS_ROPE32); const GAS f32x2* r16 = (const GAS f32x2*)(ws + WS_ROPE16);
    const int lane = F.lane, l16 = lane & 15;
    float qg[8], kg[8];
#pragma unroll
    for (int j = 0; j < 8; ++j) { qg[j] = qgain[l16 * 8 + j]; kg[j] = kgain[l16 * 8 + j]; }
    u32x4 nA, nB, nC, nD; f32x2 n32[8], n16[8];
#define AP_FETCH(rn__) do { const int rc_ = (rn__) < BATCH * TT ? (rn__) : BATCH * TT - 1; const int b_ = rc_ / TT, t_ = rc_ - b_ * TT; const GAS bf16_t* pr_ = PROJ + (size_t)(b_ * TP + t_) * 2048; \
        nA = *(const GAS u32x4*)(pr_ + 8 * lane); nB = *(const GAS u32x4*)(pr_ + 512 + 8 * lane); nC = *(const GAS u32x4*)(pr_ + 1024 + 8 * lane); nD = *(const GAS u32x4*)(pr_ + 1536 + 8 * lane); \
        _Pragma("unroll") for (int j = 0; j < 8; ++j) { n32[j] = r32[t_ * 16 + (lane & 1) * 8 + j]; n16[j] = r16[t_ * 8 + j]; } } while (0)
    AP_FETCH(F.gw);
    for (int rown = F.gw; rown < BATCH * TT; rown += F.NGW) {
        const int b = rown / TT, t = rown - b * TT; const int row = b * TP + t;
        const u32x4 wA = nA, wB = nB, wC = nC, wD = nD;
        f32x2 cs32[8], cs16[8];
#pragma unroll
        for (int j = 0; j < 8; ++j) { cs32[j] = n32[j]; cs16[j] = n16[j]; }
        asm volatile("" :: "v"(wA), "v"(wB), "v"(wC), "v"(wD));
        AP_FETCH(rown + F.NGW);
        __builtin_amdgcn_sched_barrier(0);
#pragma unroll
        for (int gp = 0; gp < 3; ++gp) {
            float x[8]; unpack8(gp == 0 ? wA : (gp == 1 ? wB : wC), x);
            float ssq = 0.f;
#pragma unroll
            for (int j = 0; j < 8; ++j) ssq += x[j] * x[j];
            ssq += DPPXF(ssq, 0xB1); ssq += DPPXF(ssq, 0x4E); ssq += DPPXF(ssq, 0x141); ssq += DPPXF(ssq, 0x140);
            const float ri = __builtin_amdgcn_rsqf(ssq * (1.0f / 128.0f) + RMS_EPS);
            const bool rot = l16 < 4, second = (lane & 2) != 0;
#pragma unroll
            for (int j = 0; j < 8; ++j) {
                float y = x[j] * ri * (gp < 2 ? qg[j] : kg[j]);
                const float p = DPPXF(y, 0x4E);
                if (rot) y = second ? (y * cs32[j].x + p * cs32[j].y) : (y * cs32[j].x - p * cs32[j].y);
                x[j] = (gp < 2) ? y * 0.08838834764831845f : y;
            }
            {
                const float sc = (gp < 2) ? Q_SCALE : K_SCALE; float y8[8];
#pragma unroll
                for (int j = 0; j < 8; ++j) y8[j] = __builtin_amdgcn_fmed3f(x[j] * sc, -416.f, 416.f);
                int w0 = __builtin_amdgcn_cvt_pk_fp8_f32(y8[0], y8[1], 0, false); w0 = __builtin_amdgcn_cvt_pk_fp8_f32(y8[2], y8[3], w0, true);
                int w1 = __builtin_amdgcn_cvt_pk_fp8_f32(y8[4], y8[5], 0, false); w1 = __builtin_amdgcn_cvt_pk_fp8_f32(y8[6], y8[7], w1, true);
                if (gp < 2) *(GAS u32x2*)(Q8 + (size_t)row * 1024 + gp * 512 + 8 * lane) = (u32x2){(unsigned)w0, (unsigned)w1};
                else if (lane < 32) *(GAS u32x2*)(K8 + (size_t)row * 256 + 8 * lane) = (u32x2){(unsigned)w0, (unsigned)w1};
            }
            if (gp == 2 && lane >= 32) {
                float xv[8]; unpack8(wC, xv);
#pragma unroll
                for (int j = 0; j < 8; ++j) xv[j] = __builtin_amdgcn_fmed3f(xv[j] * V8_SCALE, -416.f, 416.f);
                int w0 = __builtin_amdgcn_cvt_pk_fp8_f32(xv[0], xv[1], 0, false); w0 = __builtin_amdgcn_cvt_pk_fp8_f32(xv[2], xv[3], w0, true);
                int w1 = __builtin_amdgcn_cvt_pk_fp8_f32(xv[4], xv[5], 0, false); w1 = __builtin_amdgcn_cvt_pk_fp8_f32(xv[6], xv[7], w1, true);
                *(GAS u32x2*)(V8 + (size_t)row * 256 + 8 * (lane - 32)) = (u32x2){(unsigned)w0, (unsigned)w1};
            }
        }
        {
            float x[8]; unpack8(wD, x);
            const bool rot = (lane & 7) < 2 && lane < 40, second = (lane & 1) != 0;
#pragma unroll
            for (int j = 0; j < 8; ++j) {
                float y = x[j]; const float p = DPPXF(y, 0xB1);
                if (rot) y = second ? (y * cs16[j].x + p * cs16[j].y) : (y * cs16[j].x - p * cs16[j].y);
                x[j] = (lane < 32) ? y * 0.125f : y;
            }
            if (lane < 32) *(GAS u32x4*)(QI + (size_t)row * 256 + 8 * lane) = pack8(x);
            else if (lane < 40) *(GAS u32x4*)(KI + (size_t)row * 64 + 8 * (lane - 32)) = pack8(x);
            else if (lane == 40) *(GAS f32x4*)(WI + (size_t)row * 4) = (f32x4){x[0] * 0.5f, x[1] * 0.5f, x[2] * 0.5f, x[3] * 0.5f};
        }
    }
}

constexpr int SCS = 4232;
constexpr int DSA_SC = 0, DSA_HIST = 8 * SCS * 4, DSA_SEL = DSA_HIST + 8 * 256 * 4;
__device__ __forceinline__ int wave_incl_scan(int v, int lane) {
    (void)lane;
    v += __builtin_amdgcn_update_dpp(0, v, 0x111, 0xf, 0xf, false);
    v += __builtin_amdgcn_update_dpp(0, v, 0x112, 0xf, 0xf, false);
    v += __builtin_amdgcn_update_dpp(0, v, 0x114, 0xf, 0xf, false);
    v += __builtin_amdgcn_update_dpp(0, v, 0x118, 0xf, 0xf, false);
    v += __builtin_amdgcn_update_dpp(0, v, 0x142, 0xa, 0xf, false);
    v += __builtin_amdgcn_update_dpp(0, v, 0x143, 0xc, 0xf, false);
    return v;
}
__device__ __forceinline__ void phase_dsa_sel(const Frame& F) {
    GAS unsigned char* ws = F.ws;
    GAS bf16_t* SELG = (GAS bf16_t*)(ws + WS_SELG); const GAS bf16_t* QI = (const GAS bf16_t*)(ws + WS_QI);
    const GAS bf16_t* KI = (const GAS bf16_t*)(ws + WS_KI); const GAS float* WI = (const GAS float*)(ws + WS_WI);
    LAS unsigned* SC = (LAS unsigned*)(F.lds + DSA_SC); LAS unsigned* HIST = (LAS unsigned*)(F.lds + DSA_HIST) + F.wave * 256; LAS unsigned* SEL = (LAS unsigned*)(F.lds + DSA_SEL) + F.wave * 256;
    const int lane = F.lane, wave = F.wave, r = lane & 15, g = lane >> 4;
    const unsigned long long ltmask = (1ull << lane) - 1ull;
    LAS unsigned* QMAX = (LAS unsigned*)(F.lds + DSA_SEL + 8 * 256 * 4);
    if (F.tid < 8) { QMAX[F.tid] = 0u; QMAX[8 + F.tid] = 0xFFFFFFFFu; }
    __syncthreads();
    constexpr int NITEM = BATCH * (TT / 8), NFIRST = (NITEM / 256) * 256;
    bf16x8 An[2][2]; f32x4 wvn[2]; u32x4 klN[2][2];
#define SEL_MAP(i_) (((((i_) / F.G) & 1) && ((i_) / F.G + 1) * F.G <= NFIRST) ? ((i_) / F.G) * F.G + (F.G - 1 - (i_) % F.G) : (i_))
#define SEL_AFETCH(it__) do { const int icl_ = (it__) < NITEM ? (it__) : NITEM - 1; const int ic_ = SEL_MAP(icl_); const int b_ = ic_ & 3, qb_ = (ic_ < NFIRST) ? (ic_ >> 2) + (NITEM - NFIRST) / 4 : (ic_ - NFIRST) >> 2, t0_ = qb_ * 8; \
        _Pragma("unroll") for (int mt = 0; mt < 2; ++mt) { const GAS bf16_t* qp_ = QI + ((size_t)b_ * TP + t0_ + 4 * mt + (r >> 2)) * 256 + (r & 3) * 64 + 8 * g; \
            An[mt][0] = *(const GAS bf16x8*)qp_; An[mt][1] = *(const GAS bf16x8*)(qp_ + 32); wvn[mt] = *(const GAS f32x4*)(WI + ((size_t)b_ * TP + t0_ + 4 * mt + g) * 4); } \
        _Pragma("unroll") for (int u = 0; u < 2; ++u) _Pragma("unroll") for (int h = 0; h < 2; ++h) klN[u][h] = *(const GAS u32x4*)(KI + ((size_t)b_ * TP + (F.wave + 8 * u) * 16 + 8 * h + (lane >> 3)) * 64 + 8 * (lane & 7)); } while (0)
    SEL_AFETCH((int)blockIdx.x);
    for (int it = blockIdx.x; it < NITEM; it += F.G) {
        const int ie = SEL_MAP(it);
        const int b = ie & 3, qb = (ie < NFIRST) ? (ie >> 2) + (NITEM - NFIRST) / 4 : (ie - NFIRST) >> 2, t0 = qb * 8, nkeys = t0 + 8;
        const size_t rb = (size_t)b * TP;
#ifdef SEL_DUP_SCORE
#pragma unroll 1
        for (int rep_ = 0; rep_ < 2; ++rep_)
#endif
        {
            bf16x8 A[2][2]; f32x4 wv[2]; unsigned kmax[2] = {0u, 0u}, kmin[2] = {0xFFFFFFFFu, 0xFFFFFFFFu};
#pragma unroll
            for (int mt = 0; mt < 2; ++mt) { A[mt][0] = An[mt][0]; A[mt][1] = An[mt][1]; wv[mt] = wvn[mt]; }
            const int ntile = (nkeys + 15) >> 4;
            LAS unsigned char* KTL = F.lds + DSA_HIST + wave * 2048;
            const int kq8 = lane >> 3, c8 = lane & 7;
#pragma unroll 1
            for (int kt0 = wave; kt0 < ntile; kt0 += 32) {
                u32x4 kl[4][2];
#pragma unroll
                for (int u = 0; u < 4; ++u)
#pragma unroll
                    for (int h = 0; h < 2; ++h) kl[u][h] = *(const GAS u32x4*)(KI + (rb + (kt0 + 8 * u) * 16 + 8 * h + kq8) * 64 + 8 * c8);
                if (kt0 == wave) {
#pragma unroll
                    for (int h = 0; h < 2; ++h) { kl[0][h] = klN[0][h]; kl[1][h] = klN[1][h]; }
                }
#pragma unroll
                for (int u = 0; u < 4; ++u) {
                    const int kt = kt0 + 8 * u;
                    if (kt < ntile) {
#pragma unroll
                        for (int h = 0; h < 2; ++h) { const int rw = 8 * h + kq8; *(LAS u32x4*)(KTL + rw * 128 + ((c8 ^ (rw & 7)) << 4)) = kl[u][h]; }
                        const bf16x8 B0 = *(const LAS bf16x8*)(KTL + r * 128 + ((g ^ (r & 7)) << 4)), B1 = *(const LAS bf16x8*)(KTL + r * 128 + (((4 + g) ^ (r & 7)) << 4));
                        const int key = kt * 16 + r;
#pragma unroll
                        for (int mt = 0; mt < 2; ++mt) {
                            f32x4 d = (f32x4){0.f, 0.f, 0.f, 0.f};
                            d = MFMA16(A[mt][0], B0, d); d = MFMA16(A[mt][1], B1, d);
                            float s = fmaxf(d[0], 0.f) * wv[mt][0] + fmaxf(d[1], 0.f) * wv[mt][1] + fmaxf(d[2], 0.f) * wv[mt][2] + fmaxf(d[3], 0.f) * wv[mt][3];
                            if (s == 0.f) s = 0.f;
                            const int qpos = t0 + 4 * mt + g;
                            const unsigned kk = (key <= qpos) ? mono_key(s) : 0u;
                            SC[(4 * mt + g) * SCS + key] = kk; kmax[mt] = kk > kmax[mt] ? kk : kmax[mt]; if (u == 0) kmin[mt] = (kk - 1u) < kmin[mt] ? (kk - 1u) : kmin[mt];
                        }
                    }
                }
            }
#pragma unroll
            for (int mt = 0; mt < 2; ++mt) {
                unsigned x = kmax[mt], t;
#define DPPU2_(v, ctrl) (unsigned)__builtin_amdgcn_update_dpp(0, (int)(v), ctrl, 0xf, 0xf, false)
                t = DPPU2_(x, 0xB1); x = t > x ? t : x; t = DPPU2_(x, 0x4E); x = t > x ? t : x; t = DPPU2_(x, 0x141); x = t > x ? t : x; t = DPPU2_(x, 0x140); x = t > x ? t : x;
                unsigned y = kmin[mt];
                t = DPPU2_(y, 0xB1); y = t < y ? t : y; t = DPPU2_(y, 0x4E); y = t < y ? t : y; t = DPPU2_(y, 0x141); y = t < y ? t : y; t = DPPU2_(y, 0x140); y = t < y ? t : y;
                if (r == 0 && x) { __hip_atomic_fetch_max(&QMAX[4 * mt + g], x, __ATOMIC_RELAXED, __HIP_MEMORY_SCOPE_WORKGROUP); if (y != 0xFFFFFFFFu) __hip_atomic_fetch_min(&QMAX[8 + 4 * mt + g], y + 1u, __ATOMIC_RELAXED, __HIP_MEMORY_SCOPE_WORKGROUP); }
            }
#undef DPPU2_
        }
        __syncthreads();
        const int qpos = t0 + wave, n = qpos + 1;
        LAS unsigned* row = SC + wave * SCS;
        int cnt;
        const unsigned qmx_ = (unsigned)__builtin_amdgcn_readfirstlane((int)QMAX[wave]), qmn_ = (unsigned)__builtin_amdgcn_readfirstlane((int)QMAX[8 + wave]);
        QMAX[wave] = 0u; QMAX[8 + wave] = 0xFFFFFFFFu;
#define SEL_FINDBIN(want_) \
                const int h0 = (int)HIST[255 - 4 * lane], h1 = (int)HIST[254 - 4 * lane], h2 = (int)HIST[253 - 4 * lane], h3 = (int)HIST[252 - 4 * lane]; \
                const int local = h0 + h1 + h2 + h3, incl = wave_incl_scan(local, lane), excl = incl - local; \
                const bool here = (excl < (want_)) && ((want_) <= incl); \
                int bin = 0, above = 0, binc = 0; \
                if (here) { int c = excl; \
                    if (c + h0 >= (want_)) { bin = 255 - 4 * lane; above = c; binc = h0; } else { c += h0; \
                    if (c + h1 >= (want_)) { bin = 254 - 4 * lane; above = c; binc = h1; } else { c += h1; \
                    if (c + h2 >= (want_)) { bin = 253 - 4 * lane; above = c; binc = h2; } else { c += h2; bin = 252 - 4 * lane; above = c; binc = h3; } } } } \
                const unsigned long long bm = __ballot(here); \
                const int src = (int)__builtin_ctzll(bm); \
                bin = __builtin_amdgcn_readlane(bin, src); above = __builtin_amdgcn_readlane(above, src); binc = __builtin_amdgcn_readlane(binc, src);
#define SEL_MBCNT(m_) (int)__builtin_amdgcn_mbcnt_hi((unsigned)((m_) >> 32), __builtin_amdgcn_mbcnt_lo((unsigned)(m_), 0u))
        const float smin = unmono_key(qmn_ < qmx_ ? qmn_ : qmx_), bscale = 255.0f / (unmono_key(qmx_) - smin), boff = -smin * bscale;
#define SEL_BKT(k_) ({ unsigned b_ = (unsigned)__builtin_fmaf(unmono_key(k_), bscale, boff); b_ > 255u ? 255u : b_; })
        bool seldone = false;
        if (n <= TOPK) { for (int i = lane; i < TOPK; i += 64) SEL[i] = (i < n) ? (unsigned)i : 0u; cnt = n; seldone = true; }
        else if (n >= 1024) {
            LAS unsigned short* QGL = (LAS unsigned short*)SEL;
            LAS unsigned short* CIL = (LAS unsigned short*)(F.lds + DSA_SEL + 8 * 256 * 4 + 64 + wave * 1488);
            const int G = (n + 3) >> 2;
            float za = bscale, zoa = boff; bool zoomA = false;
#define SEL_ABKT(k_) ({ unsigned b_ = (unsigned)__builtin_fmaf(unmono_key(k_), za, zoa); b_ > 255u ? 255u : b_; })
            unsigned gbk[5];
            int B = 0;
#pragma unroll 1
            for (int pass = 0; pass < 2; ++pass) {
#pragma unroll
                for (int i = 0; i < 5; ++i) gbk[i] = 0u;
#pragma unroll
                for (int i = 0; i < 4; ++i) HIST[lane + 64 * i] = 0u;
#pragma unroll
                for (int c = 0; c < 17; ++c) {
                    const bool gv = lane < G - 64 * c; unsigned gm = 0u;
                    if (gv) { const u32x4 k4 = *(const LAS u32x4*)(row + 256 * c + 4 * lane); const unsigned a_ = k4.x > k4.y ? k4.x : k4.y, b_ = k4.z > k4.w ? k4.z : k4.w; gm = a_ > b_ ? a_ : b_; }
                    const unsigned bq = SEL_ABKT(gm); gbk[c >> 2] |= bq << (8 * (c & 3));
                    if (gv) __hip_atomic_fetch_add(&HIST[bq], 1u, __ATOMIC_RELAXED, __HIP_MEMORY_SCOPE_WORKGROUP);
                }
                asm volatile("s_waitcnt lgkmcnt(0)" ::: "memory");
                int bc_;
                { SEL_FINDBIN(TOPK)
                  (void)above; B = __builtin_amdgcn_readfirstlane(bin); bc_ = __builtin_amdgcn_readfirstlane(binc); }
                if (pass == 1 || bc_ <= 128) break;
                zoa = (zoa - (float)B + 0.5f) * 128.0f; za = za * 128.0f; zoomA = true;
            }
            bool ok = B > 0;
            int NQ = 0;
            if (ok) {
#pragma unroll
                for (int c = 0; c < 17; ++c) {
                    const bool q = (lane < G - 64 * c) && (((gbk[c >> 2] >> (8 * (c & 3))) & 255u) >= (unsigned)B);
                    const unsigned long long bal = __ballot(q);
                    if (bal) { const int pos = NQ + SEL_MBCNT(bal); if (q && pos < 448) QGL[pos] = (unsigned short)(64 * c + lane); NQ += (int)__popcll(bal); }
                }
                ok = NQ <= 448;
            }
            int C = 0;
            if (ok) {
#pragma unroll
                for (int i = 0; i < 4; ++i) HIST[lane + 64 * i] = 0u;
                asm volatile("s_waitcnt lgkmcnt(0)" ::: "memory");
                const int nround = (NQ + 63) >> 6;
#pragma unroll 1
                for (int u = 0; u < nround; ++u) {
                    const int t = 64 * u + lane; const bool valid = t < NQ;
                    const unsigned grp = valid ? (unsigned)QGL[t] : 0u;
                    const u32x4 k4 = *(const LAS u32x4*)(row + 4 * grp);
                    unsigned bq[4]; bool ic[4]; int cn = 0;
#pragma unroll
                    for (int e = 0; e < 4; ++e) { bq[e] = SEL_ABKT(k4[e]); ic[e] = valid && (bq[e] >= (unsigned)B); cn += ic[e] ? 1 : 0; }
                    const int incl = wave_incl_scan(cn, lane); int pos = C + incl - cn;
#pragma unroll
                    for (int e = 0; e < 4; ++e) if (ic[e]) { if (pos < 704) CIL[pos] = (unsigned short)(4 * grp + e); __hip_atomic_fetch_add(&HIST[bq[e]], 1u, __ATOMIC_RELAXED, __HIP_MEMORY_SCOPE_WORKGROUP); ++pos; }
                    C += __builtin_amdgcn_readlane(incl, 63);
                }
                ok = C <= 704;
            }
            if (ok) {
                asm volatile("s_waitcnt lgkmcnt(0)" ::: "memory");
                unsigned ck[11];
#pragma unroll
                for (int c = 0; c < 11; ++c) { const bool v = lane < C - 64 * c; const unsigned idx = v ? (unsigned)CIL[64 * c + lane] : 0u; ck[c] = v ? row[idx] : 0u; }
                if (zoomA) {
#pragma unroll
                    for (int i = 0; i < 4; ++i) HIST[lane + 64 * i] = 0u;
#pragma unroll
                    for (int c = 0; c < 11; ++c) if (64 * c < C) { if (ck[c] != 0u) __hip_atomic_fetch_add(&HIST[SEL_BKT(ck[c])], 1u, __ATOMIC_RELAXED, __HIP_MEMORY_SCOPE_WORKGROUP); }
                    asm volatile("s_waitcnt lgkmcnt(0)" ::: "memory");
                }
                int bin2, need1, m2;
                { SEL_FINDBIN(TOPK)
                  bin2 = __builtin_amdgcn_readfirstlane(bin); need1 = TOPK - __builtin_amdgcn_readfirstlane(above); m2 = __builtin_amdgcn_readfirstlane(binc); }
                float zs = bscale, zo = boff;
#define SEL_ZBKT(k_) ({ unsigned b_ = (unsigned)__builtin_fmaf(unmono_key(k_), zs, zo); b_ > 255u ? 255u : b_; })
                bool tie = false; unsigned Tt = 0u;
#pragma unroll 1
                for (int z = 0; z < 4 && m2 > 64; ++z) {
                    unsigned kmn = 0xFFFFFFFFu, kmx = 0u;
#pragma unroll
                    for (int c = 0; c < 11; ++c) if (64 * c < C) { const bool cd = (ck[c] != 0u) && (SEL_ZBKT(ck[c]) == (unsigned)bin2); if (cd) { kmn = ck[c] < kmn ? ck[c] : kmn; kmx = ck[c] > kmx ? ck[c] : kmx; } }
                    kmn = wave_min_dpp_u(kmn); kmx = wave_max_dpp_u(kmx);
                    tie = (kmn == kmx); Tt = kmx;
                    if (tie || z == 3) break;
                    zo = (zo - (float)bin2 + 0.5f) * 128.0f; zs = zs * 128.0f;
#pragma unroll
                    for (int i = 0; i < 4; ++i) HIST[lane + 64 * i] = 0u;
#pragma unroll
                    for (int c = 0; c < 11; ++c) if (64 * c < C) { if (ck[c] != 0u) __hip_atomic_fetch_add(&HIST[SEL_ZBKT(ck[c])], 1u, __ATOMIC_RELAXED, __HIP_MEMORY_SCOPE_WORKGROUP); }
                    asm volatile("s_waitcnt lgkmcnt(0)" ::: "memory");
                    { SEL_FINDBIN(TOPK)
                      bin2 = __builtin_amdgcn_readfirstlane(bin); need1 = TOPK - __builtin_amdgcn_readfirstlane(above); m2 = __builtin_amdgcn_readfirstlane(binc); }
                }
                ok = (m2 <= 64) || tie;
                if (ok) {
                    unsigned T; int need;
                    if (tie) { T = Tt; need = need1; }
                    else {
                    int base = 0;
#pragma unroll
                    for (int c = 0; c < 11; ++c) {
                        if (64 * c < C) {
                            const bool cd = (ck[c] != 0u) && (SEL_ZBKT(ck[c]) == (unsigned)bin2);
                            const unsigned long long bal = __ballot(cd);
                            if (bal) { const int pos = base + SEL_MBCNT(bal); if (cd) { HIST[pos] = ck[c]; HIST[64 + pos] = (unsigned)CIL[64 * c + lane]; } base += (int)__popcll(bal); }
                        }
                    }
                    asm volatile("s_waitcnt lgkmcnt(0)" ::: "memory");
                    const unsigned myk = HIST[lane], myi = HIST[64 + lane];
                    int rank = 0;
#pragma unroll 2
                    for (int jx = 0; jx < m2; ++jx) { const unsigned kj = (unsigned)__builtin_amdgcn_readlane((int)myk, jx), ij = (unsigned)__builtin_amdgcn_readlane((int)myi, jx); rank += (kj > myk || (kj == myk && ij < myi)) ? 1 : 0; }
                    const bool isT = (lane < m2) && (rank == need1 - 1);
                    const int srcT = (int)__builtin_ctzll(__ballot(isT));
                    T = (unsigned)__builtin_amdgcn_readlane((int)myk, srcT);
                    need = need1 - (int)__popcll(__ballot((lane < m2) && (myk > T)));
                    }
                    int outbase = 0, eqbase = 0;
#pragma unroll
                    for (int c = 0; c < 11; ++c) {
                        if (64 * c < C) {
                            const unsigned k = ck[c];
                            bool take = k > T;
                            const unsigned long long beq = __ballot(k == T);
                            if (beq) { const int eqrank = eqbase + SEL_MBCNT(beq); take = take || ((k == T) && (eqrank < need)); eqbase += (int)__popcll(beq); }
                            const unsigned long long bt = __ballot(take);
                            if (take) SEL[outbase + SEL_MBCNT(bt)] = (unsigned)CIL[64 * c + lane];
                            outbase += (int)__popcll(bt);
                        }
                    }
                    cnt = TOPK; seldone = true;
                }
            }
        }
        if (!seldone) {
            unsigned kreg[65];
#pragma unroll
            for (int c = 0; c < 65; ++c) { const int i = 64 * c + lane; kreg[c] = (i < n) ? row[i] : 0u; }
            const int nch = (n + 63) >> 6, nfull = n >> 6, rem = n & 63;
            unsigned T; int need;
            bool fast;
            {
                unsigned bk[17];
#pragma unroll
                for (int q = 0; q < 17; ++q) bk[q] = 0u;
#pragma unroll
                for (int i = 0; i < 4; ++i) HIST[lane + 64 * i] = 0u;
#pragma unroll
                for (int cb = 0; cb < 65; cb += 13) {
                    if (cb < nch) {
#pragma unroll
                        for (int c = cb; c < cb + 13; ++c) {
                            unsigned bkt = (unsigned)__builtin_fmaf(unmono_key(kreg[c]), bscale, boff); bkt = bkt > 255u ? 255u : bkt;
                            bk[c >> 2] |= (unsigned)bkt << (8 * (c & 3));
                            if (c < nfull) __hip_atomic_fetch_add(&HIST[bkt], 1u, __ATOMIC_RELAXED, __HIP_MEMORY_SCOPE_WORKGROUP);
                            else if (c == nfull && lane < rem) __hip_atomic_fetch_add(&HIST[bkt], 1u, __ATOMIC_RELAXED, __HIP_MEMORY_SCOPE_WORKGROUP);
                        }
                    }
                }
                asm volatile("s_waitcnt lgkmcnt(0)" ::: "memory");
                SEL_FINDBIN(TOPK)
                const int m = __builtin_amdgcn_readfirstlane(binc), need1 = TOPK - above;
                fast = (m <= 64) && (bin > 0);
                if (fast) {
                    int base = 0;
#pragma unroll
                    for (int cb = 0; cb < 65; cb += 13) {
                        if (cb < nch) {
#pragma unroll
                            for (int c = cb; c < cb + 13; ++c) {
                                const int i = 64 * c + lane;
                                const bool cd = (((bk[c >> 2] >> (8 * (c & 3))) & 255u) == (unsigned)bin);
                                const unsigned long long bal = __ballot(cd);
                                if (bal) { const int pos = base + __popcll(bal & ltmask); if (cd) { HIST[pos] = kreg[c]; HIST[64 + pos] = (unsigned)i; } base += __popcll(bal); }
                            }
                        }
                    }
                    asm volatile("s_waitcnt lgkmcnt(0)" ::: "memory");
                    const unsigned myk = HIST[lane], myi = HIST[64 + lane];
                    int rank = 0;
#pragma unroll 2
                    for (int jx = 0; jx < m; ++jx) { const unsigned kj = (unsigned)__builtin_amdgcn_readlane((int)myk, jx), ij = (unsigned)__builtin_amdgcn_readlane((int)myi, jx); rank += (kj > myk || (kj == myk && ij < myi)) ? 1 : 0; }
                    const bool isT = (lane < m) && (rank == need1 - 1);
                    const int srcT = (int)__builtin_ctzll(__ballot(isT));
                    T = (unsigned)__builtin_amdgcn_readlane((int)myk, srcT);
                    need = need1 - (int)__popcll(__ballot((lane < m) && (myk > T)));
                }
            }
            if (!fast) {
            unsigned prefix = 0u, mask = 0u; int want = TOPK;
#pragma unroll 1
            for (int pass = 3; pass >= 0; --pass) {
                const int sh = pass * 8;
#pragma unroll
                for (int i = 0; i < 4; ++i) HIST[lane + 64 * i] = 0u;
#pragma unroll
                for (int cb = 0; cb < 65; cb += 13) {
                    if (cb < nch) {
#pragma unroll
                        for (int c = cb; c < cb + 13; ++c) { const unsigned k = kreg[c]; if ((64 * c + lane) < n && (k & mask) == prefix) __hip_atomic_fetch_add(&HIST[(k >> sh) & 255u], 1u, __ATOMIC_RELAXED, __HIP_MEMORY_SCOPE_WORKGROUP); }
                    }
                }
                asm volatile("s_waitcnt lgkmcnt(0)" ::: "memory");
                SEL_FINDBIN(want)
                (void)binc;
                want -= above; prefix |= (unsigned)bin << sh; mask |= 0xFFu << sh;
            }
            T = prefix; need = want;
            }
            int outbase = 0, eqbase = 0;
#pragma unroll
            for (int cb = 0; cb < 65; cb += 13) {
                if (cb < nch) {
#pragma unroll
                    for (int c = cb; c < cb + 13; ++c) {
                        const unsigned k = kreg[c];
                        bool take = k > T;
                        const unsigned long long beq = __ballot(k == T);
                        if (beq) { const int eqrank = eqbase + SEL_MBCNT(beq); take = take || ((k == T) && (eqrank < need)); eqbase += (int)__popcll(beq); }
                        const unsigned long long bt = __ballot(take);
                        if (take) SEL[outbase + SEL_MBCNT(bt)] = (unsigned)(64 * c + lane);
                        outbase += (int)__popcll(bt);
                    }
                }
            }
            cnt = TOPK;
        }
        asm volatile("s_waitcnt lgkmcnt(0)" ::: "memory");
        SEL_AFETCH(it + F.G);
        { const unsigned s0 = SEL[4 * lane], s1 = SEL[4 * lane + 1], s2 = SEL[4 * lane + 2], s3 = SEL[4 * lane + 3];
          *(GAS u32x2*)(SELG + (rb + qpos) * 256 + 4 * lane) = (u32x2){s0 | (s1 << 16), s2 | (s3 << 16)}; }
        (void)cnt;
        __syncthreads();
    }
}

__device__ __forceinline__ void phase_dsa_attn(const Frame& F) {
    GAS unsigned char* ws = F.ws;
    const GAS unsigned char* Q8 = ws + WS_Q8; const GAS unsigned char* K8 = ws + WS_K8; const GAS unsigned char* V8 = ws + WS_V8; const GAS bf16_t* SELG = (const GAS bf16_t*)(ws + WS_SELG); GAS bf16_t* O = (GAS bf16_t*)(ws + WS_O);
    const int lane = F.lane, wave = F.wave, r = lane & 15, g = lane >> 4;
    volatile LAS unsigned* MISC = (volatile LAS unsigned*)(F.lds + MISC_OFF);
    const int xp = (int)MISC[4], nx = (int)MISC[5], xrank = (int)MISC[6], xn = (int)MISC[7];
    LAS unsigned* SEL = (LAS unsigned*)(F.lds) + wave * 256; LAS float* Pb = (LAS float*)(F.lds + 8192) + wave * 1024; LAS unsigned char* KT = F.lds + 40960 + wave * 8704; LAS unsigned char* PT8 = F.lds + 110592 + wave * 1024;
    const int wrank = xrank * NWAVES + wave, nw = xn * NWAVES;
#pragma unroll 1
    for (int P = xp; P < 2 * BATCH; P += nx) {
        const int b = P >> 1, kvh = P & 1;
        const size_t rb = (size_t)b * TP;
        const int kq8 = lane >> 3, c8 = lane & 7;
        const GAS unsigned char* kbase = K8 + rb * 256 + kvh * 128 + 16 * c8; const GAS unsigned char* vbase = V8 + rb * 256 + kvh * 128 + 16 * c8;
        u32x4 ka[4], kb2[4];
        u32x2 sw_n; u32x4 q0_n, q1_n;
#define DSA_LOADX(buf, base_, st) do { _Pragma("unroll") for (int u_ = 0; u_ < 4; ++u_) { const int key_ = (int)SEL[(st) * 32 + 8 * u_ + kq8]; buf[u_] = *(const GAS u32x4*)((base_) + (size_t)key_ * 256); } } while (0)
#define ATT_QPOS(qi__) (((qi__) < TT - NMETA) ? (qi__) + NMETA : (qi__) - (TT - NMETA))
#define ATT_FETCH(qi__) do { const int qc_ = (qi__) < TT ? (qi__) : TT - 1; const size_t row_ = rb + ATT_QPOS(qc_); sw_n = *(const GAS u32x2*)(SELG + row_ * 256 + 4 * lane); \
            const GAS unsigned char* qp_ = Q8 + row_ * 1024 + (kvh * 4 + (r & 3)) * 128 + g * 32; q0_n = *(const GAS u32x4*)qp_; q1_n = *(const GAS u32x4*)(qp_ + 16); } while (0)
#define ATT_SELW() do { SEL[4 * lane] = sw_n.x & 0xffffu; SEL[4 * lane + 1] = sw_n.x >> 16; SEL[4 * lane + 2] = sw_n.y & 0xffffu; SEL[4 * lane + 3] = sw_n.y >> 16; asm volatile("s_waitcnt lgkmcnt(0)" ::: "memory"); } while (0)
        ATT_FETCH(wrank); ATT_SELW(); DSA_LOADX(ka, kbase, 0);
#pragma unroll 1
        for (int qi_ = wrank; qi_ < TT; qi_ += nw) {
            const int qpos = ATT_QPOS(qi_);
            const size_t qrow = rb + qpos;
            const int cnt = (qpos + 1 < TOPK) ? qpos + 1 : TOPK, nst = ((cnt + 63) >> 6) << 1;
            long Aq[4];
            {
                u32x4 q0 = q0_n, q1 = q1_n;
                if (r >= 4) { q0 = (u32x4){0u, 0u, 0u, 0u}; q1 = q0; }
                Aq[0] = (long)(((unsigned long long)q0.y << 32) | q0.x); Aq[1] = (long)(((unsigned long long)q0.w << 32) | q0.z);
                Aq[2] = (long)(((unsigned long long)q1.y << 32) | q1.x); Aq[3] = (long)(((unsigned long long)q1.w << 32) | q1.z);
            }
            asm volatile("" : "+v"(Aq[0]), "+v"(Aq[1]), "+v"(Aq[2]), "+v"(Aq[3]));
            ATT_FETCH(qi_ + nw);
#ifndef NO_QK
            {
#define DSA_LOADK(buf, st) do { _Pragma("unroll") for (int u_ = 0; u_ < 4; ++u_) { const int key_ = (int)SEL[(st) * 32 + 8 * u_ + kq8]; buf[u_] = *(const GAS u32x4*)(kbase + (size_t)key_ * 256); } } while (0)
#define DSA_QKSTEP(buf, st) do { _Pragma("unroll") for (int u_ = 0; u_ < 4; ++u_) *(LAS u32x4*)(KT + (8 * u_ + kq8) * 144 + 16 * c8) = buf[u_]; \
                    _Pragma("unroll") for (int h_ = 0; h_ < 2; ++h_) { f32x4 d_ = (f32x4){0.f, 0.f, 0.f, 0.f}; \
                        const u32x4 k0_ = *(const LAS u32x4*)(KT + (16 * h_ + r) * 144 + g * 32), k1_ = *(const LAS u32x4*)(KT + (16 * h_ + r) * 144 + g * 32 + 16); \
                        d_ = __builtin_amdgcn_mfma_f32_16x16x32_fp8_fp8(Aq[0], (long)(((unsigned long long)k0_.y << 32) | k0_.x), d_, 0, 0, 0); \
                        d_ = __builtin_amdgcn_mfma_f32_16x16x32_fp8_fp8(Aq[1], (long)(((unsigned long long)k0_.w << 32) | k0_.z), d_, 0, 0, 0); \
                        d_ = __builtin_amdgcn_mfma_f32_16x16x32_fp8_fp8(Aq[2], (long)(((unsigned long long)k1_.y << 32) | k1_.x), d_, 0, 0, 0); \
                        d_ = __builtin_amdgcn_mfma_f32_16x16x32_fp8_fp8(Aq[3], (long)(((unsigned long long)k1_.w << 32) | k1_.z), d_, 0, 0, 0); \
                        d_ *= (1.0f / (Q_SCALE * K_SCALE)); \
                        const int kk_ = (st) * 32 + 16 * h_ + r; if (kk_ >= cnt) d_ = (f32x4){-INFINITY, -INFINITY, -INFINITY, -INFINITY}; \
                        if (g == 0) *(LAS f32x4*)(Pb + kk_ * 4) = d_; } } while (0)
#pragma unroll 1
                for (int st = 0; st < nst; st += 2) {
                    DSA_LOADK(kb2, st + 1); __builtin_amdgcn_sched_barrier(0);
                    DSA_QKSTEP(ka, st);
                    { const bool lastq_ = (st + 2 >= nst); DSA_LOADX(ka, lastq_ ? vbase : kbase, lastq_ ? 0 : st + 2); } __builtin_amdgcn_sched_barrier(0);
                    DSA_QKSTEP(kb2, st + 1);
                }
            }
#endif
            asm volatile("s_waitcnt lgkmcnt(0)" ::: "memory");
            {
                f32x4 sv[4];
#pragma unroll
                for (int j = 0; j < 4; ++j) { sv[j] = *(const LAS f32x4*)(Pb + (lane + 64 * j) * 4); if (lane + 64 * j >= 32 * nst) sv[j] = (f32x4){-INFINITY, -INFINITY, -INFINITY, -INFINITY}; }
                float mx[4], sm[4];
#pragma unroll
                for (int i = 0; i < 4; ++i) mx[i] = wave_max_dpp_f(fmaxf(fmaxf(sv[0][i], sv[1][i]), fmaxf(sv[2][i], sv[3][i])));
#pragma unroll
                for (int i = 0; i < 4; ++i) { float t = 0.f;
#pragma unroll
                    for (int j = 0; j < 4; ++j) { const float e = fexp(sv[j][i] - mx[i]); sv[j][i] = e; t += e; }
                    sm[i] = __builtin_amdgcn_rcpf(wave_sum_dpp_f(t)); }
#pragma unroll
                for (int j = 0; j < 4; ++j)
#pragma unroll
                    for (int i = 0; i < 4; ++i) { const int w8 = __builtin_amdgcn_cvt_pk_fp8_f32(sv[j][i] * sm[i] * P8_SCALE, 0.f, 0, false); PT8[i * 256 + lane + 64 * j] = (unsigned char)(w8 & 0xff); }
            }
            asm volatile("s_waitcnt lgkmcnt(0)" ::: "memory");
#ifndef NO_PV
            {
                f32x4 Od[8];
#pragma unroll
                for (int c = 0; c < 8; ++c) Od[c] = (f32x4){0.f, 0.f, 0.f, 0.f};
                const unsigned vt_lane = (unsigned)(size_t)KT + (unsigned)((8 * g + TRB8_ROW(r)) * 144 + 8 * TRB8_COL(r));
#define DSA_LOADV(buf, ks) do { _Pragma("unroll") for (int u_ = 0; u_ < 4; ++u_) { const int key_ = (int)SEL[(ks) * 32 + 8 * u_ + kq8]; buf[u_] = *(const GAS u32x4*)(vbase + (size_t)key_ * 256); } } while (0)
#define DSA_PVSTEP(buf, ks) do { _Pragma("unroll") for (int u_ = 0; u_ < 4; ++u_) *(LAS u32x4*)(KT + (8 * u_ + kq8) * 144 + 16 * c8) = buf[u_]; \
                    const u32x2 pw_ = *(const LAS u32x2*)(PT8 + (r & 3) * 256 + (ks) * 32 + 8 * g); const long pa_ = (long)(((unsigned long long)pw_.y << 32) | pw_.x); \
                    long t0_, t1_, t2_, t3_, t4_, t5_, t6_, t7_; \
                    asm volatile("ds_read_b64_tr_b8 %0, %8\n\tds_read_b64_tr_b8 %1, %8 offset:16\n\tds_read_b64_tr_b8 %2, %8 offset:32\n\tds_read_b64_tr_b8 %3, %8 offset:48\n\t" \
                                 "ds_read_b64_tr_b8 %4, %8 offset:64\n\tds_read_b64_tr_b8 %5, %8 offset:80\n\tds_read_b64_tr_b8 %6, %8 offset:96\n\tds_read_b64_tr_b8 %7, %8 offset:112\n\t" \
                                 "s_waitcnt lgkmcnt(0)" \
                                 : "=&v"(t0_), "=&v"(t1_), "=&v"(t2_), "=&v"(t3_), "=&v"(t4_), "=&v"(t5_), "=&v"(t6_), "=&v"(t7_) : "v"(vt_lane) : "memory"); \
                    __builtin_amdgcn_sched_barrier(0); \
                    Od[0] = __builtin_amdgcn_mfma_f32_16x16x32_fp8_fp8(pa_, t0_, Od[0], 0, 0, 0); Od[1] = __builtin_amdgcn_mfma_f32_16x16x32_fp8_fp8(pa_, t1_, Od[1], 0, 0, 0); \
                    Od[2] = __builtin_amdgcn_mfma_f32_16x16x32_fp8_fp8(pa_, t2_, Od[2], 0, 0, 0); Od[3] = __builtin_amdgcn_mfma_f32_16x16x32_fp8_fp8(pa_, t3_, Od[3], 0, 0, 0); \
                    Od[4] = __builtin_amdgcn_mfma_f32_16x16x32_fp8_fp8(pa_, t4_, Od[4], 0, 0, 0); Od[5] = __builtin_amdgcn_mfma_f32_16x16x32_fp8_fp8(pa_, t5_, Od[5], 0, 0, 0); \
                    Od[6] = __builtin_amdgcn_mfma_f32_16x16x32_fp8_fp8(pa_, t6_, Od[6], 0, 0, 0); Od[7] = __builtin_amdgcn_mfma_f32_16x16x32_fp8_fp8(pa_, t7_, Od[7], 0, 0, 0); } while (0)
#pragma unroll 1
                for (int ks = 0; ks < nst; ks += 2) {
                    DSA_LOADV(kb2, ks + 1); __builtin_amdgcn_sched_barrier(0);
                    DSA_PVSTEP(ka, ks);
                    { const bool lastp_ = (ks + 2 >= nst); if (lastp_) ATT_SELW();
                      DSA_LOADX(ka, lastp_ ? kbase : vbase, lastp_ ? 0 : ks + 2); } __builtin_amdgcn_sched_barrier(0);
                    DSA_PVSTEP(kb2, ks + 1);
                }
                if (g == 0) {
#pragma unroll
                    for (int c = 0; c < 8; ++c)
#pragma unroll
                        for (int i = 0; i < 4; ++i) Pb[i * 128 + c * 16 + r] = Od[c][i] * (1.0f / (P8_SCALE * V8_SCALE));
                }
                asm volatile("s_waitcnt lgkmcnt(0)" ::: "memory");
                { const int kq = lane >> 4, c16 = lane & 15;
                  const f32x4 o0 = *(const LAS f32x4*)(Pb + kq * 128 + 8 * c16), o1 = *(const LAS f32x4*)(Pb + kq * 128 + 8 * c16 + 4);
                  u32x4 w; w.x = pk2(o0[0], o0[1]); w.y = pk2(o0[2], o0[3]); w.z = pk2(o1[0], o1[1]); w.w = pk2(o1[2], o1[3]);
                  *(GAS u32x4*)(O + qrow * 1024 + (kvh * 4 + kq) * 128 + 8 * c16) = w; }
            }
#endif
            asm volatile("s_waitcnt lgkmcnt(0)" ::: "memory");
            asm volatile("s_waitcnt lgkmcnt(0)" ::: "memory");
        }
    }
}

__device__ __forceinline__ float softplus_f(float z) { return fmaxf(z, 0.f) + flog(1.0f + fexp(-fabsf(z))); }
__device__ __forceinline__ void phase_stick(const Frame& F) {
    GAS unsigned char* ws = F.ws;
    const GAS bf16_t* BQ = (const GAS bf16_t*)(ws + WS_Q); const GAS bf16_t* SKV = (const GAS bf16_t*)(ws + WS_SKV); GAS bf16_t* O = (GAS bf16_t*)(ws + WS_O);
    const int lane = F.lane, wave = F.wave, r = lane & 15, g = lane >> 4, kq = lane >> 4, c16 = lane & 15;
    LAS unsigned char* KTs = F.lds + wave * 17408; LAS unsigned char* VTs = KTs + 8704;
    const unsigned vt_lane = (unsigned)(size_t)VTs + (unsigned)((4 * g + (r >> 2)) * 272 + 8 * (r & 3));
    constexpr int NQT = TT / 16;
    constexpr int NH = 2;
    for (int it = F.gw; it < BATCH * (8 / NH) * NQT; it += F.NGW) {
        constexpr int NMAIN = BATCH * (8 / NH) * (NQT - 1);
        const int qt = (it < NMAIN) ? (it % (NQT - 1)) + 1 : 0, hb = (it < NMAIN) ? it / (NQT - 1) : it - NMAIN, head0 = (hb % (8 / NH)) * NH, b = hb / (8 / NH), kvh = head0 >> 2, t0 = qt * 16;
        const size_t rb = (size_t)b * TP;
        bf16x8 Bq[NH][4];
#pragma unroll
        for (int hh = 0; hh < NH; ++hh) { const GAS bf16_t* qp = BQ + (rb + t0 + r) * 1024 + (head0 + hh) * 128 + 32 * g;
#pragma unroll
          for (int ks = 0; ks < 4; ++ks) Bq[hh][ks] = *(const GAS bf16x8*)(qp + ks * 8); }
        f32x4 Oa[NH][8];
#pragma unroll
        for (int hh = 0; hh < NH; ++hh)
#pragma unroll
            for (int dt = 0; dt < 8; ++dt) Oa[hh][dt] = (f32x4){0.f, 0.f, 0.f, 0.f};
        float carry[NH];
#pragma unroll
        for (int hh = 0; hh < NH; ++hh) carry[hh] = 0.f;
        const int qpos = t0 + r;
        const GAS bf16_t* kvb = SKV + rb * 512 + kvh * 128 + 8 * c16;
        for (int kb = t0; kb >= 0; kb -= 32) {
            u32x4 kl[8], vl[8];
#pragma unroll
            for (int u = 0; u < 8; ++u) { int key = kb - 16 + 4 * u + kq; key = key < 0 ? 0 : key; kl[u] = *(const GAS u32x4*)(kvb + (size_t)key * 512); vl[u] = *(const GAS u32x4*)(kvb + (size_t)key * 512 + 256); }
#pragma unroll
            for (int u = 0; u < 8; ++u) { *(LAS u32x4*)(KTs + (4 * u + kq) * 272 + 16 * c16) = kl[u]; *(LAS u32x4*)(VTs + (4 * u + kq) * 272 + 16 * c16) = vl[u]; }
            bool done = true;
            bf16x8 Pbh[NH];
#pragma unroll
            for (int hh = 0; hh < NH; ++hh) {
                float a_hi[4], a_lo[4];
                float zz[2][4], sp[2][4], tot[2];
#pragma unroll
                for (int tl = 0; tl < 2; ++tl) {
                    const int kbase = kb - 16 * tl;
                    f32x4 z = (f32x4){0.f, 0.f, 0.f, 0.f};
#pragma unroll
                    for (int ks = 0; ks < 4; ++ks) z = MFMA16(*(const LAS bf16x8*)(KTs + (16 * (1 - tl) + r) * 272 + g * 64 + ks * 16), Bq[hh][ks], z);
                    float gsum = 0.f;
#pragma unroll
                    for (int i = 0; i < 4; ++i) { const int key = kbase + 4 * g + i; const bool valid = (key >= 0) && (key < qpos);
                        const float zv = z[i] * 0.08838834764831845f; zz[tl][i] = zv; const float s_ = valid ? softplus_f(zv) : 0.f; sp[tl][i] = s_; gsum += s_; }
                    const unsigned gb_ = __builtin_bit_cast(unsigned, gsum);
                    const auto pr_ = __builtin_amdgcn_permlane16_swap(gb_, gb_, false, false);
                    const float od_ = __builtin_bit_cast(float, (unsigned)pr_[1]), pp_ = __builtin_bit_cast(float, (unsigned)pr_[0]) + od_;
                    const unsigned pb_ = __builtin_bit_cast(unsigned, pp_);
                    const auto qr_ = __builtin_amdgcn_permlane32_swap(pb_, pb_, false, false);
                    const float hi_ = __builtin_bit_cast(float, (unsigned)qr_[1]);
                    tot[tl] = __builtin_bit_cast(float, (unsigned)qr_[0]) + hi_;
                    float above = ((g & 1) == 0 ? od_ : 0.f) + (g < 2 ? hi_ : 0.f);
                    float c3 = above + sp[tl][3], c2 = c3 + sp[tl][2], c1 = c2 + sp[tl][1], c0 = c1 + sp[tl][0];
                    sp[tl][3] = c3; sp[tl][2] = c2; sp[tl][1] = c1; sp[tl][0] = c0;
                }
#pragma unroll
                for (int i = 0; i < 4; ++i) {
                    const int khi = kb + 4 * g + i, klo = kb - 16 + 4 * g + i;
                    a_hi[i] = (khi < qpos) ? fexp(zz[0][i] - (carry[hh] + sp[0][i])) : 0.f;
                    a_lo[i] = (klo >= 0 && klo < qpos) ? fexp(zz[1][i] - (carry[hh] + tot[0] + sp[1][i])) : 0.f;
                }
                carry[hh] += tot[0] + tot[1];
                { const unsigned w0 = pk2(a_hi[0], a_hi[1]), w1 = pk2(a_hi[2], a_hi[3]), w2 = pk2(a_lo[0], a_lo[1]), w3 = pk2(a_lo[2], a_lo[3]);
                  const u32x4 w = (u32x4){w0, w1, w2, w3}; Pbh[hh] = __builtin_bit_cast(bf16x8, w); }
                done = done && (carry[hh] > 88.0f);
            }
#pragma unroll
            for (int dh = 0; dh < 8; dh += 4) {
                s16x4 t0_, t1_, t2_, t3_, t4_, t5_, t6_, t7_;
                if (dh == 0) asm volatile("ds_read_b64_tr_b16 %0, %8 offset:4352\n\tds_read_b64_tr_b16 %1, %8\n\tds_read_b64_tr_b16 %2, %8 offset:4384\n\tds_read_b64_tr_b16 %3, %8 offset:32\n\t"
                             "ds_read_b64_tr_b16 %4, %8 offset:4416\n\tds_read_b64_tr_b16 %5, %8 offset:64\n\tds_read_b64_tr_b16 %6, %8 offset:4448\n\tds_read_b64_tr_b16 %7, %8 offset:96\n\ts_waitcnt lgkmcnt(0)"
                             : "=&v"(t0_), "=&v"(t1_), "=&v"(t2_), "=&v"(t3_), "=&v"(t4_), "=&v"(t5_), "=&v"(t6_), "=&v"(t7_) : "v"(vt_lane) : "memory");
                else asm volatile("ds_read_b64_tr_b16 %0, %8 offset:4480\n\tds_read_b64_tr_b16 %1, %8 offset:128\n\tds_read_b64_tr_b16 %2, %8 offset:4512\n\tds_read_b64_tr_b16 %3, %8 offset:160\n\t"
                             "ds_read_b64_tr_b16 %4, %8 offset:4544\n\tds_read_b64_tr_b16 %5, %8 offset:192\n\tds_read_b64_tr_b16 %6, %8 offset:4576\n\tds_read_b64_tr_b16 %7, %8 offset:224\n\ts_waitcnt lgkmcnt(0)"
                             : "=&v"(t0_), "=&v"(t1_), "=&v"(t2_), "=&v"(t3_), "=&v"(t4_), "=&v"(t5_), "=&v"(t6_), "=&v"(t7_) : "v"(vt_lane) : "memory");
                __builtin_amdgcn_sched_barrier(0);
                const bf16x8 V0 = __builtin_shufflevector(t0_, t1_, 0, 1, 2, 3, 4, 5, 6, 7), V1 = __builtin_shufflevector(t2_, t3_, 0, 1, 2, 3, 4, 5, 6, 7), V2 = __builtin_shufflevector(t4_, t5_, 0, 1, 2, 3, 4, 5, 6, 7), V3 = __builtin_shufflevector(t6_, t7_, 0, 1, 2, 3, 4, 5, 6, 7);
#pragma unroll
                for (int hh = 0; hh < NH; ++hh) { Oa[hh][dh] = MFMA16(V0, Pbh[hh], Oa[hh][dh]); Oa[hh][dh + 1] = MFMA16(V1, Pbh[hh], Oa[hh][dh + 1]); Oa[hh][dh + 2] = MFMA16(V2, Pbh[hh], Oa[hh][dh + 2]); Oa[hh][dh + 3] = MFMA16(V3, Pbh[hh], Oa[hh][dh + 3]); }
            }
            if (__all(done)) break;
        }
#pragma unroll
        for (int hh = 0; hh < NH; ++hh) {
            GAS bf16_t* op = O + (rb + t0 + r) * 1024 + (head0 + hh) * 128 + 4 * g;
#pragma unroll
            for (int dt = 0; dt < 8; ++dt) { u32x2 w; w.x = pk2(Oa[hh][dt][0], Oa[hh][dt][1]); w.y = pk2(Oa[hh][dt][2], Oa[hh][dt][3]); *(GAS u32x2*)(op + dt * 16) = w; }
        }
    }
}
#define PE_CE(x_, y_) do { const unsigned hi_ = (x_) > (y_) ? (x_) : (y_), lo_ = (x_) > (y_) ? (y_) : (x_); (x_) = hi_; (y_) = lo_; } while (0)
#define PE_SORT16(a_) do { PE_CE(a_[0], a_[1]); PE_CE(a_[2], a_[3]); PE_CE(a_[4], a_[5]); PE_CE(a_[6], a_[7]); PE_CE(a_[8], a_[9]); PE_CE(a_[10], a_[11]); PE_CE(a_[12], a_[13]); PE_CE(a_[14], a_[15]); PE_CE(a_[0], a_[2]); PE_CE(a_[1], a_[3]); PE_CE(a_[4], a_[6]); PE_CE(a_[5], a_[7]); PE_CE(a_[8], a_[10]); PE_CE(a_[9], a_[11]); PE_CE(a_[12], a_[14]); PE_CE(a_[13], a_[15]); PE_CE(a_[1], a_[2]); PE_CE(a_[5], a_[6]); PE_CE(a_[9], a_[10]); PE_CE(a_[13], a_[14]); PE_CE(a_[0], a_[4]); PE_CE(a_[1], a_[5]); PE_CE(a_[2], a_[6]); PE_CE(a_[3], a_[7]); PE_CE(a_[8], a_[12]); PE_CE(a_[9], a_[13]); PE_CE(a_[10], a_[14]); PE_CE(a_[11], a_[15]); PE_CE(a_[2], a_[4]); PE_CE(a_[3], a_[5]); PE_CE(a_[10], a_[12]); PE_CE(a_[11], a_[13]); PE_CE(a_[1], a_[2]); PE_CE(a_[3], a_[4]); PE_CE(a_[5], a_[6]); PE_CE(a_[9], a_[10]); PE_CE(a_[11], a_[12]); PE_CE(a_[13], a_[14]); PE_CE(a_[0], a_[8]); PE_CE(a_[1], a_[9]); PE_CE(a_[2], a_[10]); PE_CE(a_[3], a_[11]); PE_CE(a_[4], a_[12]); PE_CE(a_[5], a_[13]); PE_CE(a_[6], a_[14]); PE_CE(a_[7], a_[15]); PE_CE(a_[4], a_[8]); PE_CE(a_[5], a_[9]); PE_CE(a_[6], a_[10]); PE_CE(a_[7], a_[11]); PE_CE(a_[2], a_[4]); PE_CE(a_[3], a_[5]); PE_CE(a_[6], a_[8]); PE_CE(a_[7], a_[9]); PE_CE(a_[10], a_[12]); PE_CE(a_[11], a_[13]); PE_CE(a_[1], a_[2]); PE_CE(a_[3], a_[4]); PE_CE(a_[5], a_[6]); PE_CE(a_[7], a_[8]); PE_CE(a_[9], a_[10]); PE_CE(a_[11], a_[12]); PE_CE(a_[13], a_[14]); } while (0)
#define PE_MERGETOP(a_, b_) do { a_[0] = a_[0] > b_[15] ? a_[0] : b_[15]; a_[1] = a_[1] > b_[14] ? a_[1] : b_[14]; a_[2] = a_[2] > b_[13] ? a_[2] : b_[13]; a_[3] = a_[3] > b_[12] ? a_[3] : b_[12]; a_[4] = a_[4] > b_[11] ? a_[4] : b_[11]; a_[5] = a_[5] > b_[10] ? a_[5] : b_[10]; a_[6] = a_[6] > b_[9] ? a_[6] : b_[9]; a_[7] = a_[7] > b_[8] ? a_[7] : b_[8]; a_[8] = a_[8] > b_[7] ? a_[8] : b_[7]; a_[9] = a_[9] > b_[6] ? a_[9] : b_[6]; a_[10] = a_[10] > b_[5] ? a_[10] : b_[5]; a_[11] = a_[11] > b_[4] ? a_[11] : b_[4]; a_[12] = a_[12] > b_[3] ? a_[12] : b_[3]; a_[13] = a_[13] > b_[2] ? a_[13] : b_[2]; a_[14] = a_[14] > b_[1] ? a_[14] : b_[1]; a_[15] = a_[15] > b_[0] ? a_[15] : b_[0]; PE_CE(a_[0], a_[8]); PE_CE(a_[1], a_[9]); PE_CE(a_[2], a_[10]); PE_CE(a_[3], a_[11]); PE_CE(a_[4], a_[12]); PE_CE(a_[5], a_[13]); PE_CE(a_[6], a_[14]); PE_CE(a_[7], a_[15]); PE_CE(a_[0], a_[4]); PE_CE(a_[1], a_[5]); PE_CE(a_[2], a_[6]); PE_CE(a_[3], a_[7]); PE_CE(a_[8], a_[12]); PE_CE(a_[9], a_[13]); PE_CE(a_[10], a_[14]); PE_CE(a_[11], a_[15]); PE_CE(a_[0], a_[2]); PE_CE(a_[1], a_[3]); PE_CE(a_[4], a_[6]); PE_CE(a_[5], a_[7]); PE_CE(a_[8], a_[10]); PE_CE(a_[9], a_[11]); PE_CE(a_[12], a_[14]); PE_CE(a_[13], a_[15]); PE_CE(a_[0], a_[1]); PE_CE(a_[2], a_[3]); PE_CE(a_[4], a_[5]); PE_CE(a_[6], a_[7]); PE_CE(a_[8], a_[9]); PE_CE(a_[10], a_[11]); PE_CE(a_[12], a_[13]); PE_CE(a_[14], a_[15]); } while (0)
constexpr int SCPH = 130;
constexpr int SKP = 272;
constexpr int PE_SC = 0, PE_TOP = 256 * SCPH * 2  , PE_SK = PE_TOP + 16384, PE_END = PE_SK + 2 * 128 * SKP;
__device__ __forceinline__ float gelu_erf(float v) { return 0.5f * v * (1.0f + erff(v * 0.70710678118654752f)); }
__device__ __forceinline__ void phase_peer_route(const Frame& F, int layer, const float* pu_, const float* pv_, const float* ffn_norm_) {
    GAS unsigned char* ws = F.ws;
    const float* pu = pu_ + (size_t)layer * NEXP * 1024; const float* pv = pv_ + (size_t)layer * NEXP * 1024; const float* fng = ffn_norm_ + layer * 1024;
    GAS unsigned char* TU = (GAS unsigned char*)(ws + WS_U) + (size_t)layer * 8 * NEXP * 128; GAS unsigned char* TV = (GAS unsigned char*)(ws + WS_V) + (size_t)layer * 8 * NEXP * 128;
    f32x4 tu[2][4], tv[2][4]; int tdone = 0;
#define TBL_LOAD(e_, ex_) do { const size_t ro_ = (size_t)(ex_) * 1024 + 4 * F.lane; _Pragma("unroll") for (int q = 0; q < 4; ++q) { \
        tu[e_][q] = __builtin_nontemporal_load((const f32x4*)(pu + ro_ + 256 * q)); tv[e_][q] = __builtin_nontemporal_load((const f32x4*)(pv + ro_ + 256 * q)); } } while (0)
#define TBL_STORE(e_, ex_) do { _Pragma("unroll") for (int q = 0; q < 4; ++q) { \
        f32x4 u0 = tu[e_][q] * (*(const f32x4*)(fng + 256 * q + 4 * F.lane) * U_SCALE), v0 = tv[e_][q] * V_SCALE; \
        _Pragma("unroll") for (int k = 0; k < 4; ++k) { u0[k] = __builtin_amdgcn_fmed3f(u0[k], -416.f, 416.f); v0[k] = __builtin_amdgcn_fmed3f(v0[k], -416.f, 416.f); } \
        int wu = __builtin_amdgcn_cvt_pk_fp8_f32(u0[0], u0[1], 0, false); wu = __builtin_amdgcn_cvt_pk_fp8_f32(u0[2], u0[3], wu, true); \
        int wv = __builtin_amdgcn_cvt_pk_fp8_f32(v0[0], v0[1], 0, false); wv = __builtin_amdgcn_cvt_pk_fp8_f32(v0[2], v0[3], wv, true); \
        const size_t so_ = (((size_t)(2 * q + (F.lane >> 5))) * NEXP + (ex_)) * 128 + 4 * (F.lane & 31); \
        *(GAS unsigned*)(TU + so_) = (unsigned)wu; *(GAS unsigned*)(TV + so_) = (unsigned)wv; } } while (0)
    const GAS bf16_t* PQ = (const GAS bf16_t*)(ws + WS_PROJ); const GAS bf16_t* SK = (const GAS bf16_t*)(ws + WS_SK) + (size_t)layer * 2 * 128 * 128;
    LAS unsigned* TOPL = (LAS unsigned*)(F.lds + PE_TOP);
    const GAS _Float16* SCG = (const GAS _Float16*)(ws + WS_PROJ);
    GAS bf16_t* RIDG = (GAS bf16_t*)(ws + WS_RID); GAS bf16_t* RIDT = (GAS bf16_t*)(ws + WS_RIDT); GAS float* RGG = (GAS float*)(ws + WS_RG);
    const int lane = F.lane, wave = F.wave, tid = F.tid, r = lane & 15, g = lane >> 4;
    constexpr int NMAIN = BATCH * (SEQ / 16), NIT = NMAIN + BATCH * 4;
    u32x4 svn[8];
#define RT_SVLOAD(it__) do { const int ic_ = (it__) < NIT ? (it__) : NIT - 1; const bool fl_ = ic_ < NMAIN; \
        const int b_ = fl_ ? ic_ / (SEQ / 16) : (ic_ - NMAIN) >> 2, tb_ = fl_ ? 1 + ic_ % (SEQ / 16) : 0, t0_ = fl_ ? 0 : 4 * ((ic_ - NMAIN) & 3); \
        const int li_ = t0_ * 16 + (tid >> 1); const GAS _Float16* gp_ = SCG + ((size_t)b_ * TP + tb_ * 16 + (li_ >> 4)) * 2048 + (li_ & 15) * 128 + 64 * (tid & 1); \
        _Pragma("unroll") for (int q = 0; q < 8; ++q) svn[q] = *(const GAS u32x4*)(gp_ + 8 * q); } while (0)
    RT_SVLOAD((int)blockIdx.x);
    for (int it = blockIdx.x; it < NIT; it += F.G) {
        const bool fullit = it < NMAIN;
        const int b = fullit ? it / (SEQ / 16) : (it - NMAIN) >> 2, tb = fullit ? 1 + it % (SEQ / 16) : 0, tok0 = fullit ? 0 : 4 * ((it - NMAIN) & 3), ntok = fullit ? 16 : 4;
        const size_t row0 = (size_t)b * TP + tb * 16;
#ifndef PROBE_ROUTE
#define PROBE_ROUTE 0
#endif
        const int tex0 = F.gw + tdone * F.NGW, tex1 = tex0 + F.NGW;
        {
            const int list = tok0 * 16 + (tid >> 1), half = tid & 1;
            u32x4 sv[8];
#pragma unroll
            for (int q = 0; q < 8; ++q) sv[q] = svn[q];
            asm volatile("" :: "v"(sv[0]), "v"(sv[1]), "v"(sv[2]), "v"(sv[3]), "v"(sv[4]), "v"(sv[5]), "v"(sv[6]), "v"(sv[7]));
            RT_SVLOAD(it + F.G);
            TBL_LOAD(0, tex0 < NEXP ? tex0 : NEXP - 1); TBL_LOAD(1, tex1 < NEXP ? tex1 : NEXP - 1);
            __builtin_amdgcn_sched_barrier(0);
            unsigned a[16], b[16];
#define PE_KEYS(dst_, grp_) do { _Pragma("unroll") for (int j_ = 0; j_ < 8; ++j_) { const int k_ = 16 * (grp_) + 2 * j_; const unsigned wd_ = sv[k_ >> 3][(k_ >> 1) & 3]; \
                const unsigned sg_ = (wd_ >> 15) & 0x00010001u; const unsigned mk_ = wd_ ^ (((sg_ << 15) - sg_) | 0x80008000u); \
                dst_[2 * j_] = (mk_ << 16) | (unsigned)(127 - (64 * half + k_)); dst_[2 * j_ + 1] = (mk_ & 0xffff0000u) | (unsigned)(127 - (64 * half + k_ + 1)); } } while (0)
            PE_KEYS(a, 0); PE_SORT16(a);
            PE_KEYS(b, 1); PE_SORT16(b); PE_MERGETOP(a, b);
            PE_KEYS(b, 2); PE_SORT16(b); PE_MERGETOP(a, b);
            PE_KEYS(b, 3); PE_SORT16(b); PE_MERGETOP(a, b);
#pragma unroll
            for (int i = 0; i < 16; ++i) b[i] = (unsigned)__builtin_amdgcn_update_dpp(0, (int)a[i], 0xB1, 0xf, 0xf, false);
            PE_MERGETOP(a, b);
            if (!half && tid < ntok * 32) {
#pragma unroll
                for (int i = 0; i < 16; ++i) TOPL[list * 16 + i] = a[i];
            }
        }
        __syncthreads();
        for (int rp = 0; rp < ((PROBE_ROUTE & 4) ? 2 : 1); ++rp)
        if (tid < ntok * 8) {
            const int token = tok0 + (tid >> 3), h = tid & 7;
            const LAS unsigned* L1 = TOPL + (token * 16 + h * 2) * 16; const LAS unsigned* L2 = L1 + 16;
            float v1[16], v2[16];
#pragma unroll
            for (int i = 0; i < 16; ++i) { const unsigned k1 = L1[i] >> 16, k2 = L2[i] >> 16;
                v1[i] = (float)__builtin_bit_cast(_Float16, (unsigned short)((k1 & 0x8000u) ? (k1 ^ 0x8000u) : (k1 ^ 0xffffu))); v2[i] = (float)__builtin_bit_cast(_Float16, (unsigned short)((k2 & 0x8000u) ? (k2 ^ 0x8000u) : (k2 ^ 0xffffu))); }
#define PE_CKEY(ia_, ib_) ((mono_key(v1[ia_] + v2[ib_]) & ~255u) | (unsigned)(255 - ((ia_) * 16 + (ib_))))
            unsigned cc[16], cb[16];
#pragma unroll
            for (int i = 0; i < 16; ++i) cc[i] = PE_CKEY(0, i);
#pragma unroll
            for (int i = 0; i < 16; ++i) cb[i] = (i < 8) ? PE_CKEY(1, i) : 0u;
            PE_MERGETOP(cc, cb);
            cb[0] = PE_CKEY(2, 0); cb[1] = PE_CKEY(2, 1); cb[2] = PE_CKEY(2, 2); cb[3] = PE_CKEY(2, 3); cb[4] = PE_CKEY(2, 4); cb[5] = PE_CKEY(3, 0); cb[6] = PE_CKEY(3, 1); cb[7] = PE_CKEY(3, 2);
            cb[8] = PE_CKEY(3, 3); cb[9] = PE_CKEY(4, 0); cb[10] = PE_CKEY(4, 1); cb[11] = PE_CKEY(4, 2); cb[12] = PE_CKEY(5, 0); cb[13] = PE_CKEY(5, 1); cb[14] = PE_CKEY(6, 0); cb[15] = PE_CKEY(6, 1);
            PE_SORT16(cb); PE_MERGETOP(cc, cb);
            cb[0] = PE_CKEY(7, 0); cb[1] = PE_CKEY(7, 1);
#pragma unroll
            for (int i = 0; i < 8; ++i) cb[2 + i] = PE_CKEY(8 + i, 0);
#pragma unroll
            for (int i = 10; i < 16; ++i) cb[i] = 0u;
            PE_SORT16(cb); PE_MERGETOP(cc, cb);
            const float bmax = unmono_key(cc[0] & ~255u);
            float e[16], esum = 0.f;
#pragma unroll
            for (int i = 0; i < 16; ++i) { e[i] = fexp(unmono_key(cc[i] & ~255u) - bmax); esum += e[i]; }
            const float inv = __builtin_amdgcn_rcpf(esum);
            unsigned idw[8];
#pragma unroll
            for (int i = 0; i < 16; ++i) {
                const int flat = 255 - (int)(cc[i] & 255u), ia = flat >> 4, ib = flat & 15;
                const int i1 = 127 - (int)(L1[ia] & 127u), i2 = 127 - (int)(L2[ib] & 127u);
                const unsigned id = (unsigned)(i1 * 128 + i2);
                if (i & 1) idw[i >> 1] |= id << 16; else idw[i >> 1] = id;
                RGG[(row0 + token) * 128 + i * 8 + h] = e[i] * inv;
            }
            { GAS u32x4* rp = (GAS u32x4*)(RIDG + (row0 + token) * 128 + h * 16);
              rp[0] = (u32x4){idw[0], idw[1], idw[2], idw[3]}; rp[1] = (u32x4){idw[4], idw[5], idw[6], idw[7]}; }
        }
        if (tex0 < NEXP) TBL_STORE(0, tex0);
        if (tex1 < NEXP) TBL_STORE(1, tex1);
        tdone += 2;
        __syncthreads();
    }
#pragma unroll 1
    for (int ex = F.gw + tdone * F.NGW; ex < NEXP; ex += F.NGW) { TBL_LOAD(0, ex); TBL_STORE(0, ex); }
}

constexpr int NTOK = BATCH * TT;
#define XCC_FRAME() volatile LAS unsigned* MISC_ = (volatile LAS unsigned*)(F.lds + MISC_OFF); \
    const int xp = (int)MISC_[4], nx = (int)MISC_[5], wrank = (int)MISC_[6] * NWAVES + F.wave, nw = (int)MISC_[7] * NWAVES
__device__ __forceinline__ unsigned id_of(const u32x4& a, const u32x4& b, int k) {
    const unsigned w = (k < 8) ? a[(k >> 1) & 3] : b[(k >> 1) & 3]; return (k & 1) ? (w >> 16) : (w & 0xffffu);
}
#define FP8X2(w, hi) __builtin_amdgcn_cvt_pk_f32_fp8((int)(w), hi)
__device__ __forceinline__ size_t tok_row(int tokn) { const int bsel = tokn / TT; return (size_t)bsel * TP + (tokn - bsel * TT); }
#define LDG16(base, off) (*(const GAS u32x4*)((const GAS unsigned char*)(base) + (unsigned)(off)))
__device__ __forceinline__ void phase_peer_u(const Frame& F, int layer, unsigned idmask = 0xffffu) {
    GAS unsigned char* ws = F.ws;
    const GAS unsigned char* X8 = ws + WS_HB8; const GAS unsigned char* RIDb = ws + WS_RID;
    const int lane = F.lane, j = lane >> 3, c = lane & 7, r = lane & 15, g = lane >> 4;
    LAS unsigned char* MET = F.lds + F.wave * 1024;
    LAS unsigned char* TIL = F.lds + 8192 + F.wave * 9216;
    XCC_FRAME();
#pragma unroll 1
    for (int s = xp; s < 8; s += nx) {
        const GAS unsigned char* Us = ws + WS_U + ((size_t)layer * 8 + s) * NEXP * 128;
        GAS unsigned char* Ps = ws + WS_PART + (size_t)s * NR * 128 * 2;
        const unsigned uo = 16u * c;
#define PU_FETCH(tk) do { const int tk_ = (tk) < NTOK ? (tk) : NTOK - 1; const unsigned r_ = (unsigned)tok_row(tk_); \
        pid = *(const GAS unsigned*)(RIDb + (r_ * 256u + 4u * lane)); px = *(const GAS unsigned*)(X8 + (r_ * 1024u + 128u * s + 4u * (lane & 31))); } while (0)
#define PU_STAGE(slot) do { *(LAS unsigned*)(MET + (slot) * 512 + 4 * lane) = pid; if (lane < 32) *(LAS unsigned*)(MET + (slot) * 512 + 256 + 4 * lane) = px; } while (0)
#define PU_GATHER(buf, slot) do { const u32x4 ia_ = *(const LAS u32x4*)(MET + (slot) * 512 + 32 * j), ib_ = *(const LAS u32x4*)(MET + (slot) * 512 + 32 * j + 16); \
        _Pragma("unroll") for (int b_ = 0; b_ < 16; ++b_) buf[b_] = LDG16(Us, (id_of(ia_, ib_, b_) & idmask) * 128u + uo); } while (0)
#define PU_STEP(cur, nxt) do { const unsigned row = (unsigned)tok_row(tokn); const int sl = it & 1; \
        PU_STAGE(sl ^ 1); PU_GATHER(nxt, sl ^ 1); PU_FETCH(tokn + 2 * nw); \
        const u32x4 xa = *(const LAS u32x4*)(MET + sl * 512 + 256 + 32 * g), xb = *(const LAS u32x4*)(MET + sl * 512 + 256 + 32 * g + 16); \
        const long x0 = (long)(((unsigned long long)xa.y << 32) | xa.x), x1 = (long)(((unsigned long long)xa.w << 32) | xa.z), x2 = (long)(((unsigned long long)xb.y << 32) | xb.x), x3 = (long)(((unsigned long long)xb.w << 32) | xb.z); \
        __builtin_amdgcn_sched_barrier(0); \
        f32x4 outv = (f32x4){0.f, 0.f, 0.f, 0.f}; \
        _Pragma("unroll") for (int hf = 0; hf < 2; ++hf) { \
            _Pragma("unroll") for (int b = 0; b < 8; ++b) *(LAS u32x4*)(TIL + ((b >> 1) * 16 + (b & 1) * 8 + j) * 144 + 16 * c) = cur[8 * hf + b]; \
            _Pragma("unroll") for (int tl = 0; tl < 4; ++tl) { \
                const u32x4 k0 = *(const LAS u32x4*)(TIL + (tl * 16 + r) * 144 + 32 * g), k1 = *(const LAS u32x4*)(TIL + (tl * 16 + r) * 144 + 32 * g + 16); \
                f32x4 d = (f32x4){0.f, 0.f, 0.f, 0.f}; \
                d = __builtin_amdgcn_mfma_f32_16x16x32_fp8_fp8((long)(((unsigned long long)k0.y << 32) | k0.x), x0, d, 0, 0, 0); \
                d = __builtin_amdgcn_mfma_f32_16x16x32_fp8_fp8((long)(((unsigned long long)k0.w << 32) | k0.z), x1, d, 0, 0, 0); \
                d = __builtin_amdgcn_mfma_f32_16x16x32_fp8_fp8((long)(((unsigned long long)k1.y << 32) | k1.x), x2, d, 0, 0, 0); \
                d = __builtin_amdgcn_mfma_f32_16x16x32_fp8_fp8((long)(((unsigned long long)k1.w << 32) | k1.z), x3, d, 0, 0, 0); \
                if (r == 4 * hf + tl) outv = d; } } \
        if (r < 8) *(GAS u32x2*)(Ps + (row * 256u + 32u * r + 8u * g)) = (u32x2){pk2(outv[0], outv[1]), pk2(outv[2], outv[3])};        \
        tokn += nw; ++it; } while (0)
        unsigned pid, px; int it = 0, tokn = wrank;
        u32x4 uA[16], uB[16];
        PU_FETCH(wrank); PU_STAGE(0); PU_GATHER(uA, 0); PU_FETCH(wrank + nw);
#pragma unroll 1
        while (tokn < NTOK) {
            PU_STEP(uA, uB);
            if (tokn >= NTOK) break;
            PU_STEP(uB, uA);
        }
    }
}
__device__ __forceinline__ void phase_peer_act(const Frame& F) {
    GAS unsigned char* ws = F.ws;
    const GAS bf16_t* PARTB = (const GAS bf16_t*)(ws + WS_PART); const GAS float* RGG = (const GAS float*)(ws + WS_RG); const GAS float* SS = (const GAS float*)(ws + WS_SS); GAS unsigned char* ACT8 = ws + WS_ACT;
    const int n4 = NTOK * 32;
    u32x2 pwn[8]; f32x4 ssn[4], gtn;
#define ACT_FETCH(i__) do { const int ic_ = (i__) < n4 ? (i__) : n4 - 1; const int tk_ = ic_ >> 5, bs_ = tk_ / TT; const size_t rw_ = (size_t)bs_ * TP + (tk_ - bs_ * TT), o_ = rw_ * 128 + 4 * (ic_ & 31); \
        _Pragma("unroll") for (int s = 0; s < 8; ++s) pwn[s] = *(const GAS u32x2*)(PARTB + (size_t)s * NR * 128 + o_); \
        _Pragma("unroll") for (int s = 0; s < 4; ++s) ssn[s] = *(const GAS f32x4*)(SS + rw_ * 16 + 4 * s); gtn = *(const GAS f32x4*)(RGG + o_); } while (0)
    ACT_FETCH((int)blockIdx.x * NT + F.tid);
    for (int i = (int)blockIdx.x * NT + F.tid; i < n4; i += F.G * NT) {
        const int tokn = (int)(i >> 5), q4 = (int)(i & 31); const int bsel = tokn / TT; const size_t row = (size_t)bsel * TP + (tokn - bsel * TT);
        const size_t o = row * 128 + 4 * q4;
        u32x2 pw[8]; f32x4 ssv[4]; const f32x4 gt0 = gtn;
#pragma unroll
        for (int s = 0; s < 8; ++s) pw[s] = pwn[s];
#pragma unroll
        for (int s = 0; s < 4; ++s) ssv[s] = ssn[s];
        asm volatile("" :: "v"(pw[0]), "v"(pw[7]), "v"(ssv[0]), "v"(ssv[3]), "v"(gt0));
        ACT_FETCH(i + F.G * NT);
        __builtin_amdgcn_sched_barrier(0);
        f32x4 acc = (f32x4){0.f, 0.f, 0.f, 0.f};
#pragma unroll
        for (int s = 0; s < 8; ++s) { acc[0] += __builtin_bit_cast(float, pw[s].x << 16); acc[1] += __builtin_bit_cast(float, pw[s].x & 0xffff0000u); acc[2] += __builtin_bit_cast(float, pw[s].y << 16); acc[3] += __builtin_bit_cast(float, pw[s].y & 0xffff0000u); }
        const float ssum = ((ssv[0][0] + ssv[0][1]) + (ssv[0][2] + ssv[0][3])) + ((ssv[1][0] + ssv[1][1]) + (ssv[1][2] + ssv[1][3])) + ((ssv[2][0] + ssv[2][1]) + (ssv[2][2] + ssv[2][3])) + ((ssv[3][0] + ssv[3][1]) + (ssv[3][2] + ssv[3][3]));
        const float ri = __builtin_amdgcn_rsqf(ssum * (1.0f / 1024.0f) + RMS_EPS) * (1.0f / (U_SCALE * X_SCALE)); const f32x4 gt = gt0 * ACT_SCALE;
        float a4[4];
#pragma unroll
        for (int e = 0; e < 4; ++e) a4[e] = __builtin_amdgcn_fmed3f(gelu_erf(acc[e] * ri) * gt[e], -416.f, 416.f);
        int w8 = __builtin_amdgcn_cvt_pk_fp8_f32(a4[0], a4[1], 0, false); w8 = __builtin_amdgcn_cvt_pk_fp8_f32(a4[2], a4[3], w8, true);
        *(GAS unsigned*)(ACT8 + o) = (unsigned)w8;
    }
}
__device__ __forceinline__ void phase_peer_v(const Frame& F, int layer, float* dout, size_t dry_off = 0) {
    GAS unsigned char* ws = F.ws;
    const GAS unsigned char* RIDb = ws + WS_RID; const GAS unsigned char* ACTb = ws + WS_ACT;
    GAS unsigned char* Hb = ws + WS_H + dry_off; GAS unsigned char* HBb = ws + WS_HB + dry_off; GAS float* SS = (GAS float*)(ws + WS_SS + dry_off);
    const int lane = F.lane, j = lane >> 3, c = lane & 7, r = lane & 15, g = lane >> 4;
    LAS unsigned char* MET = F.lds + F.wave * 1024;
    LAS unsigned char* TIL = F.lds + 8192 + F.wave * 18432;
    LAS float* OUTL = (LAS float*)(F.lds + 8192 + 8 * 18432) + F.wave * 128;
    const unsigned vt_lane = (unsigned)(size_t)TIL + (unsigned)((8 * g + TRB8_ROW(r)) * 144 + 8 * TRB8_COL(r));
    XCC_FRAME();
#pragma unroll 1
    for (int s = xp; s < 8; s += nx) {
        const GAS unsigned char* Vs = ws + WS_V + ((size_t)layer * 8 + s) * NEXP * 128;
        const unsigned vo = 16u * c;
#define PV_FETCH(tk) do { const int tk_ = (tk) < NTOK ? (tk) : NTOK - 1; const unsigned r_ = (unsigned)tok_row(tk_); \
        pid = *(const GAS unsigned*)(RIDb + (r_ * 256u + 4u * lane)); pact = *(const GAS unsigned*)(ACTb + (r_ * 128u + 4u * (lane & 31))); } while (0)
#define PV_STAGE(slot) do { *(LAS unsigned*)(MET + (slot) * 512 + 4 * lane) = pid; if (lane < 32) *(LAS unsigned*)(MET + (slot) * 512 + 256 + 4 * lane) = pact; } while (0)
#define PV_GATHER(slot) do { const u32x4 ia_ = *(const LAS u32x4*)(MET + (slot) * 512 + 32 * j), ib_ = *(const LAS u32x4*)(MET + (slot) * 512 + 32 * j + 16); \
        _Pragma("unroll") for (int b_ = 0; b_ < 16; ++b_) v[b_] = LDG16(Vs, id_of(ia_, ib_, b_) * 128u + vo); } while (0)
#define PV_TR(ASM_) asm volatile(ASM_ : "=&v"(t0_), "=&v"(t1_), "=&v"(t2_), "=&v"(t3_), "=&v"(t4_), "=&v"(t5_), "=&v"(t6_), "=&v"(t7_) : "v"(vt_lane) : "memory")
#define PV_STORES() do { const unsigned col_ = 128u * s + 16u * c + 2u * j; \
        *(GAS unsigned*)(HBb + (row_p * 2048u + col_ * 2u)) = pk2(hv_p.x, hv_p.y); \
        if (lane == 0) { SS[(size_t)row_p * 16 + s] = sq_p; SS[(size_t)row_p * 16 + 8 + s] = 0.f; } \
        if (dout && tsel_p >= NMETA) *(f32x2*)(dout + ((size_t)bsel_p * SEQ + (tsel_p - NMETA)) * 1024 + col_) = hv_p; } while (0)
        unsigned pid, pact; int it = 0;
        u32x4 v[16];
        f32x2 hv_p = (f32x2){0.f, 0.f}; float sq_p = 0.f; unsigned row_p = 0; int tsel_p = 0, bsel_p = 0;
        PV_FETCH(wrank); PV_STAGE(0); PV_GATHER(0); PV_FETCH(wrank + nw);
#pragma unroll 1
        for (int tokn = wrank; tokn < NTOK; tokn += nw, ++it) {
            const int bsel = tokn / TT, tsel = tokn - bsel * TT; const unsigned row = (unsigned)(bsel * TP + tsel);
            const int sl = it & 1;
            const unsigned col = 128u * s + 16u * c + 2u * j;
            PV_STAGE(sl ^ 1);
#pragma unroll
            for (int b = 0; b < 16; ++b) *(LAS u32x4*)(TIL + (8 * b + j) * 144 + 16 * c) = v[b];
            const unsigned hold = *(const GAS unsigned*)(HBb + (row * 2048u + col * 2u));
            __builtin_amdgcn_sched_barrier(0);
            PV_GATHER(sl ^ 1);
            PV_FETCH(tokn + 2 * nw);
            __builtin_amdgcn_sched_barrier(0);
            if (it > 0) PV_STORES();
            __builtin_amdgcn_sched_barrier(0);
            f32x4 Od[8];
#pragma unroll
            for (int cc = 0; cc < 8; ++cc) Od[cc] = (f32x4){0.f, 0.f, 0.f, 0.f};
#pragma unroll
            for (int ks = 0; ks < 4; ++ks) {
                const u32x2 aw = *(const LAS u32x2*)(MET + sl * 512 + 256 + 32 * ks + 8 * g); const long pa = (long)(((unsigned long long)aw.y << 32) | aw.x);
                long t0_, t1_, t2_, t3_, t4_, t5_, t6_, t7_;
                if (ks == 0) PV_TR("ds_read_b64_tr_b8 %0, %8 offset:0\n\tds_read_b64_tr_b8 %1, %8 offset:16\n\tds_read_b64_tr_b8 %2, %8 offset:32\n\tds_read_b64_tr_b8 %3, %8 offset:48\n\tds_read_b64_tr_b8 %4, %8 offset:64\n\tds_read_b64_tr_b8 %5, %8 offset:80\n\tds_read_b64_tr_b8 %6, %8 offset:96\n\tds_read_b64_tr_b8 %7, %8 offset:112\n\ts_waitcnt lgkmcnt(0)"); else if (ks == 1) PV_TR("ds_read_b64_tr_b8 %0, %8 offset:4608\n\tds_read_b64_tr_b8 %1, %8 offset:4624\n\tds_read_b64_tr_b8 %2, %8 offset:4640\n\tds_read_b64_tr_b8 %3, %8 offset:4656\n\tds_read_b64_tr_b8 %4, %8 offset:4672\n\tds_read_b64_tr_b8 %5, %8 offset:4688\n\tds_read_b64_tr_b8 %6, %8 offset:4704\n\tds_read_b64_tr_b8 %7, %8 offset:4720\n\ts_waitcnt lgkmcnt(0)"); else if (ks == 2) PV_TR("ds_read_b64_tr_b8 %0, %8 offset:9216\n\tds_read_b64_tr_b8 %1, %8 offset:9232\n\tds_read_b64_tr_b8 %2, %8 offset:9248\n\tds_read_b64_tr_b8 %3, %8 offset:9264\n\tds_read_b64_tr_b8 %4, %8 offset:9280\n\tds_read_b64_tr_b8 %5, %8 offset:9296\n\tds_read_b64_tr_b8 %6, %8 offset:9312\n\tds_read_b64_tr_b8 %7, %8 offset:9328\n\ts_waitcnt lgkmcnt(0)"); else PV_TR("ds_read_b64_tr_b8 %0, %8 offset:13824\n\tds_read_b64_tr_b8 %1, %8 offset:13840\n\tds_read_b64_tr_b8 %2, %8 offset:13856\n\tds_read_b64_tr_b8 %3, %8 offset:13872\n\tds_read_b64_tr_b8 %4, %8 offset:13888\n\tds_read_b64_tr_b8 %5, %8 offset:13904\n\tds_read_b64_tr_b8 %6, %8 offset:13920\n\tds_read_b64_tr_b8 %7, %8 offset:13936\n\ts_waitcnt lgkmcnt(0)");
                __builtin_amdgcn_sched_barrier(0);
                Od[0] = __builtin_amdgcn_mfma_f32_16x16x32_fp8_fp8(pa, t0_, Od[0], 0, 0, 0); Od[1] = __builtin_amdgcn_mfma_f32_16x16x32_fp8_fp8(pa, t1_, Od[1], 0, 0, 0);
                Od[2] = __builtin_amdgcn_mfma_f32_16x16x32_fp8_fp8(pa, t2_, Od[2], 0, 0, 0); Od[3] = __builtin_amdgcn_mfma_f32_16x16x32_fp8_fp8(pa, t3_, Od[3], 0, 0, 0);
                Od[4] = __builtin_amdgcn_mfma_f32_16x16x32_fp8_fp8(pa, t4_, Od[4], 0, 0, 0); Od[5] = __builtin_amdgcn_mfma_f32_16x16x32_fp8_fp8(pa, t5_, Od[5], 0, 0, 0);
                Od[6] = __builtin_amdgcn_mfma_f32_16x16x32_fp8_fp8(pa, t6_, Od[6], 0, 0, 0); Od[7] = __builtin_amdgcn_mfma_f32_16x16x32_fp8_fp8(pa, t7_, Od[7], 0, 0, 0);
            }
            if (g == 0) {
#pragma unroll
                for (int cc = 0; cc < 8; ++cc) OUTL[16 * cc + r] = Od[cc][0];
            }
            asm volatile("s_waitcnt lgkmcnt(0)" ::: "memory");
            const f32x2 o2 = *(const LAS f32x2*)(OUTL + 16 * c + 2 * j);
            hv_p.x = __builtin_bit_cast(float, hold << 16) + o2.x * (1.0f / (ACT_SCALE * V_SCALE)); hv_p.y = __builtin_bit_cast(float, hold & 0xffff0000u) + o2.y * (1.0f / (ACT_SCALE * V_SCALE));
            sq_p = wave_sum_dpp_f(hv_p.x * hv_p.x + hv_p.y * hv_p.y); row_p = row; tsel_p = tsel; bsel_p = bsel;
        }
        if (it > 0) PV_STORES();
    }
}

#define PHASE_FRAME() Frame F; { unsigned long long ws_ = wsu; asm volatile("" : "+s"(ws_)); int tid_ = threadIdx.x; asm volatile("" : "+v"(tid_)); \
    F.lds = (LAS unsigned char*)lds; F.ws = (GAS unsigned char*)ws_; F.tid = tid_; F.lane = tid_ & 63; F.wave = __builtin_amdgcn_readfirstlane(tid_ >> 6); F.G = gridDim.x; F.gw = blockIdx.x * NWAVES + F.wave; F.NGW = F.G * NWAVES; } \
    GAS unsigned char* ws = F.ws; (void)ws
__global__ void __launch_bounds__(NT, 2) mk_fwd(Args a) {
    extern __shared__ __attribute__((aligned(16))) unsigned char lds[];
    unsigned long long wsu = (unsigned long long)a.ws; asm volatile("" : "+s"(wsu));
    unsigned long long outu = (unsigned long long)a.out; asm volatile("" : "+s"(outu));
    volatile LAS unsigned* MISC = (volatile LAS unsigned*)((LAS unsigned char*)lds + MISC_OFF);
    if (threadIdx.x < 16) MISC[threadIdx.x] = 0u;
    __syncthreads();
    XcdBarrier bar = xcd_barrier_post((unsigned*)((unsigned char*)wsu + WS_CTL), MISC);
    if (threadIdx.x == 0) MISC[6] = xb_add((unsigned*)((unsigned char*)wsu + WS_CTL + CTL_XRANK) + 64 * bar.x, 1u);
    PG8_LAS unsigned char* glds = (PG8_LAS unsigned char*)lds;

#ifndef PROBE_DUP
#define PROBE_DUP 0
#endif
    constexpr size_t DRY_OFF = WS_END - WS_H;
    { PHASE_FRAME(); phase_prologue(F, a); }
    xcd_barrier(bar);
    if (threadIdx.x == 0) {
        unsigned nx = 0, xp = 0, xn = 1;
        for (unsigned j = 0; j < 16; ++j) { const unsigned c = xb_ld((unsigned*)((unsigned char*)wsu + WS_CTL + CTL_XRANK) + 64 * j); if (j == bar.x) { xp = nx; xn = c ? c : 1u; } nx += (c > 0u) ? 1u : 0u; }
        MISC[4] = xp; MISC[5] = nx ? nx : 1u; MISC[7] = xn;
    }
    __syncthreads();
    if (PROBE_DUP & 1) { { PHASE_FRAME(); phase_prologue(F, a); } xcd_barrier(bar); }
#pragma unroll 1
    for (int layer = 0; layer < 4; ++layer) {
        for (int rep = 0; rep < ((PROBE_DUP & 2) ? 2 : 1); ++rep) {
            PHASE_FRAME();
            const GAS bf16_t* Bt; int N; EpiScale E;
            E.ss = (const GAS float*)(ws + WS_SS); E.vT = nullptr;
            if (layer < 2) { Bt = (const GAS bf16_t*)(ws + WS_WIN) + (size_t)layer * 2048 * 1024; N = 2048; E.O0 = (GAS bf16_t*)(ws + WS_PROJ); E.ld0 = 2048; E.split = 2048; E.O1 = E.O0; E.ld1 = 2048; }
            else if (layer == 2) { Bt = (const GAS bf16_t*)(ws + WS_WKVQ); N = 1536; E.O0 = (GAS bf16_t*)(ws + WS_SKV); E.ld0 = 512; E.split = 512; E.O1 = (GAS bf16_t*)(ws + WS_Q); E.ld1 = 1024; }
            else { Bt = (const GAS bf16_t*)(ws + WS_WBQ1); N = 1024; E.O0 = (GAS bf16_t*)(ws + WS_Q); E.ld0 = 1024; E.split = 1024; E.O1 = E.O0; E.ld1 = 1024; }
            pg8::Gemm gm{(const bf16_t*)(ws + WS_HB), (const bf16_t*)Bt, BATCH * SEQ, N, 1024}; pg8::StaticOrder S; S.init(BATCH * SEQ, N, F.G, (int)blockIdx.x);
            { LAS float* RINV = (LAS float*)(F.lds + 131072); LAS int* PML = (LAS int*)(F.lds + 131072 + 4096);
              _Pragma("unroll") for (int q = 0; q < 4; ++q) { const int pmq = unit_pm_of(S, q); if (F.tid == 0) PML[q] = pmq;
                  if (pmq >= 0 && F.tid < 256) RINV[q * 256 + F.tid] = row_rinv((const GAS float*)(ws + WS_SS), pg8::tile_row(pmq) + F.tid); }
              __syncthreads(); E.rinv_lds = RINV; E.pm_lds = PML; }
            pg8::gemm_phase<EpiScale, pg8::StaticOrder>(glds, gm, S, E);
            gemm_tail<EpiScale>((const GAS bf16_t*)(ws + WS_HB), Bt, N, E, F.gw, F.NGW, F.lane, F.lds);
            if (layer == 2 && (int)blockIdx.x >= F.G / 2) { __syncthreads(); p0_deferred(F, a, ((int)blockIdx.x - F.G / 2) * NWAVES + F.wave, (F.G - F.G / 2) * NWAVES); }
            if (rep == 0 && (PROBE_DUP & 2)) xcd_barrier(bar);
        }
        xcd_barrier(bar);
        if (layer < 2) {
            for (int rep = 0; rep < ((PROBE_DUP & 4) ? 2 : 1); ++rep) {
            { PHASE_FRAME(); phase_a_post(F, a.in[4] + layer * 128, a.in[5] + layer * 128); }
            xcd_barrier(bar);
            for (int rep2 = 0; rep2 < ((PROBE_DUP & 512) ? 2 : 1); ++rep2) { { PHASE_FRAME(); phase_dsa_sel(F); } xcd_barrier(bar); }
            for (int rep2 = 0; rep2 < ((PROBE_DUP & 1024) ? 2 : 1); ++rep2) { { PHASE_FRAME(); phase_dsa_attn(F); } if (rep2 == 0 && (PROBE_DUP & 1024)) xcd_barrier(bar); }
            if (rep == 0 && (PROBE_DUP & 4)) xcd_barrier(bar);
            }
        } else {
            for (int rep = 0; rep < ((PROBE_DUP & 8) ? 2 : 1); ++rep) {
            PHASE_FRAME(); phase_stick(F);
            if (rep == 0 && (PROBE_DUP & 8)) xcd_barrier(bar);
            }
        }
        xcd_barrier(bar);
        for (int rep = ((PROBE_DUP & 16) ? 1 : 0); rep >= 0; --rep) {
            PHASE_FRAME();
            const GAS bf16_t* Bt = (layer < 2) ? (const GAS bf16_t*)(ws + WS_WOA) + (size_t)layer * 1024 * 1024 : (const GAS bf16_t*)(ws + WS_WOB) + (size_t)(layer - 2) * 1024 * 1024;
            EpiResid E; E.H = (GAS float*)(ws + WS_H + (rep ? DRY_OFF : 0)); E.HB = (GAS bf16_t*)(ws + WS_HB + (rep ? DRY_OFF : 0)); E.ss = (GAS float*)(ws + WS_SS + (rep ? DRY_OFF : 0)); E.HB8 = ws + WS_HB8;
            pg8::Gemm gm{(const bf16_t*)(ws + WS_O), (const bf16_t*)Bt, BATCH * SEQ, 1024, 1024}; pg8::StaticOrder S; S.init(BATCH * SEQ, 1024, F.G, (int)blockIdx.x);
            pg8::gemm_phase<EpiResid, pg8::StaticOrder>(glds, gm, S, E);
            gemm_tail<EpiResid>((const GAS bf16_t*)(ws + WS_O), Bt, 1024, E, F.gw, F.NGW, F.lane, F.lds);
            if (rep) xcd_barrier(bar);
        }
        xcd_barrier(bar);
        for (int rep = 0; rep < ((PROBE_DUP & 32) ? 2 : 1); ++rep) {
            PHASE_FRAME();
            EpiScale E; E.ss = (const GAS float*)(ws + WS_SS); E.vT = nullptr; E.O0 = (GAS bf16_t*)(ws + WS_PROJ); E.ld0 = 2048; E.split = 2048; E.O1 = E.O0; E.ld1 = 2048; E.f16 = true;
            pg8::Gemm gm{(const bf16_t*)(ws + WS_HB), (const bf16_t*)((const GAS bf16_t*)(ws + WS_WPQ) + (size_t)layer * 2048 * 1024), BATCH * SEQ, 2048, 1024}; pg8::StaticOrder S; S.init(BATCH * SEQ, 2048, F.G, (int)blockIdx.x);
            { LAS float* RINV = (LAS float*)(F.lds + 131072); LAS int* PML = (LAS int*)(F.lds + 131072 + 4096);
              _Pragma("unroll") for (int q = 0; q < 4; ++q) { const int pmq = unit_pm_of(S, q); if (F.tid == 0) PML[q] = pmq;
                  if (pmq >= 0 && F.tid < 256) RINV[q * 256 + F.tid] = row_rinv((const GAS float*)(ws + WS_SS), pg8::tile_row(pmq) + F.tid); }
              __syncthreads(); E.rinv_lds = RINV; E.pm_lds = PML; }
            pg8::gemm_phase<EpiScale, pg8::StaticOrder>(glds, gm, S, E);
            gemm_tail<EpiScale>((const GAS bf16_t*)(ws + WS_HB), (const GAS bf16_t*)(ws + WS_WPQ) + (size_t)layer * 2048 * 1024, 2048, E, F.gw, F.NGW, F.lane, F.lds);
            if (rep == 0 && (PROBE_DUP & 32)) xcd_barrier(bar);
        }
        xcd_barrier(bar);
        for (int rep = 0; rep < ((PROBE_DUP & 64) ? 2 : 1); ++rep) { { PHASE_FRAME(); phase_peer_route(F, layer, a.in[15], a.in[16], a.in[12]); } xcd_barrier(bar); }
        for (int rep = 0; rep < ((PROBE_DUP & (128 | 8192)) ? 2 : 1); ++rep) { { PHASE_FRAME(); phase_peer_u(F, layer, ((PROBE_DUP & 8192) && rep == 0) ? 0u : 0xffffu); } xcd_barrier(bar); }
        for (int rep = 0; rep < ((PROBE_DUP & 2048) ? 2 : 1); ++rep) { { PHASE_FRAME(); phase_peer_act(F); } xcd_barrier(bar); }
        if (PROBE_DUP & 4096) { { PHASE_FRAME(); phase_peer_v(F, layer, nullptr, DRY_OFF); } xcd_barrier(bar); }
        { PHASE_FRAME(); unsigned long long o_ = outu; asm volatile("" : "+s"(o_));
          phase_peer_v(F, layer, layer == 3 ? (float*)o_ : nullptr); }
        xcd_barrier(bar);
        if (PROBE_DUP & 256) { for (int rep = 0; rep < 8; ++rep) xcd_barrier(bar); }
    }
}

extern "C" void kernel_launch(void* const* d_in, const int* in_sizes, int n_in, void* d_out, int out_size, void* d_ws, size_t ws_size, hipStream_t stream) {
    static int grid = 0;
    if (grid == 0) {
        if (n_in != 17 || out_size != BATCH * SEQ * DM || ws_size < WS_END + (WS_PROJ - WS_H)) { fprintf(stderr, "kernel_launch: unexpected shapes (n_in %d out %d ws %zu need %zu)\n", n_in, out_size, ws_size, (size_t)WS_END); grid = -1; return; }
        int dev = 0, cus = 0, per_cu = 0;
        if (hipGetDevice(&dev) != hipSuccess || hipDeviceGetAttribute(&cus, hipDeviceAttributeMultiprocessorCount, dev) != hipSuccess) { grid = -1; return; }
        if (hipFuncSetAttribute((const void*)mk_fwd, hipFuncAttributeMaxDynamicSharedMemorySize, LDS_BYTES) != hipSuccess) { fprintf(stderr, "kernel_launch: hipFuncSetAttribute failed\n"); grid = -1; return; }
        if (hipOccupancyMaxActiveBlocksPerMultiprocessor(&per_cu, (const void*)mk_fwd, NT, LDS_BYTES) != hipSuccess || per_cu < 1) fprintf(stderr, "kernel_launch: occupancy query says %d blocks/CU\n", per_cu);
        (void)hipGetLastError();
        grid = cus;
    }
    if (grid < 0) return;
    if (hipMemsetAsync((char*)d_ws + WS_CTL, 0, 65536, stream) != hipSuccess) return;
    Args a{};
    for (int i = 0; i < 17; ++i) a.in[i] = (const float*)d_in[i];
    a.out = (float*)d_out; a.ws = (unsigned char*)d_ws;
    for (int i = 0; i < 16; ++i) a.inv32[i] = pow(500000.0, -(double)(2 * i) / 32.0);
    for (int i = 0; i < 8; ++i) a.inv16[i] = pow(500000.0, -(double)(2 * i) / 16.0);
    hipLaunchKernelGGL(mk_fwd, dim3(grid), dim3(NT), LDS_BYTES, stream, a);
}
```
